# Optimizing an MI355X kernel written in HIP

```python
import jax, jax.numpy as jnp
from jax import lax
import numpy as np


D_MODEL = 1024
BATCH = 8
SEQ = 4096
DEPTH = 2
DEC_BATCH = 128
DEC_SEQ = 8
PAST_LEN = 16384
PAGE_SIZE = 128

HEAD_DIM = 64
A_HEADS = 8
A_KV_HEADS = 2
A_GROUP = A_HEADS // A_KV_HEADS
A_WINDOW = 128
A_Q = A_HEADS * HEAD_DIM
A_KV = A_KV_HEADS * HEAD_DIM
B_WIDTH = D_MODEL // 2
CONV_WIDTH = 3
C_WIDTH = D_MODEL // 2
POOL_WINDOWS = (2, 4, 8, 16)
C_GROUPS = len(POOL_WINDOWS)
C_GROUP_WIDTH = C_WIDTH // C_GROUPS
POOL_MAX = max(POOL_WINDOWS)
D_HEADS = 8
D_QKV = D_HEADS * HEAD_DIM
D_BRANCHES = ((128, 1), (512, 4), (2048, 16))
D_WINDOW_MAX = max(w for w, _ in D_BRANCHES)
EVEN_IN = A_Q + 2 * A_KV + 3 * B_WIDTH
EVEN_MIX = A_Q + B_WIDTH
ODD_IN = C_WIDTH + 3 * D_QKV
ODD_MIX = C_WIDTH + D_QKV
D_MLP = 4 * D_MODEL
N_EVEN = (DEPTH + 1) // 2
N_ODD = DEPTH // 2
DEEPNORM_ALPHA = (2 * DEPTH) ** 0.25
DEEPNORM_BETA = (8 * DEPTH) ** -0.25
LN_EPS = 1e-5

kernel_name = "hybrid_swa_conv_pool_dilated_step"


def alibi_slopes(n_heads):
    return jnp.asarray(2.0 ** (-8.0 * np.arange(1, n_heads + 1) / n_heads), dtype=jnp.float32)


def layer_norm(x, g, b):
    xf = x.astype(jnp.float32)
    mu = jnp.mean(xf, axis=-1, keepdims=True)
    var = jnp.mean(jnp.square(xf - mu), axis=-1, keepdims=True)
    return ((xf - mu) * lax.rsqrt(var + LN_EPS) * g.astype(jnp.float32) + b.astype(jnp.float32)).astype(x.dtype)


def squared_relu_mlp(x, w1, w2):
    return jnp.square(jax.nn.relu(x @ w1)) @ w2


def combine_branches(parts, sink=None):
    o = jnp.stack([p[0] for p in parts])
    m = jnp.stack([p[1] for p in parts])
    s = jnp.stack([p[2] for p in parts])
    m_ref = jnp.max(m, axis=0)
    if sink is not None:
        m_ref = jnp.maximum(m_ref, sink)
    w = s * jnp.exp(m - m_ref)
    den = jnp.sum(w, axis=0)
    if sink is not None:
        den = den + jnp.exp(sink - m_ref)
    return jnp.sum(w[..., None] * o, axis=0) / den[..., None]


def banded_window_attn(q, k, v, dilation, n_w, slopes):
    B, S = q.shape[0], q.shape[1]
    n = S // dilation
    blk = n_w
    nb = -(-n // blk)
    pad = nb * blk - n

    def strided(x):
        rest = x.shape[2:]
        x = jnp.moveaxis(x.reshape((B, n, dilation) + rest), 2, 1)
        return x.reshape((B * dilation, n) + rest)

    def blocks(x):
        x = jnp.pad(x, [(0, 0), (0, pad)] + [(0, 0)] * (x.ndim - 2))
        return x.reshape((x.shape[0], nb, blk) + x.shape[2:])

    def with_prev(xb):
        prev = jnp.pad(xb[:, :-1], [(0, 0), (1, 0)] + [(0, 0)] * (xb.ndim - 2))
        return jnp.concatenate([prev, xb], axis=2)

    def unstrided(x):
        rest = x.shape[3:]
        x = x.reshape((B * dilation, nb * blk) + rest)[:, :n]
        x = jnp.moveaxis(x.reshape((B, dilation, n) + rest), 1, 2)
        return x.reshape((B, S) + rest)

    qb = blocks(strided(q))
    kk = with_prev(blocks(strided(k)))
    vv = with_prev(blocks(strided(v)))
    scores = jnp.einsum('bnqhgd,bnkhd->bnhgqk', qb, kk, preferred_element_type=jnp.float32)
    qi = jnp.arange(blk)[:, None]
    kj = jnp.arange(2 * blk)[None, :]
    dist = qi + blk - kj
    key_idx = jnp.arange(nb)[:, None, None] * blk - blk + kj[None]
    valid = (dist >= 0)[None] & (dist <= n_w)[None] & (key_idx >= 0)
    bias = -slopes[:, :, None, None] * (dist * dilation).astype(jnp.float32)[None, None]
    scores = jnp.where(valid[None, :, None, None], scores + bias[None, None], -jnp.inf)
    m = jnp.max(scores, axis=-1)
    p = jnp.exp(scores - m[..., None])
    s = jnp.sum(p, axis=-1)
    o = jnp.einsum('bnhgqk,bnkhd->bnqhgd', p, vv.astype(jnp.float32))
    m = jnp.moveaxis(m, -1, 2)
    s = jnp.moveaxis(s, -1, 2)
    o = o / s[..., None]
    return unstrided(o), unstrided(m), unstrided(s)


def gathered_window_attn(q, k_all, v_all, n_hist, dilation, n_w, slopes):
    T = q.shape[1]
    j = jnp.arange(n_w + 1)
    idx = n_hist + jnp.arange(T)[:, None] - j[None, :] * dilation
    valid = idx >= 0
    idx = jnp.maximum(idx, 0)
    kg = k_all[:, idx]
    vg = v_all[:, idx]
    scores = jnp.einsum('bthgd,btjhd->bthgj', q, kg, preferred_element_type=jnp.float32)
    bias = -slopes[:, :, None] * (j * dilation).astype(jnp.float32)[None, None]
    scores = jnp.where(valid[None, :, None, None, :], scores + bias, -jnp.inf)
    m = jnp.max(scores, axis=-1)
    p = jnp.exp(scores - m[..., None])
    s = jnp.sum(p, axis=-1)
    o = jnp.einsum('bthgj,btjhd->bthgd', p, vg.astype(jnp.float32)) / s[..., None]
    return o, m, s


def multi_pool_minus_identity(u_all, n_new, pos):
    H = u_all.shape[1] - n_new
    uf = u_all.astype(jnp.float32)
    cs = jnp.pad(jnp.cumsum(uf, axis=1), [(0, 0), (1, 0), (0, 0)])
    end = cs[:, H + 1:H + 1 + n_new]
    outs = []
    for g, w in enumerate(POOL_WINDOWS):
        lo, hi = g * C_GROUP_WIDTH, (g + 1) * C_GROUP_WIDTH
        start = cs[:, H + 1 - w:H + 1 - w + n_new, lo:hi]
        cnt = jnp.minimum(pos + 1, w).astype(jnp.float32)[:, None]
        outs.append((end[..., lo:hi] - start) / cnt - uf[:, H:, lo:hi])
    return jnp.concatenate(outs, axis=-1)


def even_mixer(x, hist, w_in, b_in, sinks, conv_w, w_out, b_out):
    Bn, T, _ = x.shape
    proj = x @ w_in + b_in
    o1 = A_Q
    o2 = o1 + A_KV
    o3 = o2 + A_KV
    o4 = o3 + B_WIDTH
    o5 = o4 + B_WIDTH
    q, k, v, h, gb, gc = jnp.split(proj, [o1, o2, o3, o4, o5], axis=-1)
    q = q.reshape(Bn, T, A_KV_HEADS, A_GROUP, HEAD_DIM) * HEAD_DIM ** -0.5
    k = k.reshape(Bn, T, A_KV_HEADS, HEAD_DIM)
    v = v.reshape(Bn, T, A_KV_HEADS, HEAD_DIM)
    c = gc * h
    slopes = alibi_slopes(A_HEADS).reshape(A_KV_HEADS, A_GROUP)
    if hist is None:
        part = banded_window_attn(q, k, v, 1, A_WINDOW, slopes)
        c_hist = jnp.zeros((Bn, CONV_WIDTH - 1, B_WIDTH), c.dtype)
        n_keep = min(A_WINDOW, T)
        new_k, new_v = k[:, -n_keep:], v[:, -n_keep:]
    else:
        k_cache, v_cache, c_hist = hist
        n_hist = k_cache.shape[1]
        k_all = jnp.concatenate([k_cache, k], axis=1)
        v_all = jnp.concatenate([v_cache, v], axis=1)
        part = gathered_window_attn(q, k_all, v_all, n_hist, 1, A_WINDOW, slopes)
        new_k, new_v = k_all[:, -n_hist:], v_all[:, -n_hist:]
    sink = sinks.astype(jnp.float32).reshape(A_KV_HEADS, A_GROUP)
    y_a = combine_branches([part], sink=sink).reshape(Bn, T, A_Q).astype(x.dtype)
    c_all = jnp.concatenate([c_hist, c], axis=1)
    conv = sum(c_all[:, i:i + T] * conv_w[i] for i in range(CONV_WIDTH))
    y_b = gb * conv
    mix = jnp.concatenate([y_a, y_b], axis=-1) @ w_out + b_out
    return mix, (new_k, new_v, c_all[:, -(CONV_WIDTH - 1):])


def odd_mixer(x, pos, hist, w_in, b_in, w_group, scale, w_out, b_out):
    Bn, T, _ = x.shape
    proj = x @ w_in + b_in
    u, q, k, v = jnp.split(proj, [C_WIDTH, C_WIDTH + D_QKV, C_WIDTH + 2 * D_QKV], axis=-1)
    q = q.reshape(Bn, T, D_HEADS, 1, HEAD_DIM) * HEAD_DIM ** -0.5
    k = k.reshape(Bn, T, D_HEADS, HEAD_DIM)
    v = v.reshape(Bn, T, D_HEADS, HEAD_DIM)
    slopes = alibi_slopes(D_HEADS).reshape(D_HEADS, 1)
    if hist is None:
        parts = [banded_window_attn(q, k, v, d, w // d, slopes) for w, d in D_BRANCHES]
        u_hist = jnp.zeros((Bn, POOL_MAX - 1, C_WIDTH), u.dtype)
        n_keep = min(D_WINDOW_MAX, T)
        new_k, new_v = k[:, -n_keep:], v[:, -n_keep:]
    else:
        u_hist, k_cache, v_cache = hist
        n_hist = k_cache.shape[1]
        k_all = jnp.concatenate([k_cache, k], axis=1)
        v_all = jnp.concatenate([v_cache, v], axis=1)
        parts = [gathered_window_attn(q, k_all, v_all, n_hist, d, w // d, slopes) for w, d in D_BRANCHES]
        new_k, new_v = k_all[:, -n_hist:], v_all[:, -n_hist:]
    y_d = combine_branches(parts).reshape(Bn, T, D_QKV).astype(x.dtype)
    u_all = jnp.concatenate([u_hist, u], axis=1)
    pooled = multi_pool_minus_identity(u_all, T, pos).astype(x.dtype)
    y_c = jnp.einsum('btgc,gcd->btgd', pooled.reshape(Bn, T, C_GROUPS, C_GROUP_WIDTH), w_group)
    y_c = y_c.reshape(Bn, T, C_WIDTH) * scale
    mix = jnp.concatenate([y_c, y_d], axis=-1) @ w_out + b_out
    return mix, (u_all[:, -(POOL_MAX - 1):], new_k, new_v)


def trunk(x, pos, caches, even_w_in, even_b_in, a_sinks, b_conv_w, even_w_out, even_b_out,
          odd_w_in, odd_b_in, c_w_group, c_scale, odd_w_out, odd_b_out,
          mlp_w1, mlp_w2, ln1_g, ln1_b, ln2_g, ln2_b):
    even_states, odd_states = [], []
    for layer in range(DEPTH):
        i = layer // 2
        if layer % 2 == 0:
            hist = None if caches is None else (caches[0][i], caches[1][i], caches[2][i])
            mix, st = even_mixer(x, hist, even_w_in[i], even_b_in[i], a_sinks[i], b_conv_w[i],
                                 even_w_out[i], even_b_out[i])
            even_states.append(st)
        else:
            hist = None if caches is None else (caches[3][i], caches[4][i], caches[5][i])
            mix, st = odd_mixer(x, pos, hist, odd_w_in[i], odd_b_in[i], c_w_group[i], c_scale[i],
                                odd_w_out[i], odd_b_out[i])
            odd_states.append(st)
        x = layer_norm(DEEPNORM_ALPHA * x + mix, ln1_g[layer], ln1_b[layer])
        x = layer_norm(DEEPNORM_ALPHA * x + squared_relu_mlp(x, mlp_w1[layer], mlp_w2[layer]),
                       ln2_g[layer], ln2_b[layer])
    a_k = jnp.stack([s[0] for s in even_states])
    a_v = jnp.stack([s[1] for s in even_states])
    b_conv = jnp.stack([s[2] for s in even_states])
    c_pool = jnp.stack([s[0] for s in odd_states])
    d_k = jnp.stack([s[1] for s in odd_states])
    d_v = jnp.stack([s[2] for s in odd_states])
    return x, a_k, a_v, b_conv, c_pool, d_k, d_v


def setup_inputs(seed: int = 0) -> dict:
    key = jax.random.key(seed)
    ks = jax.random.split(key, 26)

    def nrm(k, shape, scale):
        return jax.random.normal(k, shape, jnp.float32) * scale

    n_a = min(A_WINDOW, PAST_LEN)
    n_d = min(D_WINDOW_MAX, PAST_LEN)
    return {
        "x_prompt": nrm(ks[0], (BATCH, SEQ, D_MODEL), 1.0),
        "x_sample": nrm(ks[1], (DEC_BATCH, DEC_SEQ, D_MODEL), 1.0),
        "cache_a_k": nrm(ks[2], (N_EVEN, DEC_BATCH, n_a, A_KV_HEADS, HEAD_DIM), 1.0),
        "cache_a_v": nrm(ks[3], (N_EVEN, DEC_BATCH, n_a, A_KV_HEADS, HEAD_DIM), 1.0),
        "state_b_conv": nrm(ks[4], (N_EVEN, DEC_BATCH, CONV_WIDTH - 1, B_WIDTH), 1.0),
        "state_c_pool": nrm(ks[5], (N_ODD, DEC_BATCH, POOL_MAX - 1, C_WIDTH), 1.0),
        "cache_d_k": nrm(ks[6], (N_ODD, DEC_BATCH, n_d, D_HEADS, HEAD_DIM), 1.0),
        "cache_d_v": nrm(ks[7], (N_ODD, DEC_BATCH, n_d, D_HEADS, HEAD_DIM), 1.0),
        "even_w_in": nrm(ks[8], (N_EVEN, D_MODEL, EVEN_IN), D_MODEL ** -0.5),
        "even_b_in": nrm(ks[9], (N_EVEN, EVEN_IN), 0.02),
        "a_sinks": nrm(ks[10], (N_EVEN, A_HEADS), 1.0),
        "b_conv_w": nrm(ks[11], (N_EVEN, CONV_WIDTH, B_WIDTH), CONV_WIDTH ** -0.5),
        "even_w_out": nrm(ks[12], (N_EVEN, EVEN_MIX, D_MODEL), EVEN_MIX ** -0.5 * DEEPNORM_BETA),
        "even_b_out": nrm(ks[13], (N_EVEN, D_MODEL), 0.02),
        "odd_w_in": nrm(ks[14], (N_ODD, D_MODEL, ODD_IN), D_MODEL ** -0.5),
        "odd_b_in": nrm(ks[15], (N_ODD, ODD_IN), 0.02),
        "c_w_group": nrm(ks[16], (N_ODD, C_GROUPS, C_GROUP_WIDTH, C_GROUP_WIDTH), C_GROUP_WIDTH ** -0.5),
        "c_scale": 1.0 + nrm(ks[17], (N_ODD, C_WIDTH), 0.1),
        "odd_w_out": nrm(ks[18], (N_ODD, ODD_MIX, D_MODEL), ODD_MIX ** -0.5 * DEEPNORM_BETA),
        "odd_b_out": nrm(ks[19], (N_ODD, D_MODEL), 0.02),
        "mlp_w1": nrm(ks[20], (DEPTH, D_MODEL, D_MLP), D_MODEL ** -0.5),
        "mlp_w2": nrm(ks[21], (DEPTH, D_MLP, D_MODEL), D_MLP ** -0.5 * DEEPNORM_BETA),
        "ln1_g": 1.0 + nrm(ks[22], (DEPTH, D_MODEL), 0.05),
        "ln1_b": nrm(ks[23], (DEPTH, D_MODEL), 0.02),
        "ln2_g": 1.0 + nrm(ks[24], (DEPTH, D_MODEL), 0.05),
        "ln2_b": nrm(ks[25], (DEPTH, D_MODEL), 0.02),
    }


def reference(x_prompt, x_sample, cache_a_k, cache_a_v, state_b_conv, state_c_pool, cache_d_k, cache_d_v,
              even_w_in, even_b_in, a_sinks, b_conv_w, even_w_out, even_b_out,
              odd_w_in, odd_b_in, c_w_group, c_scale, odd_w_out, odd_b_out,
              mlp_w1, mlp_w2, ln1_g, ln1_b, ln2_g, ln2_b):
    weights = (even_w_in, even_b_in, a_sinks, b_conv_w, even_w_out, even_b_out,
               odd_w_in, odd_b_in, c_w_group, c_scale, odd_w_out, odd_b_out,
               mlp_w1, mlp_w2, ln1_g, ln1_b, ln2_g, ln2_b)
    pos_prompt = jnp.arange(x_prompt.shape[1])
    pos_sample = PAST_LEN + jnp.arange(x_sample.shape[1])
    y_prompt, ak_p, av_p, bc_p, cp_p, dk_p, dv_p = trunk(x_prompt, pos_prompt, None, *weights)
    sample_caches = (cache_a_k, cache_a_v, state_b_conv, state_c_pool, cache_d_k, cache_d_v)
    y_sample, ak_s, av_s, bc_s, cp_s, dk_s, dv_s = trunk(x_sample, pos_sample, sample_caches, *weights)
    return (y_prompt, y_sample, ak_p, av_p, bc_p, cp_p, dk_p, dv_p, ak_s, av_s, bc_s, cp_s, dk_s, dv_s)
```

```cpp
#include <hip/hip_runtime.h>
#include <cstdio>
#include <cstdint>
namespace pg8 {
#define PG8_LAS __attribute__((address_space(3)))
typedef unsigned short bf16_t;
typedef short bf16x8 __attribute__((ext_vector_type(8)));
typedef float f32x4 __attribute__((ext_vector_type(4)));
typedef unsigned u32x4 __attribute__((ext_vector_type(4)));
constexpr int BM = 256, BK = 64, HALF = 128, HTB = HALF * BK * 2  , STAGE_BYTES = 8 * HTB, NXCD = 8, WGM = 8;

__host__ __device__ __forceinline__ int lds_byte(int r, int c) { const int st = (r >> 4) * 2 + (c >> 5), rr = r & 15, cc = c & 31, ob = rr * 64 + cc * 2; return st * 1024 + (ob ^ (((ob >> 9) & 1) << 5)); }
__host__ __device__ __forceinline__ void stage_rc(int b, int& R, int& C) { const int st = b / 1024, sb = b % 1024, swz = sb ^ (((sb >> 9) & 1) << 5); R = (st >> 1) * 16 + swz / 64; C = (st & 1) * 32 + (swz % 64) / 2; }
__host__ __device__ __forceinline__ int perm32(int rho) { const int n = rho >> 4, i = rho & 15; return 8 * (i >> 2) + 4 * n + (i & 3); }

struct Unit { int pm, pn; };
struct Gemm { const bf16_t* A; const bf16_t* Bt; int M, N, K; };

struct StaticOrder {
    int nM, nN, nwg, G, c;
    __host__ __device__ void init(int M, int N, int G_, int c_) { nM = M / BM; nN = N / BM; nwg = nM * nN; G = G_; c = c_; }
    __host__ __device__ bool next(int i, Unit& u) const {
        const long L = (long)i * G + c; if (L >= nwg) return false;
        int wgid = (int)L; { const int q = nwg / NXCD, r = nwg % NXCD, xcd = wgid % NXCD, off = wgid / NXCD; wgid = (xcd < r ? xcd * (q + 1) : r * (q + 1) + (xcd - r) * q) + off; }
        const int nig = WGM * nN, gid = wgid / nig, fm = gid * WGM, gsz = (nM - fm) < WGM ? (nM - fm) : WGM;
        u.pm = fm + ((wgid % nig) % gsz); u.pn = (wgid % nig) / gsz; return true;
    }
    __device__ __forceinline__ void a_ready(const Unit&) const {}
    __device__ __forceinline__ void done(const Unit&) const {}
};

__device__ __forceinline__ unsigned cvt_pk_bf16(float lo, float hi) { unsigned r; asm volatile("v_cvt_pk_bf16_f32 %0, %1, %2" : "=v"(r) : "v"(lo), "v"(hi)); return r; }
typedef float f32x2 __attribute__((ext_vector_type(2)));
template <class Epi, class Sched, bool ALIGN_EPI = false, bool SP2 = false>
__device__ __forceinline__ void gemm_phase(PG8_LAS unsigned char* lds, const Gemm g, const Sched& S, const Epi& E) {
    const int tid = threadIdx.x, wid = __builtin_amdgcn_readfirstlane(tid >> 6), lane = tid & 63, wr = wid >> 2, wc = wid & 3, fr = lane & 15, fq = lane >> 4;
    const int K = g.K, nt = K / BK;
    unsigned voffA[2], voffB[2];
#pragma unroll
    for (int i = 0; i < 2; ++i) { int R, C; stage_rc(tid * 16 + i * 8192, R, C); const int Rb = Epi::PERM ? ((R & ~31) + perm32(R & 31)) : R;
        voffA[i] = (unsigned)(R * K + C) * 2u; voffB[i] = (unsigned)(Rb * K + C) * 2u; }
    const size_t kstep = (size_t)(BK * 2);
    const size_t hstep = (size_t)HALF * K * 2;
    const size_t tstep = 2 * hstep;
    const unsigned ldsw = (unsigned)wid * 1024u;
    const int aoff = lds_byte(wr * 64 + fr, fq * 8), boff = lds_byte(wc * 32 + fr, fq * 8);
#define PG8_SA(b, h) (((b) * 2 + (h)) * HTB)
#define PG8_SB(b, h) ((4 + (b) * 2 + (h)) * HTB)
#define PG8_STAGE(bufoff, gbase, voff) do { _Pragma("unroll") for (int _i = 0; _i < 2; ++_i) \
        __builtin_amdgcn_global_load_lds((const unsigned*)((const char*)(gbase) + (voff)[_i]), (PG8_LAS unsigned*)(lds + (bufoff) + ldsw + _i * 8192), 16, 0, 0); } while (0)
#define PG8_LDA(dst, b, h) do { _Pragma("unroll") for (int m = 0; m < 4; ++m) _Pragma("unroll") for (int k = 0; k < 2; ++k) dst[m][k] = *(const PG8_LAS bf16x8*)(lds + PG8_SA(b, h) + aoff + m * 2048 + k * 1024); } while (0)
#define PG8_LDB(dst, b, h) do { _Pragma("unroll") for (int n = 0; n < 2; ++n) _Pragma("unroll") for (int k = 0; k < 2; ++k) dst[n][k] = *(const PG8_LAS bf16x8*)(lds + PG8_SB(b, h) + boff + n * 2048 + k * 1024); } while (0)
#define PG8_MMA(ai, bj, At, Bt) do { __builtin_amdgcn_s_setprio(1); _Pragma("unroll") for (int m = 0; m < 4; ++m) _Pragma("unroll") for (int n = 0; n < 2; ++n) _Pragma("unroll") for (int k = 0; k < 2; ++k) \
        acc[ai][bj][m][n] = __builtin_amdgcn_mfma_f32_16x16x32_bf16(Bt[n][k], At[m][k], acc[ai][bj][m][n], 0, 0, 0); __builtin_amdgcn_s_setprio(0); } while (0)
#define PG8_WAIT_V(n) asm volatile("s_waitcnt vmcnt(" #n ")" ::: "memory")
#define PG8_WAIT_L(n) asm volatile("s_waitcnt lgkmcnt(" #n ")" ::: "memory")
#define PG8_BAR __builtin_amdgcn_s_barrier()
#define PG8_SCHED __builtin_amdgcn_sched_barrier(0)
    Unit cur, nxt; int ui = 0;
    if (!S.next(0, cur)) return;
    f32x4 acc[2][2][4][2];
#pragma unroll
    for (int a = 0; a < 2; ++a)
#pragma unroll
        for (int b = 0; b < 2; ++b)
#pragma unroll
            for (int m = 0; m < 4; ++m)
#pragma unroll
                for (int n = 0; n < 2; ++n) acc[a][b][m][n] = (f32x4){0.f, 0.f, 0.f, 0.f};
    bf16x8 At[4][2], B0[2][2], B1[2][2];
    const char* cA = (const char*)g.A + (size_t)cur.pm * tstep; const char* cB = (const char*)g.Bt + (size_t)cur.pn * tstep;
    S.a_ready(cur);
    if constexpr (SP2) {
        PG8_STAGE(PG8_SB(0, 0), cB, voffB); PG8_STAGE(PG8_SB(0, 1), cB + hstep, voffB); PG8_STAGE(PG8_SA(0, 0), cA, voffA); PG8_STAGE(PG8_SA(0, 1), cA + hstep, voffA);
        if (wr == 1) PG8_BAR;
        PG8_WAIT_V(2); PG8_BAR;
        PG8_STAGE(PG8_SB(1, 0), cB + kstep, voffB); PG8_STAGE(PG8_SA(1, 0), cA + kstep, voffA); PG8_STAGE(PG8_SB(1, 1), cB + hstep + kstep, voffB);
        PG8_WAIT_V(6); PG8_BAR;
    } else {
        PG8_STAGE(PG8_SB(0, 0), cB, voffB); PG8_STAGE(PG8_SA(0, 0), cA, voffA); PG8_STAGE(PG8_SB(0, 1), cB + hstep, voffB); PG8_STAGE(PG8_SA(0, 1), cA + hstep, voffA);
        if (wr == 1) PG8_BAR;
        PG8_WAIT_V(4); PG8_BAR;
        PG8_STAGE(PG8_SB(1, 0), cB + kstep, voffB); PG8_STAGE(PG8_SA(1, 0), cA + kstep, voffA); PG8_STAGE(PG8_SB(1, 1), cB + hstep + kstep, voffB);
        PG8_WAIT_V(6); PG8_BAR;
    }
    for (;;) {
        const bool has_next = S.next(ui + 1, nxt);
        const char* nA = has_next ? (const char*)g.A + (size_t)nxt.pm * tstep : cA; const char* nB = has_next ? (const char*)g.Bt + (size_t)nxt.pn * tstep : cB;
        for (int t = 0; t < nt; t += 2) {
            const bool last = (t == nt - 2);
            const char* a1 = cA + (size_t)(t + 1) * kstep;
            const char* a2 = last ? nA : cA + (size_t)(t + 2) * kstep; const char* b2 = last ? nB : cB + (size_t)(t + 2) * kstep;
            const char* a3 = a2 + kstep; const char* b3 = b2 + kstep;
            if (last && has_next) S.a_ready(nxt);
            if constexpr (SP2) {
            PG8_LDB(B0, 0, 0); PG8_LDB(B1, 0, 1); PG8_SCHED; PG8_LDA(At, 0, 0); PG8_STAGE(PG8_SA(1, 1), a1 + hstep, voffA);
            PG8_WAIT_V(8); PG8_WAIT_L(0); PG8_BAR; PG8_MMA(0, 0, At, B0); PG8_MMA(0, 1, At, B1); PG8_BAR; PG8_SCHED;
            PG8_LDA(At, 0, 1); PG8_STAGE(PG8_SB(0, 0), b2, voffB); PG8_STAGE(PG8_SB(0, 1), b2 + hstep, voffB); PG8_STAGE(PG8_SA(0, 0), a2, voffA);
            PG8_WAIT_V(8); PG8_WAIT_L(0); PG8_BAR; PG8_MMA(1, 0, At, B0); PG8_MMA(1, 1, At, B1); PG8_BAR; PG8_SCHED;
            PG8_LDB(B0, 1, 0); PG8_LDB(B1, 1, 1); PG8_SCHED; PG8_LDA(At, 1, 0); PG8_STAGE(PG8_SA(0, 1), a2 + hstep, voffA);
            PG8_WAIT_V(8); PG8_WAIT_L(0); PG8_BAR; PG8_MMA(0, 0, At, B0); PG8_MMA(0, 1, At, B1); PG8_BAR; PG8_SCHED;
            PG8_LDA(At, 1, 1); PG8_STAGE(PG8_SB(1, 0), b3, voffB); PG8_STAGE(PG8_SB(1, 1), b3 + hstep, voffB); PG8_STAGE(PG8_SA(1, 0), a3, voffA);
            PG8_WAIT_V(8); PG8_WAIT_L(0); PG8_BAR; PG8_MMA(1, 0, At, B0); PG8_MMA(1, 1, At, B1); PG8_BAR; PG8_SCHED;
            } else {
            PG8_LDB(B0, 0, 0); PG8_SCHED; PG8_LDA(At, 0, 0); PG8_STAGE(PG8_SA(1, 1), a1 + hstep, voffA);
            PG8_WAIT_L(8); PG8_BAR; PG8_WAIT_L(0); PG8_MMA(0, 0, At, B0); PG8_BAR; PG8_SCHED;
            PG8_LDB(B1, 0, 1); PG8_STAGE(PG8_SB(0, 0), b2, voffB);
            PG8_BAR; PG8_WAIT_L(0); PG8_MMA(0, 1, At, B1); PG8_BAR;
            PG8_LDA(At, 0, 1); PG8_STAGE(PG8_SA(0, 0), a2, voffA);
            PG8_BAR; PG8_WAIT_L(0); PG8_MMA(1, 0, At, B0); PG8_BAR; PG8_SCHED;
            PG8_STAGE(PG8_SB(0, 1), b2 + hstep, voffB);
            PG8_WAIT_V(6); PG8_BAR; PG8_MMA(1, 1, At, B1); PG8_BAR;
            PG8_LDB(B0, 1, 0); PG8_SCHED; PG8_LDA(At, 1, 0); PG8_STAGE(PG8_SA(0, 1), a2 + hstep, voffA);
            PG8_WAIT_L(8); PG8_BAR; PG8_WAIT_L(0); PG8_MMA(0, 0, At, B0); PG8_BAR; PG8_SCHED;
            PG8_LDB(B1, 1, 1); PG8_STAGE(PG8_SB(1, 0), b3, voffB);
            PG8_BAR; PG8_WAIT_L(0); PG8_MMA(0, 1, At, B1); PG8_BAR;
            PG8_LDA(At, 1, 1); PG8_STAGE(PG8_SA(1, 0), a3, voffA);
            PG8_BAR; PG8_WAIT_L(0); PG8_MMA(1, 0, At, B0); PG8_BAR; PG8_SCHED;
            PG8_STAGE(PG8_SB(1, 1), b3 + hstep, voffB);
            PG8_WAIT_V(6); PG8_BAR; PG8_MMA(1, 1, At, B1); PG8_BAR;
            }
        }
        if constexpr (ALIGN_EPI) { if (wr == 0) PG8_BAR; }
        if constexpr (!Epi::AFTER_DRAIN) { E(acc, cur, wr, wc, fr, fq); S.done(cur); }
        if (!has_next) break;
#pragma unroll
        for (int a = 0; a < 2; ++a)
#pragma unroll
            for (int b = 0; b < 2; ++b)
#pragma unroll
                for (int m = 0; m < 4; ++m)
#pragma unroll
                    for (int n = 0; n < 2; ++n) acc[a][b][m][n] = (f32x4){0.f, 0.f, 0.f, 0.f};
        cur = nxt; cA = nA; cB = nB; ++ui;
        if constexpr (ALIGN_EPI) { if (wr == 1) PG8_BAR; }
    }
    PG8_WAIT_V(0);
    if constexpr (!ALIGN_EPI) { if (wr == 0) PG8_BAR; }
    PG8_BAR;
    if constexpr (Epi::AFTER_DRAIN) { E.fused(acc, cur, wr, wc, fr, fq, lds, wid, lane); S.done(cur); }
#undef PG8_SA
#undef PG8_SB
#undef PG8_STAGE
#undef PG8_LDA
#undef PG8_LDB
#undef PG8_MMA
#undef PG8_WAIT_V
#undef PG8_WAIT_L
#undef PG8_BAR
#undef PG8_SCHED
}
}
#define GAS __attribute__((address_space(1)))
#define LAS __attribute__((address_space(3)))
typedef unsigned short bf16;
typedef unsigned v4u __attribute__((ext_vector_type(4)));
typedef float f32x4 __attribute__((ext_vector_type(4)));
typedef short bf16x8 __attribute__((ext_vector_type(8)));
typedef GAS unsigned gu32;
typedef GAS unsigned long long gu64;
#define RLX_AGENT __ATOMIC_RELAXED, __HIP_MEMORY_SCOPE_AGENT
#define LDS_WAIT() asm volatile("s_waitcnt lgkmcnt(0)" ::: "memory")
#define VM_WAIT() asm volatile("s_waitcnt vmcnt(0)" ::: "memory")
__device__ __forceinline__ unsigned long long rt() { return __builtin_amdgcn_s_memrealtime(); }
__device__ __forceinline__ unsigned f2bf(float f) { unsigned u = __builtin_bit_cast(unsigned, f); return (u + 0x7fffu + ((u >> 16) & 1u)) >> 16; }
__device__ __forceinline__ unsigned pk2(float lo, float hi) { return f2bf(lo) | (f2bf(hi) << 16); }

#define XB_TMO      128
#define XB_XCNT(j)  (256  + 64 * (j))
#define XB_XSUB(j)  (1280 + 64 * (j))
#define XB_XGEN(j)  (2304 + 64 * (j))
#define XB_TOP      3328
#define XB_TOPGEN   3392
#define XCD_BAR_WORDS 3456
#define XB_SPIN_CAP (1u << 22)

__device__ __forceinline__ unsigned xb_ld(unsigned* p)              { return __hip_atomic_load(p, __ATOMIC_RELAXED, __HIP_MEMORY_SCOPE_AGENT); }
__device__ __forceinline__ unsigned xb_add(unsigned* p, unsigned v) { return __hip_atomic_fetch_add(p, v, __ATOMIC_RELAXED, __HIP_MEMORY_SCOPE_AGENT); }
__device__ __forceinline__ unsigned xb_xcc_id() { return (unsigned)__builtin_amdgcn_s_getreg((3 << 11) | 20) & 0xFu; }
#define XB_SPIN(cond, bar) do { unsigned _sp = 0; while (cond) { __builtin_amdgcn_s_sleep(1); \
    if ((++_sp & 255u) == 0u) { if (xb_ld(&(bar)[XB_TMO])) break; if (_sp > XB_SPIN_CAP) { atomicAdd(&(bar)[XB_TMO], 1u); break; } } } } while (0)

struct XcdBarrier {
    unsigned* bar; unsigned x;
    volatile LAS unsigned* st;
};

__device__ __forceinline__ XcdBarrier xcd_barrier_post(unsigned* bar, volatile LAS unsigned* st) {
    XcdBarrier b; b.bar = bar; b.x = xb_xcc_id(); b.st = st;
    if (threadIdx.x == 0) (void)xb_add(&bar[XB_XCNT(b.x)], 1u);
    return b;
}
__device__ __forceinline__ void xcd_barrier_complete(unsigned* bar, unsigned x, unsigned& nloc, unsigned& nx) {
    const unsigned G = gridDim.x * gridDim.y * gridDim.z;
    unsigned sum, cnt, mine, sp = 0u;
    for (;;) {
        sum = 0u; cnt = 0u; mine = 0u;
#pragma unroll
        for (unsigned j = 0; j < 16; ++j) { const unsigned c = xb_ld(&bar[XB_XCNT(j)]); sum += c; cnt += (c > 0u) ? 1u : 0u; mine = (j == x) ? c : mine; }
        if (sum == G) break;
        __builtin_amdgcn_s_sleep(1);
        if ((++sp & 255u) == 0u) { if (xb_ld(&bar[XB_TMO])) break; if (sp > XB_SPIN_CAP) { atomicAdd(&bar[XB_TMO], 1u); break; } }
    }
    nloc = mine > 0u ? mine : 1u; nx = cnt > 0u ? cnt : 1u;
}

__device__ __forceinline__ void xcd_barrier(const XcdBarrier& b) {
    asm volatile("s_waitcnt vmcnt(0)" ::: "memory");
    __syncthreads();
    if (threadIdx.x == 0) {
        unsigned* bar = b.bar;
        __builtin_amdgcn_s_waitcnt(0);
        unsigned nloc = b.st[0], nx = b.st[1];
        if (nloc == 0u) { xcd_barrier_complete(bar, b.x, nloc, nx); b.st[0] = nloc; b.st[1] = nx; }
        const unsigned old = xb_add(&bar[XB_XSUB(b.x)], 1u);
        const unsigned gen = old / nloc;
        if (old + 1u == (gen + 1u) * nloc) {
            __builtin_amdgcn_fence(__ATOMIC_RELEASE, "agent");
            asm volatile("s_waitcnt vmcnt(0)" ::: "memory");
            const unsigned og = xb_add(&bar[XB_TOP], 1u);
            const unsigned tg = og / nx;
            if (og + 1u == (tg + 1u) * nx) xb_add(&bar[XB_TOPGEN], 1u);
            else XB_SPIN(xb_ld(&bar[XB_TOPGEN]) == tg, bar);
            __builtin_amdgcn_fence(__ATOMIC_ACQUIRE, "agent");
            xb_add(&bar[XB_XGEN(b.x)], 1u);
            asm volatile("s_waitcnt vmcnt(0)" ::: "memory");
        } else {
            XB_SPIN(xb_ld(&bar[XB_XGEN(b.x)]) == gen, bar);
            __builtin_amdgcn_fence(__ATOMIC_ACQUIRE, "agent");
            asm volatile("s_waitcnt vmcnt(0)" ::: "memory");
        }
    }
    __syncthreads();
}
constexpr int NWAVES = 8;
constexpr int DM = 1024, SEQ = 4096, NB = 8, NSB = 128, NST = 8, FF = 4096;
constexpr int MP = NB * SEQ;
constexpr int MS = NSB * NST;
constexpr int M = MP + MS;
constexpr int N_IN0 = 2304, N_IN1 = 2048;
constexpr float LN_EPS = 1e-5f;
constexpr float ALPHA = 1.4142135623730951f;
constexpr float LOG2E = 1.4426950408889634f;
constexpr float QS = 0.125f * LOG2E;
constexpr int NA_HIST = 128, ND_HIST = 2048;

constexpr size_t O_Y = 0, O_AKP = 34603008, O_AVP = 34734080, O_BCP = 34865152, O_CPP = 34873344, O_DKP = 34934784, O_DVP = 43323392,
                 O_AKS = 51712000, O_AVS = 53809152, O_BCS = 55906304, O_CPS = 56037376, O_DKS = 57020416, O_DVS = 191238144, O_TOTAL = 325455872;

constexpr size_t MiB = 1u << 20;
constexpr size_t WS_CTL = 0, CTL_ZERO_BYTES = 1 * MiB;
constexpr size_t WS_WIN0 = 2 * MiB, WS_WOUT0 = 8 * MiB, WS_W1_0 = 10 * MiB, WS_W2_0 = 18 * MiB, WS_WIN1 = 26 * MiB, WS_WOUT1 = 30 * MiB, WS_W1_1 = 32 * MiB, WS_W2_1 = 40 * MiB;
constexpr size_t WS_VEC = 48 * MiB;
constexpr int V_BIN0 = 0, V_CS1_0 = 4096, V_BW1_0 = 8192, V_CSIN1 = 12288, V_BWIN1 = 16384, V_CS1_1 = 20480, V_BW1_1 = 24576;
constexpr size_t WS_STA = 49 * MiB, WS_STB = 51 * MiB;
constexpr size_t WS_XB = 64 * MiB;
constexpr size_t WS_Q = 130 * MiB, WS_K = 163 * MiB, WS_V = 196 * MiB, WS_C = 229 * MiB, WS_GB = 262 * MiB;
constexpr size_t WS_MIX = 295 * MiB;
constexpr size_t WS_ZA = 361 * MiB, WS_ZB = 493 * MiB;
constexpr size_t WS_ZH = 625 * MiB;
constexpr size_t WS_H = 691 * MiB;
constexpr size_t WS_STO = 955 * MiB;
constexpr size_t WS_STML = 1021 * MiB;
constexpr size_t WS_END = 1024 * MiB;
constexpr int CW_BAR = 4096;

constexpr int RING_BYTES = 131072;
constexpr int LDSCTL_OFF = RING_BYTES, MISC_OFF = LDSCTL_OFF + 320;
constexpr int EPI_P_OFF = RING_BYTES + 1024;
constexpr int EPI_S_OFF = EPI_P_OFF + 8192;
constexpr int LDS_BYTES = 147456;
static_assert(EPI_S_OFF + 2048 <= LDS_BYTES, "LDS map");

typedef float f32x2v __attribute__((ext_vector_type(2)));
typedef unsigned u32x2v __attribute__((ext_vector_type(2)));
using pg8::bf16_t; using pg8::Unit; using pg8::u32x4;
#define EPI_BAR() do { asm volatile("s_waitcnt lgkmcnt(0)" ::: "memory"); __builtin_amdgcn_s_barrier(); asm volatile("" ::: "memory"); } while (0)

__device__ __forceinline__ u32x4 pack8(const f32x4 a, const f32x4 b) { u32x4 w; w.x = pg8::cvt_pk_bf16(a[0], a[1]); w.y = pg8::cvt_pk_bf16(a[2], a[3]); w.z = pg8::cvt_pk_bf16(b[0], b[1]); w.w = pg8::cvt_pk_bf16(b[2], b[3]); return w; }
__device__ __forceinline__ float bf2f(unsigned short h) { return __builtin_bit_cast(float, (unsigned)h << 16); }
__device__ __forceinline__ float bflo(unsigned w) { return __builtin_bit_cast(float, w << 16); }
__device__ __forceinline__ float bfhi(unsigned w) { return __builtin_bit_cast(float, w & 0xffff0000u); }

__device__ __forceinline__ void epi_load_stats(const float* slots, int pm, LAS unsigned char* lds, int tid) {
    LAS f32x2v* S = (LAS f32x2v*)(lds + EPI_S_OFF);
    if (tid < 256) {
        const f32x4* sp = (const f32x4*)(slots + (size_t)(pm * 256 + tid) * 8);
        const f32x4 a = sp[0], b = sp[1];
        const float mean = ((a[0] + a[2]) + (b[0] + b[2])) * 0.25f;
        const float d0 = a[0] - mean, d1 = a[2] - mean, d2 = b[0] - mean, d3 = b[2] - mean;
        const float q = ((a[1] + a[3]) + (b[1] + b[3])) + 256.0f * ((d0 * d0 + d1 * d1) + (d2 * d2 + d3 * d3));
        S[tid] = (f32x2v){mean, 1.0f / sqrtf(q * (1.0f / 1024.0f) + LN_EPS)};
    }
    EPI_BAR();
}
__device__ __forceinline__ void epi_row_stats(const f32x4 (&z)[2][2], LAS unsigned char* lds, int rl, int wc, int fq) {
    float s = 0.f;
#pragma unroll
    for (int bj = 0; bj < 2; ++bj)
#pragma unroll
        for (int n = 0; n < 2; ++n) s += (z[bj][n][0] + z[bj][n][1]) + (z[bj][n][2] + z[bj][n][3]);
    s += __shfl_xor(s, 16); s += __shfl_xor(s, 32);
    const float mw = s * (1.0f / 64.0f); float q = 0.f;
#pragma unroll
    for (int bj = 0; bj < 2; ++bj)
#pragma unroll
        for (int n = 0; n < 2; ++n) { const f32x4 d = z[bj][n] - mw; q += (d[0] * d[0] + d[1] * d[1]) + (d[2] * d[2] + d[3] * d[3]); }
    q += __shfl_xor(q, 16); q += __shfl_xor(q, 32);
    if (fq == 0) ((LAS f32x2v*)(lds + EPI_P_OFF))[rl * 4 + wc] = (f32x2v){mw, q};
}
__device__ __forceinline__ void epi_store_stats(float* slots, int pm, int pn, LAS unsigned char* lds, int tid) {
    if (tid < 256) {
        const LAS f32x2v* P = (const LAS f32x2v*)(lds + EPI_P_OFF) + tid * 4;
        const f32x2v a = P[0], b = P[1], c = P[2], d = P[3];
        const float mt = ((a.x + b.x) + (c.x + d.x)) * 0.25f;
        const float da = a.x - mt, db = b.x - mt, dc = c.x - mt, dd = d.x - mt;
        const float m2 = ((a.y + b.y) + (c.y + d.y)) + 64.0f * ((da * da + db * db) + (dc * dc + dd * dd));
        *(f32x2v*)(slots + (size_t)(pm * 256 + tid) * 8 + pn * 2) = (f32x2v){mt, m2};
    }
}


struct EpiIn0 {
    static constexpr bool PERM = true, AFTER_DRAIN = false;
    bf16_t *Q, *K, *V, *C, *GB; const float* bias; float* out;
    __device__ __forceinline__ void operator()(const f32x4 (&acc)[2][2][4][2], const Unit& u, int wr, int wc, int fr_in, int fq_in) const {
        int fr = fr_in, fq = fq_in; asm volatile("" : "+v"(fr), "+v"(fq));
        const int pn = u.pn, cc0 = wc * 32 + 8 * fq;
        f32x4 bv[2][2];
#pragma unroll
        for (int bj = 0; bj < 2; ++bj)
#pragma unroll
            for (int n = 0; n < 2; ++n) bv[bj][n] = *(const f32x4*)(bias + pn * 256 + bj * 128 + cc0 + 4 * n);
#pragma unroll
        for (int ai = 0; ai < 2; ++ai)
#pragma unroll
            for (int m = 0; m < 4; ++m) {
                const int row = u.pm * 256 + ai * 128 + wr * 64 + m * 16 + fr;
                f32x4 v[2][2];
#pragma unroll
                for (int bj = 0; bj < 2; ++bj)
#pragma unroll
                    for (int n = 0; n < 2; ++n) v[bj][n] = acc[ai][bj][m][n] + bv[bj][n];
                if (pn < 2) {
#pragma unroll
                    for (int bj = 0; bj < 2; ++bj) *(u32x4*)(Q + (size_t)row * 512 + pn * 256 + bj * 128 + cc0) = pack8(v[bj][0] * QS, v[bj][1] * QS);
                } else if (pn == 2) {
                    *(u32x4*)(K + (size_t)row * 128 + cc0) = pack8(v[0][0], v[0][1]);
                    *(u32x4*)(V + (size_t)row * 128 + cc0) = pack8(v[1][0], v[1][1]);
                    long o = -1;
                    if (row >= MP) { const int s = row - MP; o = (long)((s >> 3) * 128 + 120 + (s & 7)) * 128 + (long)(O_AKS - O_AKP); }
                    else { const int t = row & (SEQ - 1); if (t >= SEQ - 128) o = (long)((row >> 12) * 128 + t - (SEQ - 128)) * 128; }
                    if (o >= 0) {
                        float* ok = out + O_AKP + o + cc0; float* ov = ok + (row >= MP ? (O_AVS - O_AKS) : (O_AVP - O_AKP));
                        *(f32x4*)ok = v[0][0]; *(f32x4*)(ok + 4) = v[0][1]; *(f32x4*)ov = v[1][0]; *(f32x4*)(ov + 4) = v[1][1];
                    }
                } else if (pn < 7) {
                    const int p = pn - 3; const f32x4 c0 = v[0][0] * v[1][0], c1 = v[0][1] * v[1][1];
                    *(u32x4*)(C + (size_t)row * 512 + p * 128 + cc0) = pack8(c0, c1);
                    long o = -1;
                    if (row >= MP) { const int s = row - MP; if ((s & 7) >= 6) o = (long)((s >> 3) * 2 + (s & 7) - 6) * 512 + (long)(O_BCS - O_BCP); }
                    else { const int t = row & (SEQ - 1); if (t >= SEQ - 2) o = (long)((row >> 12) * 2 + t - (SEQ - 2)) * 512; }
                    if (o >= 0) { float* oc = out + O_BCP + o + p * 128 + cc0; *(f32x4*)oc = c0; *(f32x4*)(oc + 4) = c1; }
                } else {
#pragma unroll
                    for (int bj = 0; bj < 2; ++bj) *(u32x4*)(GB + (size_t)row * 512 + (pn - 7) * 256 + bj * 128 + cc0) = pack8(v[bj][0], v[bj][1]);
                }
            }
    }
};

struct EpiIn1 {
    static constexpr bool PERM = true, AFTER_DRAIN = false;
    bf16_t *U, *Q, *K, *V; const float *cs, *bw, *slots; float* out; LAS unsigned char* lds;
    __device__ __forceinline__ void operator()(const f32x4 (&acc)[2][2][4][2], const Unit& u, int wr, int wc, int fr_in, int fq_in) const {
        int fr = fr_in, fq = fq_in; asm volatile("" : "+v"(fr), "+v"(fq));
        const int pn = u.pn, cc0 = wc * 32 + 8 * fq, tid = threadIdx.x;
        epi_load_stats(slots, u.pm, lds, tid);
        const LAS f32x2v* S = (const LAS f32x2v*)(lds + EPI_S_OFF);
        f32x4 cv[2][2], bv[2][2];
#pragma unroll
        for (int bj = 0; bj < 2; ++bj)
#pragma unroll
            for (int n = 0; n < 2; ++n) { cv[bj][n] = *(const f32x4*)(cs + pn * 256 + bj * 128 + cc0 + 4 * n); bv[bj][n] = *(const f32x4*)(bw + pn * 256 + bj * 128 + cc0 + 4 * n); }
        const int sel = pn >> 1; bf16_t* dst = sel == 0 ? U : sel == 1 ? Q : sel == 2 ? K : V;
        const float sc = sel == 1 ? QS : 1.0f;
        const size_t obase = sel == 0 ? O_CPP : sel == 2 ? O_DKP : O_DVP;
#pragma unroll
        for (int ai = 0; ai < 2; ++ai)
#pragma unroll
            for (int m = 0; m < 4; ++m) {
                const int rl = ai * 128 + wr * 64 + m * 16 + fr, row = u.pm * 256 + rl;
                const f32x2v st = S[rl];
                f32x4 v[2][2];
#pragma unroll
                for (int bj = 0; bj < 2; ++bj)
#pragma unroll
                    for (int n = 0; n < 2; ++n) v[bj][n] = (acc[ai][bj][m][n] - cv[bj][n] * st.x) * st.y + bv[bj][n];
                const int c512 = (pn & 1) * 256 + cc0;
#pragma unroll
                for (int bj = 0; bj < 2; ++bj) *(u32x4*)(dst + (size_t)row * 512 + c512 + bj * 128) = pack8(v[bj][0] * sc, v[bj][1] * sc);
                if (sel != 1) {
                    long o = -1;
                    if (sel == 0) {
                        if (row >= MP) { const int s = row - MP; o = (long)((s >> 3) * 15 + 7 + (s & 7)) * 512 + (long)(O_CPS - O_CPP); }
                        else { const int t = row & (SEQ - 1); if (t >= SEQ - 15) o = (long)((row >> 12) * 15 + t - (SEQ - 15)) * 512; }
                    } else {
                        if (row >= MP) { const int s = row - MP; o = (long)((s >> 3) * 2048 + 2040 + (s & 7)) * 512 + (sel == 2 ? (long)(O_DKS - O_DKP) : (long)(O_DVS - O_DVP)); }
                        else { const int t = row & (SEQ - 1); if (t >= SEQ - 2048) o = (long)((row >> 12) * 2048 + t - (SEQ - 2048)) * 512; }
                    }
                    if (o >= 0) {
                        float* op = out + obase + o + c512;
#pragma unroll
                        for (int bj = 0; bj < 2; ++bj) { *(f32x4*)(op + bj * 128) = v[bj][0]; *(f32x4*)(op + bj * 128 + 4) = v[bj][1]; }
                    }
                }
            }
    }
};

struct EpiMlp1 {
    static constexpr bool PERM = true, AFTER_DRAIN = false;
    bf16_t* H; const float *cs, *bw, *slots; LAS unsigned char* lds;
    __device__ __forceinline__ void operator()(const f32x4 (&acc)[2][2][4][2], const Unit& u, int wr, int wc, int fr_in, int fq_in) const {
        int fr = fr_in, fq = fq_in; asm volatile("" : "+v"(fr), "+v"(fq));
        const int cc0 = u.pn * 256 + wc * 32 + 8 * fq, tid = threadIdx.x;
        epi_load_stats(slots, u.pm, lds, tid);
        const LAS f32x2v* S = (const LAS f32x2v*)(lds + EPI_S_OFF);
        f32x4 cv[2][2], bv[2][2];
#pragma unroll
        for (int bj = 0; bj < 2; ++bj)
#pragma unroll
            for (int n = 0; n < 2; ++n) { cv[bj][n] = *(const f32x4*)(cs + cc0 + bj * 128 + 4 * n); bv[bj][n] = *(const f32x4*)(bw + cc0 + bj * 128 + 4 * n); }
#pragma unroll
        for (int ai = 0; ai < 2; ++ai)
#pragma unroll
            for (int m = 0; m < 4; ++m) {
                const int rl = ai * 128 + wr * 64 + m * 16 + fr, row = u.pm * 256 + rl;
                const f32x2v st = S[rl];
#pragma unroll
                for (int bj = 0; bj < 2; ++bj) {
                    f32x4 v0 = (acc[ai][bj][m][0] - cv[bj][0] * st.x) * st.y + bv[bj][0], v1 = (acc[ai][bj][m][1] - cv[bj][1] * st.x) * st.y + bv[bj][1];
#pragma unroll
                    for (int e = 0; e < 4; ++e) { const float a = fmaxf(v0[e], 0.f), b = fmaxf(v1[e], 0.f); v0[e] = a * a; v1[e] = b * b; }
                    *(u32x4*)(H + (size_t)row * FF + cc0 + bj * 128) = pack8(v0, v1);
                }
            }
    }
};

template <bool LNRES, bool HAS_BIAS>
struct EpiRes {
    static constexpr bool PERM = true, AFTER_DRAIN = false;
    const float *xp, *xs;
    const float *zprev, *sprev, *g, *b;
    const float* bias; float* zout; bf16_t* zb; float* sout; LAS unsigned char* lds;
    __device__ __forceinline__ void operator()(const f32x4 (&acc)[2][2][4][2], const Unit& u, int wr, int wc, int fr_in, int fq_in) const {
        int fr = fr_in, fq = fq_in; asm volatile("" : "+v"(fr), "+v"(fq));
        const int col0 = u.pn * 256 + wc * 32 + 8 * fq, tid = threadIdx.x;
        if (LNRES) epi_load_stats(sprev, u.pm, lds, tid);
        const LAS f32x2v* S = (const LAS f32x2v*)(lds + EPI_S_OFF);
        f32x4 biv[2][2], gv[2][2], bv[2][2];
#pragma unroll
        for (int bj = 0; bj < 2; ++bj)
#pragma unroll
            for (int n = 0; n < 2; ++n) {
                const int c = col0 + bj * 128 + 4 * n;
                biv[bj][n] = HAS_BIAS ? *(const f32x4*)(bias + c) : (f32x4){0.f, 0.f, 0.f, 0.f};
                if (LNRES) { gv[bj][n] = *(const f32x4*)(g + c) * ALPHA; bv[bj][n] = *(const f32x4*)(b + c) * ALPHA + biv[bj][n]; }
            }
        const float* xin = LNRES ? zprev + (size_t)u.pm * 256 * DM : (u.pm < MP / 256 ? xp + (size_t)u.pm * 256 * DM : xs + (size_t)(u.pm - MP / 256) * 256 * DM);
#pragma unroll
        for (int ai = 0; ai < 2; ++ai)
#pragma unroll
            for (int m = 0; m < 4; ++m) {
                const int rl = ai * 128 + wr * 64 + m * 16 + fr; const size_t row = (size_t)u.pm * 256 + rl;
                f32x2v st = (f32x2v){0.f, 1.f}; if (LNRES) st = S[rl];
                f32x4 z[2][2];
#pragma unroll
                for (int bj = 0; bj < 2; ++bj)
#pragma unroll
                    for (int n = 0; n < 2; ++n) {
                        const f32x4 xv = *(const f32x4*)(xin + (size_t)rl * DM + col0 + bj * 128 + 4 * n);
                        if (LNRES) z[bj][n] = acc[ai][bj][m][n] + ((xv - st.x) * st.y) * gv[bj][n] + bv[bj][n];
                        else z[bj][n] = acc[ai][bj][m][n] + biv[bj][n] + xv * ALPHA;
                    }
#pragma unroll
                for (int bj = 0; bj < 2; ++bj) {
                    float* zo = zout + row * DM + col0 + bj * 128; *(f32x4*)zo = z[bj][0]; *(f32x4*)(zo + 4) = z[bj][1];
                    *(u32x4*)(zb + row * DM + col0 + bj * 128) = pack8(z[bj][0], z[bj][1]);
                }
                epi_row_stats(z, lds, rl, wc, fq);
                if (m & 1) asm volatile("" ::: "memory");
            }
        EPI_BAR();
        epi_store_stats(sout, u.pm, u.pn, lds, tid);
    }
};
struct Args { const float* in[26]; float* out; unsigned char* ws; };
struct Frame {
    LAS unsigned char* lds; gu32* ctl; int tid, lane, wave, vcu, G, gw, NGW;
};
__device__ __forceinline__ float wave_sum(float v) {
#pragma unroll
    for (int o = 1; o < 64; o <<= 1) v += __shfl_xor(v, o);
    return v;
}
__device__ __forceinline__ float wave_max(float v) {
#pragma unroll
    for (int o = 1; o < 64; o <<= 1) v = fmaxf(v, __shfl_xor(v, o));
    return v;
}

__device__ __forceinline__ void transpose_tile(const float* W, int ldw, int n0, int k0, const float* gk, bf16_t* WT, int ldt, int drow0, int kdst0, LAS float* scr, int lane) {
#pragma unroll 8
    for (int i = 0; i < 32; ++i) { const int kk = 2 * i + (lane >> 5); float w = W[(size_t)(k0 + kk) * ldw + n0 + (lane & 31)]; if (gk) w *= gk[k0 + kk]; scr[kk * 33 + (lane & 31)] = w; }
    LDS_WAIT(); asm volatile("" ::: "memory");
    const int c = lane & 7;
#pragma unroll
    for (int j = 0; j < 4; ++j) { const int n = (lane >> 3) + 8 * j; const LAS float* s = scr + (8 * c) * 33 + n;
        v4u o; o.x = pk2(s[0 * 33], s[1 * 33]); o.y = pk2(s[2 * 33], s[3 * 33]); o.z = pk2(s[4 * 33], s[5 * 33]); o.w = pk2(s[6 * 33], s[7 * 33]);
        *(GAS v4u*)(WT + (size_t)(drow0 + n) * ldt + kdst0 + k0 + 8 * c) = o; }
    LDS_WAIT(); asm volatile("" ::: "memory");
}
__device__ __forceinline__ int in0_src_col(int np) {
    if (np < 768) return np;
    if (np < 1792) { const int tt = np - 768, p = tt >> 8, w = tt & 255; return w < 128 ? 768 + 128 * p + w : 1792 + 128 * p + (w - 128); }
    return 1280 + (np - 1792);
}
__device__ __forceinline__ void colsum_item(const float* W, int K, int N, const float* g, const float* b, const float* bias, float* cs, float* bw, int item, int lane) {
    const int n = item * 16 + (lane & 15), kq = lane >> 4, kn = K / 4;
    float a = 0.f, c = 0.f;
    for (int k = kq * kn; k < (kq + 1) * kn; ++k) { const float w = W[(size_t)k * N + n]; a += __builtin_bit_cast(float, f2bf(g[k] * w) << 16); c += b[k] * w; }
    a += __shfl_xor(a, 16); a += __shfl_xor(a, 32); c += __shfl_xor(c, 16); c += __shfl_xor(c, 32);
    if (lane < 16) { cs[n] = a; bw[n] = c + (bias ? bias[n] : 0.f); }
}
__device__ __forceinline__ void poolfold_item(const float* Wg, const float* scale, const float* Wo, bf16_t* WT, int item, int lane) {
    const int nb = item & 15, ib = (item >> 4) & 15, g = item >> 8, n = nb * 64 + lane, i0 = ib * 8;
    float acc[8];
#pragma unroll
    for (int ii = 0; ii < 8; ++ii) acc[ii] = 0.f;
    const float* wg = Wg + (size_t)g * 128 * 128 + (size_t)i0 * 128;
    for (int j = 0; j < 128; ++j) {
        const float w = scale[128 * g + j] * Wo[(size_t)(128 * g + j) * DM + n];
#pragma unroll
        for (int ii = 0; ii < 8; ++ii) acc[ii] += wg[ii * 128 + j] * w;
    }
    v4u o; o.x = pk2(acc[0], acc[1]); o.y = pk2(acc[2], acc[3]); o.z = pk2(acc[4], acc[5]); o.w = pk2(acc[6], acc[7]);
    *(GAS v4u*)(WT + (size_t)n * DM + 128 * g + i0) = o;
}
template <int BP, int SKIP>
__device__ __forceinline__ void copy_shift(const Frame& F, const float* src, float* dst, int nbatch) {
    const GAS f32x4* s = (const GAS f32x4*)src; GAS f32x4* d = (GAS f32x4*)dst;
    constexpr int PER = BP - SKIP;
    const size_t total = (size_t)nbatch * PER, stride = (size_t)F.NGW * 64;
    size_t i = (size_t)F.gw * 64 + F.lane;
#define CS_IDX(ii, si, di) const size_t b_##si = (ii) / PER, r_##si = (ii) - b_##si * PER, si = b_##si * BP + SKIP + r_##si, di = b_##si * BP + r_##si
    for (; i + 3 * stride < total; i += 4 * stride) {
        CS_IDX(i, s0, d0); CS_IDX(i + stride, s1, d1); CS_IDX(i + 2 * stride, s2, d2); CS_IDX(i + 3 * stride, s3, d3);
        const f32x4 a = __builtin_nontemporal_load(s + s0), b = __builtin_nontemporal_load(s + s1), c = __builtin_nontemporal_load(s + s2), e = __builtin_nontemporal_load(s + s3);
        __builtin_nontemporal_store(a, d + d0); __builtin_nontemporal_store(b, d + d1); __builtin_nontemporal_store(c, d + d2); __builtin_nontemporal_store(e, d + d3);
    }
    for (; i < total; i += stride) { CS_IDX(i, s0, d0); __builtin_nontemporal_store(__builtin_nontemporal_load(s + s0), d + d0); }
#undef CS_IDX
}

__device__ __forceinline__ void p0_prologue(const Frame& F, const Args& A) {
    unsigned char* ws = A.ws;
    LAS float* scr = (LAS float*)(F.lds + F.wave * 16384);
    float* vec = (float*)(ws + WS_VEC);
    const int lane = F.lane;
    constexpr int T_IN0 = 16 * 72, T_OUT0 = 16 * 32, T_W1 = 16 * 128, T_W2 = 64 * 32, T_IN1 = 16 * 64, T_OUT1 = 8 * 32;
    constexpr int NT = T_IN0 + T_OUT0 + 2 * T_W1 + 2 * T_W2 + T_IN1 + T_OUT1;
    for (int it = F.gw; it < NT; it += F.NGW) {
        int r = it;
        if (r < T_IN0) { const int kb = r / 72, nb = r % 72; transpose_tile(A.in[8], N_IN0, in0_src_col(32 * nb), 64 * kb, nullptr, (bf16_t*)(ws + WS_WIN0), DM, 32 * nb, 0, scr, lane); continue; } r -= T_IN0;
        if (r < T_OUT0) { const int kb = r / 32, nb = r % 32; transpose_tile(A.in[12], DM, 32 * nb, 64 * kb, nullptr, (bf16_t*)(ws + WS_WOUT0), DM, 32 * nb, 0, scr, lane); continue; } r -= T_OUT0;
        if (r < 2 * T_W1) { const int L = r / T_W1; r %= T_W1; const int kb = r / 128, nb = r % 128;
            transpose_tile(A.in[20] + (size_t)L * DM * FF, FF, 32 * nb, 64 * kb, A.in[22] + L * DM, (bf16_t*)(ws + (L ? WS_W1_1 : WS_W1_0)), DM, 32 * nb, 0, scr, lane); continue; } r -= 2 * T_W1;
        if (r < 2 * T_W2) { const int L = r / T_W2; r %= T_W2; const int kb = r / 32, nb = r % 32;
            transpose_tile(A.in[21] + (size_t)L * FF * DM, DM, 32 * nb, 64 * kb, nullptr, (bf16_t*)(ws + (L ? WS_W2_1 : WS_W2_0)), FF, 32 * nb, 0, scr, lane); continue; } r -= 2 * T_W2;
        if (r < T_IN1) { const int kb = r / 64, nb = r % 64; transpose_tile(A.in[14], N_IN1, 32 * nb, 64 * kb, A.in[24], (bf16_t*)(ws + WS_WIN1), DM, 32 * nb, 0, scr, lane); continue; } r -= T_IN1;
        { const int kb = r / 32, nb = r % 32; transpose_tile(A.in[18] + (size_t)512 * DM, DM, 32 * nb, 64 * kb, nullptr, (bf16_t*)(ws + WS_WOUT1), DM, 32 * nb, 512, scr, lane); }
    }
    for (int it = F.gw; it < 1024; it += F.NGW) poolfold_item(A.in[16], A.in[17], A.in[18], (bf16_t*)(ws + WS_WOUT1), it, lane);
    for (int it = F.gw; it < 640; it += F.NGW) {
        if (it < 256) colsum_item(A.in[20], DM, FF, A.in[22], A.in[23], nullptr, vec + V_CS1_0, vec + V_BW1_0, it, lane);
        else if (it < 512) colsum_item(A.in[20] + (size_t)DM * FF, DM, FF, A.in[22] + DM, A.in[23] + DM, nullptr, vec + V_CS1_1, vec + V_BW1_1, it - 256, lane);
        else colsum_item(A.in[14], DM, N_IN1, A.in[24], A.in[25], A.in[15], vec + V_CSIN1, vec + V_BWIN1, it - 512, lane);
    }
    for (int i = F.gw * 64 + lane; i < N_IN0; i += F.NGW * 64) vec[V_BIN0 + i] = A.in[9][in0_src_col(i)];
    for (int m = F.gw; m < M; m += F.NGW) {
        const float* xr = m < MP ? A.in[0] + (size_t)m * DM : A.in[1] + (size_t)(m - MP) * DM;
        const GAS f32x4* x4 = (const GAS f32x4*)xr + lane; GAS u32x2v* o = (GAS u32x2v*)((bf16_t*)(ws + WS_XB) + (size_t)m * DM) + lane;
#pragma unroll
        for (int j = 0; j < 4; ++j) { const f32x4 v = x4[64 * j]; u32x2v w; w.x = pk2(v[0], v[1]); w.y = pk2(v[2], v[3]); o[64 * j] = w; }
    }
    copy_shift<ND_HIST * 128, NST * 128>(F, A.in[6], A.out + O_DKS, NSB);
    copy_shift<ND_HIST * 128, NST * 128>(F, A.in[7], A.out + O_DVS, NSB);
    copy_shift<NA_HIST * 32, NST * 32>(F, A.in[2], A.out + O_AKS, NSB);
    copy_shift<NA_HIST * 32, NST * 32>(F, A.in[3], A.out + O_AVS, NSB);
    copy_shift<15 * 128, NST * 128>(F, A.in[5], A.out + O_CPS, NSB);
}
typedef float f32x16 __attribute__((ext_vector_type(16)));
typedef short s16x4 __attribute__((ext_vector_type(4)));
typedef short v4i16_t __attribute__((ext_vector_type(4)));
using pg8::bf16x8;
constexpr int VROW = 192;
constexpr int VIMG = 32 * VROW;
__device__ __forceinline__ s16x4 vtr(LAS const unsigned char* p) { return __builtin_bit_cast(s16x4, __builtin_amdgcn_ds_read_tr16_b64_v4i16((LAS v4i16_t*)p)); }
__device__ __forceinline__ unsigned cvtpk(float lo, float hi) { return pg8::cvt_pk_bf16(lo, hi); }

struct AttnCfg {
    const bf16_t *Q, *K, *V; int qpitch, kvpitch;
    long rowbase;
    int i0, dl; float sl2;
    float* st_o; float* st_ml;
    bf16_t* out; int opitch; float sink2;
};
template <bool LOADST, bool FINAL, bool SINK>
__device__ __forceinline__ void attn_item(const AttnCfg& c, LAS unsigned char* vimg, int lane) {
    const int qi = lane & 31, hh = lane >> 5;
    const long qrow = c.rowbase + (long)c.dl * (c.i0 + qi);
    bf16x8 qf[4];
#pragma unroll
    for (int kk = 0; kk < 4; ++kk) qf[kk] = *(const bf16x8*)(c.Q + qrow * c.qpitch + 16 * kk + 8 * hh);
    float m, l; f32x16 o[2];
    if (LOADST) {
        const float* so = c.st_o + qrow * 512; const f32x2v ml = *(const f32x2v*)(c.st_ml + qrow * 16);
        m = ml.x; l = hh == 0 ? ml.y : 0.f;
#pragma unroll
        for (int cb = 0; cb < 2; ++cb)
#pragma unroll
            for (int g = 0; g < 4; ++g) { const f32x4 t = *(const f32x4*)(so + 32 * cb + 8 * g + 4 * hh); o[cb][4 * g] = t[0]; o[cb][4 * g + 1] = t[1]; o[cb][4 * g + 2] = t[2]; o[cb][4 * g + 3] = t[3]; }
    } else {
        m = -INFINITY; l = 0.f;
#pragma unroll
        for (int r = 0; r < 16; ++r) { o[0][r] = 0.f; o[1][r] = 0.f; }
    }
    const int blk = (lane >> 4) & 1, tq = (lane & 15) >> 2, tp = lane & 3;
    LAS const unsigned char* vrd = vimg + (4 * hh + tq) * VROW + (16 * blk + 4 * tp) * 2;
    LAS unsigned char* vwr = vimg + (lane >> 3) * VROW + (lane & 7) * 16;
    const int ktmin = c.i0 >= 97 ? 0 : (128 - c.i0) / 32;
    bf16x8 kf[4]; u32x4 vv[4];
#define ATT_LOAD(KT, KF, VV) do { const int pk0_ = c.i0 - 128 + 32 * (KT); const int pk_ = pk0_ + qi; const long krow_ = c.rowbase + (long)c.dl * (pk_ < 0 ? 0 : pk_); \
        _Pragma("unroll") for (int kk = 0; kk < 4; ++kk) KF[kk] = *(const bf16x8*)(c.K + krow_ * c.kvpitch + 16 * kk + 8 * hh); \
        _Pragma("unroll") for (int i = 0; i < 4; ++i) { const int pv_ = pk0_ + (lane >> 3) + 8 * i; const long vrow_ = c.rowbase + (long)c.dl * (pv_ < 0 ? 0 : pv_); \
            VV[i] = *(const u32x4*)(c.V + vrow_ * c.kvpitch + 8 * (lane & 7)); } } while (0)
    ATT_LOAD(4, kf, vv);
    for (int kt = 4; kt >= ktmin; --kt) {
        const int pk0 = c.i0 - 128 + 32 * kt;
        bf16x8 kn[4]; u32x4 vn[4];
#pragma unroll
        for (int kk = 0; kk < 4; ++kk) { kn[kk] = kf[kk]; vn[kk] = vv[kk]; }
        if (kt > ktmin) ATT_LOAD(kt - 1, kn, vn);
        {
          f32x16 s;
#pragma unroll
          for (int r = 0; r < 16; ++r) s[r] = 0.f;
#pragma unroll
          for (int kk = 0; kk < 4; ++kk) s = __builtin_amdgcn_mfma_f32_32x32x16_bf16(kf[kk], qf[kk], s, 0, 0, 0);
          asm volatile("" ::: "memory");
#pragma unroll
          for (int i = 0; i < 4; ++i) *(LAS u32x4*)(vwr + 8 * i * VROW) = vv[i];
          const int dq = qi + 128 - 32 * kt;
          float tmax = -INFINITY;
#pragma unroll
          for (int r = 0; r < 16; ++r) { const int ko = (r & 3) + 8 * (r >> 2) + 4 * hh, dist = dq - ko;
              const bool ok = (dist >= 0) & (dist <= 128) & (pk0 + ko >= 0);
              const float v = ok ? s[r] - c.sl2 * (float)dist : -INFINITY; s[r] = v; tmax = fmaxf(tmax, v); }
          tmax = fmaxf(tmax, __shfl_xor(tmax, 32));
          const float mnew = fmaxf(m, tmax), scl = __builtin_amdgcn_exp2f(m - mnew);
          m = mnew; l *= scl;
#pragma unroll
          for (int r = 0; r < 16; ++r) { o[0][r] *= scl; o[1][r] *= scl; }
          float ps = 0.f;
#pragma unroll
          for (int r = 0; r < 16; ++r) { s[r] = __builtin_amdgcn_exp2f(s[r] - mnew); ps += s[r]; }
          l += ps;
          u32x4 pw0, pw1;
          pw0.x = cvtpk(s[0], s[1]); pw0.y = cvtpk(s[2], s[3]); pw0.z = cvtpk(s[4], s[5]); pw0.w = cvtpk(s[6], s[7]);
          pw1.x = cvtpk(s[8], s[9]); pw1.y = cvtpk(s[10], s[11]); pw1.z = cvtpk(s[12], s[13]); pw1.w = cvtpk(s[14], s[15]);
          const bf16x8 pf0 = __builtin_bit_cast(bf16x8, pw0), pf1 = __builtin_bit_cast(bf16x8, pw1);
          asm volatile("s_waitcnt lgkmcnt(0)" ::: "memory");
#pragma unroll
          for (int cb = 0; cb < 2; ++cb) {
              const s16x4 a0 = vtr(vrd + (0) * VROW + cb * 64), a1 = vtr(vrd + (8) * VROW + cb * 64), b0 = vtr(vrd + (16) * VROW + cb * 64), b1 = vtr(vrd + (24) * VROW + cb * 64);
              const bf16x8 vf0 = (bf16x8){a0[0], a0[1], a0[2], a0[3], a1[0], a1[1], a1[2], a1[3]}, vf1 = (bf16x8){b0[0], b0[1], b0[2], b0[3], b1[0], b1[1], b1[2], b1[3]};
              o[cb] = __builtin_amdgcn_mfma_f32_32x32x16_bf16(vf0, pf0, o[cb], 0, 0, 0);
              o[cb] = __builtin_amdgcn_mfma_f32_32x32x16_bf16(vf1, pf1, o[cb], 0, 0, 0);
          }
          asm volatile("s_waitcnt lgkmcnt(0)" ::: "memory");
        }
#pragma unroll
        for (int kk = 0; kk < 4; ++kk) { kf[kk] = kn[kk]; vv[kk] = vn[kk]; }
    }
#undef ATT_LOAD
    float lt = l + __shfl_xor(l, 32);
    if (FINAL) {
        if (SINK) lt += __builtin_amdgcn_exp2f(c.sink2 - m);
        const float inv = 1.0f / lt;
        bf16_t* op = c.out + qrow * c.opitch;
#pragma unroll
        for (int cb = 0; cb < 2; ++cb)
#pragma unroll
            for (int g = 0; g < 4; ++g) { u32x2v w; w.x = cvtpk(o[cb][4 * g] * inv, o[cb][4 * g + 1] * inv); w.y = cvtpk(o[cb][4 * g + 2] * inv, o[cb][4 * g + 3] * inv);
                *(u32x2v*)(op + 32 * cb + 8 * g + 4 * hh) = w; }
    } else {
        float* so = c.st_o + qrow * 512;
#pragma unroll
        for (int cb = 0; cb < 2; ++cb)
#pragma unroll
            for (int g = 0; g < 4; ++g) *(f32x4*)(so + 32 * cb + 8 * g + 4 * hh) = (f32x4){o[cb][4 * g], o[cb][4 * g + 1], o[cb][4 * g + 2], o[cb][4 * g + 3]};
        if (hh == 0) *(f32x2v*)(c.st_ml + qrow * 16) = (f32x2v){m, lt};
    }
}

struct SAttnCfg {
    const bf16_t* q;
    const float *kc, *vc; int cpitch;
    const bf16_t *kn, *vn; int npitch;
    int nh, i, dl; float sl2;
};
template <bool SINK>
__device__ __forceinline__ void sattn_item(const SAttnCfg& c, float sink2, bf16_t* out, float& m_io, float& l_io, f32x4& o_io, bool first, bool last, int lane) {
    int qd = lane >> 4; const int sub = lane & 15;
    asm volatile("" : "+v"(qd));
    f32x4 qv; { const u32x2v w = *(const u32x2v*)(c.q + 4 * sub); qv = (f32x4){bflo(w.x), bfhi(w.x), bflo(w.y), bfhi(w.y)}; }
    float sc[33];
#pragma unroll
    for (int it = 0; it < 33; ++it) {
        const int j = 4 * it + qd, row = c.nh + c.i - j * c.dl;
        f32x4 kv = (f32x4){0.f, 0.f, 0.f, 0.f};
        if (j <= 128) {
            if (row >= c.nh) { const u32x2v w = *(const u32x2v*)(c.kn + (size_t)(row - c.nh) * c.npitch + 4 * sub); kv = (f32x4){bflo(w.x), bfhi(w.x), bflo(w.y), bfhi(w.y)}; }
            else kv = *(const f32x4*)(c.kc + (size_t)row * c.cpitch + 4 * sub);
        }
        float d = (qv[0] * kv[0] + qv[1] * kv[1]) + (qv[2] * kv[2] + qv[3] * kv[3]);
        d += __shfl_xor(d, 1); d += __shfl_xor(d, 2); d += __shfl_xor(d, 4); d += __shfl_xor(d, 8);
        sc[it] = j <= 128 ? d - c.sl2 * (float)j : -INFINITY;
        if (it % 11 == 10) asm volatile("" ::: "memory");
    }
    float tm = sc[0];
#pragma unroll
    for (int it = 1; it < 33; ++it) tm = fmaxf(tm, sc[it]);
    tm = fmaxf(tm, __shfl_xor(tm, 16)); tm = fmaxf(tm, __shfl_xor(tm, 32));
    float m = first ? tm : fmaxf(m_io, tm);
    const float scl = first ? 0.f : __builtin_amdgcn_exp2f(m_io - m);
    float l = first ? 0.f : l_io * scl; f32x4 o = first ? (f32x4){0.f, 0.f, 0.f, 0.f} : o_io * scl;
    float ps = 0.f; f32x4 oa = (f32x4){0.f, 0.f, 0.f, 0.f};
#pragma unroll
    for (int it = 0; it < 33; ++it) {
        const int j = 4 * it + qd, row = c.nh + c.i - j * c.dl;
        const float p = __builtin_amdgcn_exp2f(sc[it] - m);
        f32x4 vv = (f32x4){0.f, 0.f, 0.f, 0.f};
        if (j <= 128) {
            if (row >= c.nh) { const u32x2v w = *(const u32x2v*)(c.vn + (size_t)(row - c.nh) * c.npitch + 4 * sub); vv = (f32x4){bflo(w.x), bfhi(w.x), bflo(w.y), bfhi(w.y)}; }
            else vv = *(const f32x4*)(c.vc + (size_t)row * c.cpitch + 4 * sub);
        }
        ps += p; oa += vv * p;
        if (it % 11 == 10) asm volatile("" ::: "memory");
    }
    ps += __shfl_xor(ps, 16); ps += __shfl_xor(ps, 32);
#pragma unroll
    for (int e = 0; e < 4; ++e) { float t = oa[e]; t += __shfl_xor(t, 16); t += __shfl_xor(t, 32); oa[e] = t; }
    l += ps; o += oa;
    if (last) {
        if (SINK) l += __builtin_amdgcn_exp2f(sink2 - m);
        const float inv = 1.0f / l;
        if (qd == 0) { u32x2v w; w.x = cvtpk(o[0] * inv, o[1] * inv); w.y = cvtpk(o[2] * inv, o[3] * inv); *(u32x2v*)(out + 4 * sub) = w; }
    }
    m_io = m; l_io = l; o_io = o;
}
__device__ __forceinline__ void ld8(const bf16_t* p, float (&v)[8]) { const u32x4 w = *(const u32x4*)p; v[0] = bflo(w.x); v[1] = bfhi(w.x); v[2] = bflo(w.y); v[3] = bfhi(w.y); v[4] = bflo(w.z); v[5] = bfhi(w.z); v[6] = bflo(w.w); v[7] = bfhi(w.w); }
__device__ __forceinline__ void ld8f(const float* p, float (&v)[8]) { const f32x4 a = *(const f32x4*)p, b = *(const f32x4*)(p + 4); v[0] = a[0]; v[1] = a[1]; v[2] = a[2]; v[3] = a[3]; v[4] = b[0]; v[5] = b[1]; v[6] = b[2]; v[7] = b[3]; }
__device__ __forceinline__ void st8(bf16_t* p, const float (&v)[8]) { u32x4 w; w.x = cvtpk(v[0], v[1]); w.y = cvtpk(v[2], v[3]); w.z = cvtpk(v[4], v[5]); w.w = cvtpk(v[6], v[7]); *(u32x4*)p = w; }
__device__ __forceinline__ void conv_item(const Args& A, int item, int lane) {
    unsigned char* ws = A.ws; const bf16_t* C = (const bf16_t*)(ws + WS_C); const bf16_t* GB = (const bf16_t*)(ws + WS_GB); bf16_t* MIX = (bf16_t*)(ws + WS_MIX);
    const int c0 = 8 * lane;
    float w0[8], w1[8], w2[8], cm2[8], cm1[8];
    ld8f(A.in[11] + c0, w0); ld8f(A.in[11] + 512 + c0, w1); ld8f(A.in[11] + 1024 + c0, w2);
    long row0; int nrow;
    if (item < 1024) {
        const int b = item >> 7, t0 = (item & 127) * 32; row0 = (long)b * SEQ + t0; nrow = 32;
        if (t0 == 0) {
#pragma unroll
            for (int e = 0; e < 8; ++e) { cm2[e] = 0.f; cm1[e] = 0.f; }
        } else { ld8(C + (row0 - 2) * 512 + c0, cm2); ld8(C + (row0 - 1) * 512 + c0, cm1); }
    } else {
        const int b = item - 1024; row0 = MP + (long)b * NST; nrow = NST;
        ld8f(A.in[4] + (size_t)(b * 2 + 0) * 512 + c0, cm2); ld8f(A.in[4] + (size_t)(b * 2 + 1) * 512 + c0, cm1);
    }
    for (int t = 0; t < nrow; ++t) {
        float cc[8], gb[8], y[8];
        ld8(C + (row0 + t) * 512 + c0, cc); ld8(GB + (row0 + t) * 512 + c0, gb);
#pragma unroll
        for (int e = 0; e < 8; ++e) { y[e] = gb[e] * (w0[e] * cm2[e] + w1[e] * cm1[e] + w2[e] * cc[e]); cm2[e] = cm1[e]; cm1[e] = cc[e]; }
        st8(MIX + (row0 + t) * DM + 512 + c0, y);
    }
}

__device__ __forceinline__ void pool_item(const Args& A, int item, int lane) {
    unsigned char* ws = A.ws; const bf16_t* U = (const bf16_t*)(ws + WS_C); bf16_t* MIX = (bf16_t*)(ws + WS_MIX);
    const int c0 = 8 * lane, w = 2 << (lane >> 4);
    if (item < 1024) {
        const int b = item >> 7, t0 = (item & 127) * 32; const long rb = (long)b * SEQ;
        float S[8];
#pragma unroll
        for (int e = 0; e < 8; ++e) S[e] = 0.f;
        for (int k = 1; k < w; ++k) { const int t = t0 - k; if (t >= 0) { float u[8]; ld8(U + (rb + t) * 512 + c0, u);
#pragma unroll
            for (int e = 0; e < 8; ++e) S[e] += u[e]; } }
        for (int t = t0; t < t0 + 32; ++t) {
            float u[8], y[8]; ld8(U + (rb + t) * 512 + c0, u);
            const float inv = 1.0f / (float)(t + 1 < w ? t + 1 : w);
#pragma unroll
            for (int e = 0; e < 8; ++e) { S[e] += u[e]; y[e] = S[e] * inv - u[e]; }
            st8(MIX + (rb + t) * DM + c0, y);
            if (t - w + 1 >= 0) { float o[8]; ld8(U + (rb + t - w + 1) * 512 + c0, o);
#pragma unroll
                for (int e = 0; e < 8; ++e) S[e] -= o[e]; }
        }
    } else {
        const int b = item - 1024; const long rb = MP + (long)b * NST; const float inv = 1.0f / (float)w;
        for (int i = 0; i < NST; ++i) {
            float S[8], ui[8], y[8];
#pragma unroll
            for (int e = 0; e < 8; ++e) S[e] = 0.f;
            for (int k = 0; k < w; ++k) { const int idx = 15 + i - k; float u[8];
                if (idx >= 15) ld8(U + (rb + idx - 15) * 512 + c0, u); else ld8f(A.in[5] + ((size_t)b * 15 + idx) * 512 + c0, u);
#pragma unroll
                for (int e = 0; e < 8; ++e) S[e] += u[e]; }
            ld8(U + (rb + i) * 512 + c0, ui);
#pragma unroll
            for (int e = 0; e < 8; ++e) y[e] = S[e] * inv - ui[e];
            st8(MIX + (rb + i) * DM + c0, y);
        }
    }
}

__device__ __forceinline__ float alibi_slope(int h) { return __builtin_amdgcn_exp2f(-(float)(h + 1)); }

__device__ __forceinline__ void mixer0(const Frame& F, const Args& A) {
    unsigned char* ws = A.ws; const int lane = F.lane;
    const bf16_t* Q = (const bf16_t*)(ws + WS_Q); const bf16_t* K = (const bf16_t*)(ws + WS_K); const bf16_t* V = (const bf16_t*)(ws + WS_V); bf16_t* MIX = (bf16_t*)(ws + WS_MIX);
    LAS unsigned char* vimg = F.lds + F.wave * VIMG;
#ifndef NO_M0_ATT
    for (int un = blockIdx.x; un < 512; un += F.G) {
        const int kvh = un & 1, ch = (un >> 1) & 31, b = un >> 6;
#pragma unroll 1
        for (int k = 0; k < 2; ++k) {
            const int it = F.wave * 2 + k, g = it >> 2, qt = it & 3, h = kvh * 4 + g;
            AttnCfg c; c.Q = Q + h * 64; c.K = K + kvh * 64; c.V = V + kvh * 64; c.qpitch = 512; c.kvpitch = 128; c.rowbase = (long)b * SEQ; c.i0 = ch * 128 + qt * 32; c.dl = 1;
            c.sl2 = alibi_slope(h) * LOG2E; c.st_o = nullptr; c.st_ml = nullptr; c.out = MIX + h * 64; c.opitch = DM; c.sink2 = A.in[10][h] * LOG2E;
            attn_item<false, true, true>(c, vimg, lane);
        }
    }
#endif
#ifndef NO_M0_CONV
    for (int it = F.gw; it < 1024 + NSB; it += F.NGW) conv_item(A, it, lane);
#endif
#ifndef NO_M0_SATT
    for (int it = F.gw; it < NSB * 8 * NST; it += F.NGW) {
        const int i = it & 7, h = (it >> 3) & 7, b = it >> 6, kvh = h >> 2; const long row = MP + (long)b * NST;
        SAttnCfg c; c.q = Q + (row + i) * 512 + h * 64; c.kc = A.in[2] + (size_t)b * NA_HIST * 128 + kvh * 64; c.vc = A.in[3] + (size_t)b * NA_HIST * 128 + kvh * 64; c.cpitch = 128;
        c.kn = K + row * 128 + kvh * 64; c.vn = V + row * 128 + kvh * 64; c.npitch = 128; c.nh = NA_HIST; c.i = i; c.dl = 1; c.sl2 = alibi_slope(h) * LOG2E;
        float m = 0.f, l = 0.f; f32x4 o = (f32x4){0.f, 0.f, 0.f, 0.f};
        sattn_item<true>(c, A.in[10][h] * LOG2E, MIX + (row + i) * DM + h * 64, m, l, o, true, true, lane);
    }
#endif
}

__device__ __forceinline__ void mixer1(const Frame& F, const Args& A) {
    unsigned char* ws = A.ws; const int lane = F.lane;
    const bf16_t* Q = (const bf16_t*)(ws + WS_Q); const bf16_t* K = (const bf16_t*)(ws + WS_K); const bf16_t* V = (const bf16_t*)(ws + WS_V); bf16_t* MIX = (bf16_t*)(ws + WS_MIX);
    float* STO = (float*)(ws + WS_STO); float* STML = (float*)(ws + WS_STML);
    LAS unsigned char* vimg = F.lds + F.wave * VIMG;
    for (int un = blockIdx.x; un < 512; un += F.G) {
        const int h = un & 7, ch = (un >> 3) & 7, b = un >> 6, T0 = ch * 512;
#pragma unroll 1
        for (int br = 0; br < 3; ++br) {
            const int dl = br == 0 ? 16 : br == 1 ? 4 : 1;
#pragma unroll 1
            for (int k = 0; k < 2; ++k) {
                const int it = F.wave * 2 + k;
                int r, i0; if (br == 0) { r = it; i0 = T0 / 16; } else if (br == 1) { r = it & 3; i0 = T0 / 4 + 32 * (it >> 2); } else { r = 0; i0 = T0 + 32 * it; }
                AttnCfg c; c.Q = Q + h * 64; c.K = K + h * 64; c.V = V + h * 64; c.qpitch = 512; c.kvpitch = 512; c.rowbase = (long)b * SEQ + r; c.i0 = i0; c.dl = dl;
                c.sl2 = alibi_slope(h) * (float)dl * LOG2E; c.st_o = STO + h * 64; c.st_ml = STML + h * 2; c.out = MIX + 512 + h * 64; c.opitch = DM; c.sink2 = 0.f;
                if (br == 0) attn_item<false, false, false>(c, vimg, lane);
                else if (br == 1) attn_item<true, false, false>(c, vimg, lane);
                else attn_item<true, true, false>(c, vimg, lane);
            }
            if (br < 2) { __syncthreads(); __builtin_amdgcn_fence(__ATOMIC_ACQUIRE, "agent"); asm volatile("s_waitcnt vmcnt(0)" ::: "memory"); }
        }
    }
    for (int it = F.gw; it < 1024 + NSB; it += F.NGW) pool_item(A, it, lane);
    for (int it = F.gw; it < NSB * 8 * NST; it += F.NGW) {
        const int i = it & 7, h = (it >> 3) & 7, b = it >> 6; const long row = MP + (long)b * NST;
        SAttnCfg c; c.q = Q + (row + i) * 512 + h * 64; c.kc = A.in[6] + (size_t)b * ND_HIST * 512 + h * 64; c.vc = A.in[7] + (size_t)b * ND_HIST * 512 + h * 64; c.cpitch = 512;
        c.kn = K + row * 512 + h * 64; c.vn = V + row * 512 + h * 64; c.npitch = 512; c.nh = ND_HIST; c.i = i;
        float m = 0.f, l = 0.f; f32x4 o = (f32x4){0.f, 0.f, 0.f, 0.f};
#pragma unroll 1
        for (int br = 0; br < 3; ++br) {
            c.dl = br == 0 ? 1 : br == 1 ? 4 : 16; c.sl2 = alibi_slope(h) * (float)c.dl * LOG2E;
            sattn_item<false>(c, 0.f, MIX + (row + i) * DM + 512 + h * 64, m, l, o, br == 0, br == 2, lane);
        }
    }
}

__device__ __forceinline__ void final_ln(const Frame& F, const Args& A) {
    const float* g = A.in[24] + DM; const float* bb = A.in[25] + DM;
    f32x4 gv[4], bv[4];
#pragma unroll
    for (int j = 0; j < 4; ++j) { gv[j] = ((const f32x4*)g)[F.lane + 64 * j]; bv[j] = ((const f32x4*)bb)[F.lane + 64 * j]; }
    for (int m = F.gw; m < M; m += F.NGW) {
        GAS f32x4* xr = (GAS f32x4*)(A.out + O_Y + (size_t)m * DM) + F.lane;
        f32x4 v[4]; float s = 0.f;
#pragma unroll
        for (int j = 0; j < 4; ++j) { v[j] = xr[64 * j]; s += (v[j][0] + v[j][1]) + (v[j][2] + v[j][3]); }
        const float mean = wave_sum(s) * (1.f / DM); float s2 = 0.f;
#pragma unroll
        for (int j = 0; j < 4; ++j) { v[j] = v[j] - mean; s2 += (v[j][0] * v[j][0] + v[j][1] * v[j][1]) + (v[j][2] * v[j][2] + v[j][3] * v[j][3]); }
        const float rstd = 1.f / sqrtf(wave_sum(s2) * (1.f / DM) + LN_EPS);
#pragma unroll
        for (int j = 0; j < 4; ++j) xr[64 * j] = v[j] * rstd * gv[j] + bv[j];
    }
}
#ifndef LAST_PHASE
#define LAST_PHASE 11
#endif
__global__ void __launch_bounds__(NWAVES * 64, 2) hybrid_fwd(Args args) {
    extern __shared__ __attribute__((aligned(16))) unsigned char lds[];
    Frame F;
    F.lds = (LAS unsigned char*)lds;
    F.tid = threadIdx.x; F.lane = F.tid & 63; F.wave = __builtin_amdgcn_readfirstlane(F.tid >> 6);
    F.G = gridDim.x; { const int bx = blockIdx.x; F.vcu = (F.G % 8 == 0) ? (bx % 8) * (F.G / 8) + bx / 8 : bx; }
    F.gw = F.vcu * NWAVES + F.wave; F.NGW = F.G * NWAVES;
    unsigned char* ws = args.ws;
    F.ctl = (gu32*)(ws + WS_CTL);
    volatile LAS unsigned* MISC = (volatile LAS unsigned*)(F.lds + MISC_OFF);
    for (int u = F.tid; u < (LDS_BYTES - LDSCTL_OFF) / 4; u += NWAVES * 64) ((LAS unsigned*)(F.lds + LDSCTL_OFF))[u] = 0u;
    __syncthreads();
    XcdBarrier bar = xcd_barrier_post((unsigned*)(F.ctl + CW_BAR), MISC + 8);
    float* vec = (float*)(ws + WS_VEC);
    bf16_t* XB = (bf16_t*)(ws + WS_XB); bf16_t* QB = (bf16_t*)(ws + WS_Q); bf16_t* KB = (bf16_t*)(ws + WS_K); bf16_t* VB = (bf16_t*)(ws + WS_V); bf16_t* CB = (bf16_t*)(ws + WS_C);
    bf16_t* GBB = (bf16_t*)(ws + WS_GB); bf16_t* MIX = (bf16_t*)(ws + WS_MIX); bf16_t* ZH = (bf16_t*)(ws + WS_ZH); bf16_t* HB = (bf16_t*)(ws + WS_H);
    float* ZA = (float*)(ws + WS_ZA); float* ZB = (float*)(ws + WS_ZB); float* STA = (float*)(ws + WS_STA); float* STB = (float*)(ws + WS_STB);
    const int bid = (int)blockIdx.x;
#define PHASE_END(k) do { if (LAST_PHASE == (k)) return; xcd_barrier(bar); } while (0)

    p0_prologue(F, args);
    PHASE_END(0);
    { pg8::Gemm g{XB, (const bf16_t*)(ws + WS_WIN0), M, N_IN0, DM}; pg8::StaticOrder S; S.init(M, N_IN0, F.G, bid);
      EpiIn0 E{QB, KB, VB, CB, GBB, vec + V_BIN0, args.out};
      pg8::gemm_phase<EpiIn0, pg8::StaticOrder, true, true>(F.lds, g, S, E); }
    PHASE_END(1);
    mixer0(F, args);
    PHASE_END(2);
    { pg8::Gemm g{MIX, (const bf16_t*)(ws + WS_WOUT0), M, DM, DM}; pg8::StaticOrder S; S.init(M, DM, F.G, bid);
      EpiRes<false, true> E{args.in[0], args.in[1], nullptr, nullptr, nullptr, nullptr, args.in[13], ZA, ZH, STA, F.lds};
      pg8::gemm_phase<EpiRes<false, true>, pg8::StaticOrder, true, true>(F.lds, g, S, E); }
    PHASE_END(3);
    { pg8::Gemm g{ZH, (const bf16_t*)(ws + WS_W1_0), M, FF, DM}; pg8::StaticOrder S; S.init(M, FF, F.G, bid);
      EpiMlp1 E{HB, vec + V_CS1_0, vec + V_BW1_0, STA, F.lds};
      pg8::gemm_phase<EpiMlp1, pg8::StaticOrder, true, true>(F.lds, g, S, E); }
    PHASE_END(4);
    { pg8::Gemm g{HB, (const bf16_t*)(ws + WS_W2_0), M, DM, FF}; pg8::StaticOrder S; S.init(M, DM, F.G, bid);
      EpiRes<true, false> E{nullptr, nullptr, ZA, STA, args.in[22], args.in[23], nullptr, ZB, ZH, STB, F.lds};
      pg8::gemm_phase<EpiRes<true, false>, pg8::StaticOrder, true, true>(F.lds, g, S, E); }
    PHASE_END(5);
    { pg8::Gemm g{ZH, (const bf16_t*)(ws + WS_WIN1), M, N_IN1, DM}; pg8::StaticOrder S; S.init(M, N_IN1, F.G, bid);
      EpiIn1 E{CB, QB, KB, VB, vec + V_CSIN1, vec + V_BWIN1, STB, args.out, F.lds};
      pg8::gemm_phase<EpiIn1, pg8::StaticOrder, true, true>(F.lds, g, S, E); }
    PHASE_END(6);
    mixer1(F, args);
    PHASE_END(7);
    { pg8::Gemm g{MIX, (const bf16_t*)(ws + WS_WOUT1), M, DM, DM}; pg8::StaticOrder S; S.init(M, DM, F.G, bid);
      EpiRes<true, true> E{nullptr, nullptr, ZB, STB, args.in[24], args.in[25], args.in[19], ZA, ZH, STA, F.lds};
      pg8::gemm_phase<EpiRes<true, true>, pg8::StaticOrder, true, true>(F.lds, g, S, E); }
    PHASE_END(8);
    { pg8::Gemm g{ZH, (const bf16_t*)(ws + WS_W1_1), M, FF, DM}; pg8::StaticOrder S; S.init(M, FF, F.G, bid);
      EpiMlp1 E{HB, vec + V_CS1_1, vec + V_BW1_1, STA, F.lds};
      pg8::gemm_phase<EpiMlp1, pg8::StaticOrder, true, true>(F.lds, g, S, E); }
    PHASE_END(9);
    { pg8::Gemm g{HB, (const bf16_t*)(ws + WS_W2_1), M, DM, FF}; pg8::StaticOrder S; S.init(M, DM, F.G, bid);
      EpiRes<true, false> E{nullptr, nullptr, ZA, STA, args.in[22] + DM, args.in[23] + DM, nullptr, args.out + O_Y, ZH, STB, F.lds};
      pg8::gemm_phase<EpiRes<true, false>, pg8::StaticOrder, true, true>(F.lds, g, S, E); }
    PHASE_END(10);
    final_ln(F, args);
#undef PHASE_END
}

extern "C" void kernel_launch(void* const* d_in, const int* in_sizes, int n_in, void* d_out, int out_size, void* d_ws, size_t ws_size, hipStream_t stream) {
    static int grid = 0;
    if (grid == 0) {
        if (n_in != 26 || in_sizes[0] != MP * DM || (size_t)out_size != O_TOTAL || ws_size < WS_END) {
            fprintf(stderr, "kernel_launch: unexpected shapes (n_in %d, in0 %d, out %d, ws %zu); nothing launched\n", n_in, n_in > 0 ? in_sizes[0] : -1, out_size, ws_size); grid = -1; return; }
        int dev = 0, cus = 0, per_cu = 0;
        if (hipGetDevice(&dev) != hipSuccess || hipDeviceGetAttribute(&cus, hipDeviceAttributeMultiprocessorCount, dev) != hipSuccess) { grid = -1; return; }
        if (hipFuncSetAttribute((const void*)hybrid_fwd, hipFuncAttributeMaxDynamicSharedMemorySize, LDS_BYTES) != hipSuccess) { fprintf(stderr, "kernel_launch: hipFuncSetAttribute failed\n"); grid = -1; return; }
        if (hipOccupancyMaxActiveBlocksPerMultiprocessor(&per_cu, (const void*)hybrid_fwd, NWAVES * 64, LDS_BYTES) != hipSuccess || per_cu < 1) {
            fprintf(stderr, "kernel_launch: occupancy query reports %d workgroups per CU; nothing launched\n", per_cu); (void)hipGetLastError(); grid = -1; return; }
        grid = cus;
    }
    if (grid < 0) return;
    if (hipMemsetAsync((char*)d_ws + WS_CTL, 0, CTL_ZERO_BYTES, stream) != hipSuccess) return;
    Args a{};
    for (int i = 0; i < 26; ++i) a.in[i] = (const float*)d_in[i];
    a.out = (float*)d_out; a.ws = (unsigned char*)d_ws;
    hipLaunchKernelGGL(hybrid_fwd, dim3(grid), dim3(NWAVES * 64), LDS_BYTES, stream, a);
}
```

```cpp
#include <hip/hip_runtime.h>
#include <cstdio>
#include <cstdint>
namespace pg8 {
#define PG8_LAS __attribute__((address_space(3)))
typedef unsigned short bf16_t;
typedef short bf16x8 __attribute__((ext_vector_type(8)));
typedef float f32x4 __attribute__((ext_vector_type(4)));
typedef unsigned u32x4 __attribute__((ext_vector_type(4)));
constexpr int BM = 256, BK = 64, HALF = 128, HTB = HALF * BK * 2  , STAGE_BYTES = 8 * HTB, NXCD = 8, WGM = 8;

__host__ __device__ __forceinline__ int lds_byte(int r, int c) { const int st = (r >> 4) * 2 + (c >> 5), rr = r & 15, cc = c & 31, ob = rr * 64 + cc * 2; return st * 1024 + (ob ^ (((ob >> 9) & 1) << 5)); }
__host__ __device__ __forceinline__ void stage_rc(int b, int& R, int& C) { const int st = b / 1024, sb = b % 1024, swz = sb ^ (((sb >> 9) & 1) << 5); R = (st >> 1) * 16 + swz / 64; C = (st & 1) * 32 + (swz % 64) / 2; }
__host__ __device__ __forceinline__ int perm32(int rho) { const int n = rho >> 4, i = rho & 15; return 8 * (i >> 2) + 4 * n + (i & 3); }

struct Unit { int pm, pn; };
struct Gemm { const bf16_t* A; const bf16_t* Bt; int M, N, K; };

struct StaticOrder {
    int nM, nN, nwg, G, c;
    __host__ __device__ void init(int M, int N, int G_, int c_) { nM = M / BM; nN = N / BM; nwg = nM * nN; G = G_; c = c_; }
    __host__ __device__ bool next(int i, Unit& u) const {
        const long L = (long)i * G + c; if (L >= nwg) return false;
        int wgid = (int)L; { const int q = nwg / NXCD, r = nwg % NXCD, xcd = wgid % NXCD, off = wgid / NXCD; wgid = (xcd < r ? xcd * (q + 1) : r * (q + 1) + (xcd - r) * q) + off; }
        const int nig = WGM * nN, gid = wgid / nig, fm = gid * WGM, gsz = (nM - fm) < WGM ? (nM - fm) : WGM;
        u.pm = fm + ((wgid % nig) % gsz); u.pn = (wgid % nig) / gsz; return true;
    }
    __device__ __forceinline__ void a_ready(const Unit&) const {}
    __device__ __forceinline__ void done(const Unit&) const {}
};

__device__ __forceinline__ unsigned cvt_pk_bf16(float lo, float hi) { unsigned r; asm volatile("v_cvt_pk_bf16_f32 %0, %1, %2" : "=v"(r) : "v"(lo), "v"(hi)); return r; }
typedef float f32x2 __attribute__((ext_vector_type(2)));
template <class Epi, class Sched, bool ALIGN_EPI = false, bool SP2 = false>
__device__ __forceinline__ void gemm_phase(PG8_LAS unsigned char* lds, const Gemm g, const Sched& S, const Epi& E) {
    int tid_ = threadIdx.x; asm volatile("" : "+v"(tid_));
    const int tid = tid_, wid = __builtin_amdgcn_readfirstlane(tid >> 6), lane = tid & 63, wr = wid >> 2, wc = wid & 3, fr = lane & 15, fq = lane >> 4;
    const int K = g.K, nt = K / BK;
    unsigned voffA[2], voffB[2];
#pragma unroll
    for (int i = 0; i < 2; ++i) { int R, C; stage_rc(tid * 16 + i * 8192, R, C); const int Rb = Epi::PERM ? ((R & ~31) + perm32(R & 31)) : R;
        voffA[i] = (unsigned)(R * K + C) * 2u; voffB[i] = (unsigned)(Rb * K + C) * 2u; }
    const size_t kstep = (size_t)(BK * 2);
    const size_t hstep = (size_t)HALF * K * 2;
    const size_t tstep = 2 * hstep;
    const unsigned ldsw = (unsigned)wid * 1024u;
    const int aoff = lds_byte(wr * 64 + fr, fq * 8), boff = lds_byte(wc * 32 + fr, fq * 8);
#define PG8_SA(b, h) (((b) * 2 + (h)) * HTB)
#define PG8_SB(b, h) ((4 + (b) * 2 + (h)) * HTB)
#define PG8_STAGE(bufoff, gbase, voff) do { _Pragma("unroll") for (int _i = 0; _i < 2; ++_i) \
        __builtin_amdgcn_global_load_lds((const unsigned*)((const char*)(gbase) + (voff)[_i]), (PG8_LAS unsigned*)(lds + (bufoff) + ldsw + _i * 8192), 16, 0, 0); } while (0)
#define PG8_LDA(dst, b, h) do { _Pragma("unroll") for (int m = 0; m < 4; ++m) _Pragma("unroll") for (int k = 0; k < 2; ++k) dst[m][k] = *(const PG8_LAS bf16x8*)(lds + PG8_SA(b, h) + aoff + m * 2048 + k * 1024); } while (0)
#define PG8_LDB(dst, b, h) do { _Pragma("unroll") for (int n = 0; n < 2; ++n) _Pragma("unroll") for (int k = 0; k < 2; ++k) dst[n][k] = *(const PG8_LAS bf16x8*)(lds + PG8_SB(b, h) + boff + n * 2048 + k * 1024); } while (0)
#define PG8_MMA(ai, bj, At, Bt) do { __builtin_amdgcn_s_setprio(1); _Pragma("unroll") for (int m = 0; m < 4; ++m) _Pragma("unroll") for (int n = 0; n < 2; ++n) _Pragma("unroll") for (int k = 0; k < 2; ++k) \
        acc[ai][bj][m][n] = __builtin_amdgcn_mfma_f32_16x16x32_bf16(Bt[n][k], At[m][k], acc[ai][bj][m][n], 0, 0, 0); __builtin_amdgcn_s_setprio(0); } while (0)
#define PG8_WAIT_V(n) asm volatile("s_waitcnt vmcnt(" #n ")" ::: "memory")
#define PG8_WAIT_L(n) asm volatile("s_waitcnt lgkmcnt(" #n ")" ::: "memory")
#define PG8_BAR __builtin_amdgcn_s_barrier()
#define PG8_SCHED __builtin_amdgcn_sched_barrier(0)
    Unit cur, nxt; int ui = 0;
    if (!S.next(0, cur)) return;
    f32x4 acc[2][2][4][2];
#pragma unroll
    for (int a = 0; a < 2; ++a)
#pragma unroll
        for (int b = 0; b < 2; ++b)
#pragma unroll
            for (int m = 0; m < 4; ++m)
#pragma unroll
                for (int n = 0; n < 2; ++n) acc[a][b][m][n] = (f32x4){0.f, 0.f, 0.f, 0.f};
    bf16x8 At[4][2], B0[2][2], B1[2][2];
    const char* cA = (const char*)g.A + (size_t)cur.pm * tstep; const char* cB = (const char*)g.Bt + (size_t)cur.pn * tstep;
    S.a_ready(cur);
    if (wr == 1) E.pre(cur, wid, lane);
    if constexpr (SP2) {
        PG8_STAGE(PG8_SB(0, 0), cB, voffB); PG8_STAGE(PG8_SB(0, 1), cB + hstep, voffB); PG8_STAGE(PG8_SA(0, 0), cA, voffA); PG8_STAGE(PG8_SA(0, 1), cA + hstep, voffA);
        if (wr == 1) PG8_BAR;
        PG8_WAIT_V(2); PG8_BAR;
        PG8_STAGE(PG8_SB(1, 0), cB + kstep, voffB); PG8_STAGE(PG8_SA(1, 0), cA + kstep, voffA); PG8_STAGE(PG8_SB(1, 1), cB + hstep + kstep, voffB);
        PG8_WAIT_V(6); PG8_BAR;
    } else {
        PG8_STAGE(PG8_SB(0, 0), cB, voffB); PG8_STAGE(PG8_SA(0, 0), cA, voffA); PG8_STAGE(PG8_SB(0, 1), cB + hstep, voffB); PG8_STAGE(PG8_SA(0, 1), cA + hstep, voffA);
        if (wr == 1) PG8_BAR;
        PG8_WAIT_V(4); PG8_BAR;
        PG8_STAGE(PG8_SB(1, 0), cB + kstep, voffB); PG8_STAGE(PG8_SA(1, 0), cA + kstep, voffA); PG8_STAGE(PG8_SB(1, 1), cB + hstep + kstep, voffB);
        PG8_WAIT_V(6); PG8_BAR;
    }
    for (;;) {
        const bool has_next = S.next(ui + 1, nxt);
        const char* nA = has_next ? (const char*)g.A + (size_t)nxt.pm * tstep : cA; const char* nB = has_next ? (const char*)g.Bt + (size_t)nxt.pn * tstep : cB;
        for (int t = 0; t < nt; t += 2) {
            const bool last = (t == nt - 2);
            const char* a1 = cA + (size_t)(t + 1) * kstep;
            const char* a2 = last ? nA : cA + (size_t)(t + 2) * kstep; const char* b2 = last ? nB : cB + (size_t)(t + 2) * kstep;
            const char* a3 = a2 + kstep; const char* b3 = b2 + kstep;
            if (last && has_next) S.a_ready(nxt);
            if constexpr (SP2) {
            PG8_LDB(B0, 0, 0); PG8_LDB(B1, 0, 1); PG8_SCHED; PG8_LDA(At, 0, 0); PG8_STAGE(PG8_SA(1, 1), a1 + hstep, voffA);
            PG8_WAIT_V(8); PG8_WAIT_L(0); PG8_BAR; PG8_MMA(0, 0, At, B0); PG8_MMA(0, 1, At, B1); PG8_BAR; PG8_SCHED;
            PG8_LDA(At, 0, 1); PG8_STAGE(PG8_SB(0, 0), b2, voffB); PG8_STAGE(PG8_SB(0, 1), b2 + hstep, voffB); PG8_STAGE(PG8_SA(0, 0), a2, voffA);
            PG8_WAIT_V(8); PG8_WAIT_L(0); PG8_BAR; PG8_MMA(1, 0, At, B0); PG8_MMA(1, 1, At, B1); PG8_BAR; PG8_SCHED;
            PG8_LDB(B0, 1, 0); PG8_LDB(B1, 1, 1); PG8_SCHED; PG8_LDA(At, 1, 0); PG8_STAGE(PG8_SA(0, 1), a2 + hstep, voffA);
            PG8_WAIT_V(8); PG8_WAIT_L(0); PG8_BAR; PG8_MMA(0, 0, At, B0); PG8_MMA(0, 1, At, B1); PG8_BAR; PG8_SCHED;
            PG8_LDA(At, 1, 1); PG8_STAGE(PG8_SB(1, 0), b3, voffB); PG8_STAGE(PG8_SB(1, 1), b3 + hstep, voffB); PG8_STAGE(PG8_SA(1, 0), a3, voffA);
            PG8_WAIT_V(8); PG8_WAIT_L(0); PG8_BAR; PG8_MMA(1, 0, At, B0); PG8_MMA(1, 1, At, B1); PG8_BAR; PG8_SCHED;
            } else {
            PG8_LDB(B0, 0, 0); PG8_SCHED; PG8_LDA(At, 0, 0); PG8_STAGE(PG8_SA(1, 1), a1 + hstep, voffA);
            PG8_WAIT_L(8); PG8_BAR; PG8_WAIT_L(0); PG8_MMA(0, 0, At, B0); PG8_BAR; PG8_SCHED;
            PG8_LDB(B1, 0, 1); PG8_STAGE(PG8_SB(0, 0), b2, voffB);
            PG8_BAR; PG8_WAIT_L(0); PG8_MMA(0, 1, At, B1); PG8_BAR;
            PG8_LDA(At, 0, 1); PG8_STAGE(PG8_SA(0, 0), a2, voffA);
            PG8_BAR; PG8_WAIT_L(0); PG8_MMA(1, 0, At, B0); PG8_BAR; PG8_SCHED;
            PG8_STAGE(PG8_SB(0, 1), b2 + hstep, voffB);
            PG8_WAIT_V(6); PG8_BAR; PG8_MMA(1, 1, At, B1); PG8_BAR;
            PG8_LDB(B0, 1, 0); PG8_SCHED; PG8_LDA(At, 1, 0); PG8_STAGE(PG8_SA(0, 1), a2 + hstep, voffA);
            PG8_WAIT_L(8); PG8_BAR; PG8_WAIT_L(0); PG8_MMA(0, 0, At, B0); PG8_BAR; PG8_SCHED;
            PG8_LDB(B1, 1, 1); PG8_STAGE(PG8_SB(1, 0), b3, voffB);
            PG8_BAR; PG8_WAIT_L(0); PG8_MMA(0, 1, At, B1); PG8_BAR;
            PG8_LDA(At, 1, 1); PG8_STAGE(PG8_SA(1, 0), a3, voffA);
            PG8_BAR; PG8_WAIT_L(0); PG8_MMA(1, 0, At, B0); PG8_BAR; PG8_SCHED;
            PG8_STAGE(PG8_SB(1, 1), b3 + hstep, voffB);
            PG8_WAIT_V(6); PG8_BAR; PG8_MMA(1, 1, At, B1); PG8_BAR;
            }
        }
        if constexpr (ALIGN_EPI) { if (wr == 0) PG8_BAR; }
        if constexpr (!Epi::AFTER_DRAIN) { E(acc, cur, wr, wc, fr, fq); S.done(cur); }
        if (!has_next) break;
#pragma unroll
        for (int a = 0; a < 2; ++a)
#pragma unroll
            for (int b = 0; b < 2; ++b)
#pragma unroll
                for (int m = 0; m < 4; ++m)
#pragma unroll
                    for (int n = 0; n < 2; ++n) acc[a][b][m][n] = (f32x4){0.f, 0.f, 0.f, 0.f};
        cur = nxt; cA = nA; cB = nB; ++ui;
        if constexpr (ALIGN_EPI) { if (wr == 1) { PG8_BAR; E.pre(cur, wid, lane); } }
    }
    PG8_WAIT_V(0);
    if constexpr (!ALIGN_EPI) { if (wr == 0) PG8_BAR; }
    PG8_BAR;
    if constexpr (Epi::AFTER_DRAIN) { E.fused(acc, cur, wr, wc, fr, fq, lds, wid, lane); S.done(cur); }
#undef PG8_SA
#undef PG8_SB
#undef PG8_STAGE
#undef PG8_LDA
#undef PG8_LDB
#undef PG8_MMA
#undef PG8_WAIT_V
#undef PG8_WAIT_L
#undef PG8_BAR
#undef PG8_SCHED
}
}
#define GAS __attribute__((address_space(1)))
#define LAS __attribute__((address_space(3)))
typedef unsigned short bf16;
typedef unsigned v4u __attribute__((ext_vector_type(4)));
typedef float f32x4 __attribute__((ext_vector_type(4)));
typedef short bf16x8 __attribute__((ext_vector_type(8)));
typedef GAS unsigned gu32;
typedef GAS unsigned long long gu64;
#define RLX_AGENT __ATOMIC_RELAXED, __HIP_MEMORY_SCOPE_AGENT
#define LDS_WAIT() asm volatile("s_waitcnt lgkmcnt(0)" ::: "memory")
#define VM_WAIT() asm volatile("s_waitcnt vmcnt(0)" ::: "memory")
__device__ __forceinline__ unsigned long long rt() { return __builtin_amdgcn_s_memrealtime(); }
__device__ __forceinline__ unsigned f2bf(float f) { unsigned u = __builtin_bit_cast(unsigned, f); return (u + 0x7fffu + ((u >> 16) & 1u)) >> 16; }
__device__ __forceinline__ unsigned pk2(float lo, float hi) { return f2bf(lo) | (f2bf(hi) << 16); }

#define XB_TMO      128
#define XB_XCNT(j)  (256  + 64 * (j))
#define XB_XSUB(j)  (1280 + 64 * (j))
#define XB_XGEN(j)  (2304 + 64 * (j))
#define XB_TOP      3328
#define XB_TOPGEN   3392
#define XCD_BAR_WORDS 3456
#define XB_SPIN_CAP (1u << 22)

__device__ __forceinline__ unsigned xb_ld(unsigned* p)              { return __hip_atomic_load(p, __ATOMIC_RELAXED, __HIP_MEMORY_SCOPE_AGENT); }
__device__ __forceinline__ unsigned xb_add(unsigned* p, unsigned v) { return __hip_atomic_fetch_add(p, v, __ATOMIC_RELAXED, __HIP_MEMORY_SCOPE_AGENT); }
__device__ __forceinline__ unsigned xb_xcc_id() { return (unsigned)__builtin_amdgcn_s_getreg((3 << 11) | 20) & 0xFu; }
#define XB_SPIN(cond, bar) do { unsigned _sp = 0; while (cond) { __builtin_amdgcn_s_sleep(1); \
    if ((++_sp & 255u) == 0u) { if (xb_ld(&(bar)[XB_TMO])) break; if (_sp > XB_SPIN_CAP) { atomicAdd(&(bar)[XB_TMO], 1u); break; } } } } while (0)

struct XcdBarrier {
    unsigned* bar; unsigned x;
    volatile LAS unsigned* st;
};

__device__ __forceinline__ XcdBarrier xcd_barrier_post(unsigned* bar, volatile LAS unsigned* st) {
    XcdBarrier b; b.bar = bar; b.x = xb_xcc_id(); b.st = st;
    if (threadIdx.x == 0) (void)xb_add(&bar[XB_XCNT(b.x)], 1u);
    return b;
}
__device__ __forceinline__ void xcd_barrier_complete(unsigned* bar, unsigned x, unsigned& nloc, unsigned& nx) {
    const unsigned G = gridDim.x * gridDim.y * gridDim.z;
    unsigned sum, cnt, mine, sp = 0u;
    for (;;) {
        sum = 0u; cnt = 0u; mine = 0u;
#pragma unroll
        for (unsigned j = 0; j < 16; ++j) { const unsigned c = xb_ld(&bar[XB_XCNT(j)]); sum += c; cnt += (c > 0u) ? 1u : 0u; mine = (j == x) ? c : mine; }
        if (sum == G) break;
        __builtin_amdgcn_s_sleep(1);
        if ((++sp & 255u) == 0u) { if (xb_ld(&bar[XB_TMO])) break; if (sp > XB_SPIN_CAP) { atomicAdd(&bar[XB_TMO], 1u); break; } }
    }
    nloc = mine > 0u ? mine : 1u; nx = cnt > 0u ? cnt : 1u;
}

__device__ __forceinline__ void xcd_barrier(const XcdBarrier& b) {
    asm volatile("s_waitcnt vmcnt(0)" ::: "memory");
    __syncthreads();
    if (threadIdx.x == 0) {
        unsigned* bar = b.bar;
        __builtin_amdgcn_s_waitcnt(0);
        unsigned nloc = b.st[0], nx = b.st[1];
        if (nloc == 0u) { xcd_barrier_complete(bar, b.x, nloc, nx); b.st[0] = nloc; b.st[1] = nx; }
        const unsigned old = xb_add(&bar[XB_XSUB(b.x)], 1u);
        const unsigned gen = old / nloc;
        if (old + 1u == (gen + 1u) * nloc) {
            __builtin_amdgcn_fence(__ATOMIC_RELEASE, "agent");
            asm volatile("s_waitcnt vmcnt(0)" ::: "memory");
            const unsigned og = xb_add(&bar[XB_TOP], 1u);
            const unsigned tg = og / nx;
            if (og + 1u == (tg + 1u) * nx) xb_add(&bar[XB_TOPGEN], 1u);
            else XB_SPIN(xb_ld(&bar[XB_TOPGEN]) == tg, bar);
            __builtin_amdgcn_fence(__ATOMIC_ACQUIRE, "agent");
            xb_add(&bar[XB_XGEN(b.x)], 1u);
            asm volatile("s_waitcnt vmcnt(0)" ::: "memory");
        } else {
            XB_SPIN(xb_ld(&bar[XB_XGEN(b.x)]) == gen, bar);
            __builtin_amdgcn_fence(__ATOMIC_ACQUIRE, "agent");
            asm volatile("s_waitcnt vmcnt(0)" ::: "memory");
        }
    }
    __syncthreads();
}
constexpr int NWAVES = 8;
constexpr int DM = 1024, SEQ = 4096, NB = 8, NSB = 128, NST = 8, FF = 4096;
constexpr int MP = NB * SEQ;
constexpr int MS = NSB * NST;
constexpr int M = MP + MS;
constexpr int N_IN0 = 2304, N_IN1 = 2048;
constexpr float LN_EPS = 1e-5f;
constexpr float ALPHA = 1.4142135623730951f;
constexpr float LOG2E = 1.4426950408889634f;
constexpr float QS = 0.125f * LOG2E;
constexpr int NA_HIST = 128, ND_HIST = 2048;

constexpr size_t O_Y = 0, O_AKP = 34603008, O_AVP = 34734080, O_BCP = 34865152, O_CPP = 34873344, O_DKP = 34934784, O_DVP = 43323392,
                 O_AKS = 51712000, O_AVS = 53809152, O_BCS = 55906304, O_CPS = 56037376, O_DKS = 57020416, O_DVS = 191238144, O_TOTAL = 325455872;

constexpr size_t MiB = 1u << 20;
constexpr size_t WS_CTL = 0, CTL_ZERO_BYTES = 1 * MiB;
constexpr size_t WS_WIN0 = 2 * MiB, WS_WOUT0 = 8 * MiB, WS_W1_0 = 10 * MiB, WS_W2_0 = 18 * MiB, WS_WIN1 = 26 * MiB, WS_WOUT1 = 30 * MiB, WS_W1_1 = 32 * MiB, WS_W2_1 = 40 * MiB;
constexpr size_t WS_VEC = 48 * MiB;
constexpr int V_BIN0 = 0, V_CS1_0 = 4096, V_BW1_0 = 8192, V_CSIN1 = 12288, V_BWIN1 = 16384, V_CS1_1 = 20480, V_BW1_1 = 24576;
constexpr size_t WS_STA = 49 * MiB, WS_STB = 51 * MiB;
constexpr size_t WS_XB = 64 * MiB;
constexpr size_t WS_Q = 130 * MiB, WS_K = 163 * MiB, WS_V = 196 * MiB, WS_C = 229 * MiB, WS_GB = 262 * MiB;
constexpr size_t WS_MIX = 295 * MiB;
constexpr size_t WS_ZH0 = 361 * MiB, WS_ZH1 = 493 * MiB;
constexpr size_t WS_ZB = 559 * MiB;
constexpr size_t WS_H = 691 * MiB;
constexpr size_t WS_STO = 955 * MiB;
constexpr size_t WS_STML = 1021 * MiB;
constexpr size_t WS_END = 1024 * MiB;
constexpr int CW_BAR = 4096;
constexpr int CW_XQ = 9216;

constexpr int RING_BYTES = 131072;
constexpr int LDSCTL_OFF = RING_BYTES, MISC_OFF = LDSCTL_OFF + 320;
constexpr int EPI_P_OFF = RING_BYTES + 1024;
constexpr int EPI_S_OFF = EPI_P_OFF + 8192;
constexpr int EPI_R_OFF = EPI_S_OFF + 2048;
constexpr int EPI_V_OFF = EPI_R_OFF + 8192;
constexpr int LDS_BYTES = 154624;
static_assert(EPI_V_OFF + 4096 <= LDS_BYTES && LDS_BYTES <= 163840, "LDS map");

typedef float f32x2v __attribute__((ext_vector_type(2)));
typedef unsigned u32x2v __attribute__((ext_vector_type(2)));
using pg8::bf16_t; using pg8::Unit; using pg8::u32x4;
#define EPI_BAR() do { asm volatile("s_waitcnt lgkmcnt(0)" ::: "memory"); __builtin_amdgcn_s_barrier(); asm volatile("" ::: "memory"); } while (0)

__device__ __forceinline__ u32x4 pack8(const f32x4 a, const f32x4 b) { u32x4 w; w.x = pg8::cvt_pk_bf16(a[0], a[1]); w.y = pg8::cvt_pk_bf16(a[2], a[3]); w.z = pg8::cvt_pk_bf16(b[0], b[1]); w.w = pg8::cvt_pk_bf16(b[2], b[3]); return w; }
__device__ __forceinline__ float bf2f(unsigned short h) { return __builtin_bit_cast(float, (unsigned)h << 16); }
__device__ __forceinline__ float bflo(unsigned w) { return __builtin_bit_cast(float, w << 16); }
__device__ __forceinline__ float bfhi(unsigned w) { return __builtin_bit_cast(float, w & 0xffff0000u); }

__device__ __forceinline__ void swap32(float& a, float& b) { asm volatile("s_nop 1\n\tv_permlane32_swap_b32 %0, %1\n\ts_nop 1" : "+v"(a), "+v"(b)); }
__device__ __forceinline__ void swap32(unsigned& a, unsigned& b) { asm volatile("s_nop 1\n\tv_permlane32_swap_b32 %0, %1\n\ts_nop 1" : "+v"(a), "+v"(b)); }
__device__ __forceinline__ void swap16(float& a, float& b) { asm volatile("s_nop 1\n\tv_permlane16_swap_b32 %0, %1\n\ts_nop 1" : "+v"(a), "+v"(b)); }
__device__ __forceinline__ float rows16_sum(float v) { float a = v, b = v; swap16(a, b); const float s2 = a + b; a = s2; b = s2; swap32(a, b); return a + b; }
__device__ __forceinline__ void epi_dma1k(const void* g, LAS unsigned char* l, int lane) { __builtin_amdgcn_global_load_lds((const unsigned*)((const char*)g + lane * 16), (LAS unsigned*)l, 16, 0, 0); }
__device__ __forceinline__ void epi_pre_slots(const float* slots, int pm, LAS unsigned char* lds, int wid, int lane) {
    const char* src = (const char*)(slots + (size_t)pm * 256 * 8); const int c = 2 * (wid - 4);
    epi_dma1k(src + c * 1024, lds + EPI_R_OFF + c * 1024, lane); epi_dma1k(src + (c + 1) * 1024, lds + EPI_R_OFF + (c + 1) * 1024, lane);
}
__device__ __forceinline__ void epi_pre_vec(const float* v, int col0, int slot, LAS unsigned char* lds, int lane) { epi_dma1k(v + col0, lds + EPI_V_OFF + slot * 1024, lane); }
__device__ __forceinline__ void epi_stats_lds(LAS unsigned char* lds, int tid) {
    LAS f32x2v* S = (LAS f32x2v*)(lds + EPI_S_OFF);
    if (tid < 256) {
        const LAS f32x4* sp = (const LAS f32x4*)(lds + EPI_R_OFF + tid * 32);
        const f32x4 a = sp[0], b = sp[1];
        const float mean = ((a[0] + a[2]) + (b[0] + b[2])) * 0.25f;
        const float d0 = a[0] - mean, d1 = a[2] - mean, d2 = b[0] - mean, d3 = b[2] - mean;
        const float q = ((a[1] + a[3]) + (b[1] + b[3])) + 256.0f * ((d0 * d0 + d1 * d1) + (d2 * d2 + d3 * d3));
        S[tid] = (f32x2v){mean, 1.0f / sqrtf(q * (1.0f / 1024.0f) + LN_EPS)};
    }
    EPI_BAR();
}
__device__ __forceinline__ void epi_load_stats(const float* slots, int pm, LAS unsigned char* lds, int tid) {
    LAS f32x2v* S = (LAS f32x2v*)(lds + EPI_S_OFF);
    if (tid < 256) {
        const f32x4* sp = (const f32x4*)(slots + (size_t)(pm * 256 + tid) * 8);
        const f32x4 a = sp[0], b = sp[1];
        const float mean = ((a[0] + a[2]) + (b[0] + b[2])) * 0.25f;
        const float d0 = a[0] - mean, d1 = a[2] - mean, d2 = b[0] - mean, d3 = b[2] - mean;
        const float q = ((a[1] + a[3]) + (b[1] + b[3])) + 256.0f * ((d0 * d0 + d1 * d1) + (d2 * d2 + d3 * d3));
        S[tid] = (f32x2v){mean, 1.0f / sqrtf(q * (1.0f / 1024.0f) + LN_EPS)};
    }
    EPI_BAR();
}
__device__ __forceinline__ void epi_row_stats(const f32x4 (&z)[2][2], LAS unsigned char* lds, int rl, int wc, int fq) {
    float s = 0.f;
#pragma unroll
    for (int bj = 0; bj < 2; ++bj)
#pragma unroll
        for (int n = 0; n < 2; ++n) s += (z[bj][n][0] + z[bj][n][1]) + (z[bj][n][2] + z[bj][n][3]);
    s = rows16_sum(s);
    const float mw = s * (1.0f / 64.0f); float q = 0.f;
#pragma unroll
    for (int bj = 0; bj < 2; ++bj)
#pragma unroll
        for (int n = 0; n < 2; ++n) { const f32x4 d = z[bj][n] - mw; q += (d[0] * d[0] + d[1] * d[1]) + (d[2] * d[2] + d[3] * d[3]); }
    q = rows16_sum(q);
    if (fq == 0) ((LAS f32x2v*)(lds + EPI_P_OFF))[rl * 4 + wc] = (f32x2v){mw, q};
}
__device__ __forceinline__ void epi_store_stats(float* slots, int pm, int pn, LAS unsigned char* lds, int tid) {
    if (tid < 256) {
        const LAS f32x2v* P = (const LAS f32x2v*)(lds + EPI_P_OFF) + tid * 4;
        const f32x2v a = P[0], b = P[1], c = P[2], d = P[3];
        const float mt = ((a.x + b.x) + (c.x + d.x)) * 0.25f;
        const float da = a.x - mt, db = b.x - mt, dc = c.x - mt, dd = d.x - mt;
        const float m2 = ((a.y + b.y) + (c.y + d.y)) + 64.0f * ((da * da + db * db) + (dc * dc + dd * dd));
        *(f32x2v*)(slots + (size_t)(pm * 256 + tid) * 8 + pn * 2) = (f32x2v){mt, m2};
    }
}


struct EpiIn0 {
    static constexpr bool PERM = true, AFTER_DRAIN = false;
    bf16_t *Q, *K, *V, *C, *GB; const float* bias; float* out;
    __device__ __forceinline__ void pre(const Unit&, int, int) const {}
    __device__ __forceinline__ void operator()(const f32x4 (&acc)[2][2][4][2], const Unit& u, int wr, int wc, int fr_in, int fq_in) const {
        int fr = fr_in, fq = fq_in; asm volatile("" : "+v"(fr), "+v"(fq));
        const int pn = u.pn, cc0 = wc * 32 + 8 * fq;
        f32x4 bv[2][2];
#pragma unroll
        for (int bj = 0; bj < 2; ++bj)
#pragma unroll
            for (int n = 0; n < 2; ++n) bv[bj][n] = *(const f32x4*)(bias + pn * 256 + bj * 128 + cc0 + 4 * n);
#pragma unroll
        for (int ai = 0; ai < 2; ++ai)
#pragma unroll
            for (int m = 0; m < 4; ++m) {
                const int row = u.pm * 256 + ai * 128 + wr * 64 + m * 16 + fr;
                f32x4 v[2][2];
#pragma unroll
                for (int bj = 0; bj < 2; ++bj)
#pragma unroll
                    for (int n = 0; n < 2; ++n) v[bj][n] = acc[ai][bj][m][n] + bv[bj][n];
                if (pn < 2) {
#pragma unroll
                    for (int bj = 0; bj < 2; ++bj) *(u32x4*)(Q + (size_t)row * 512 + pn * 256 + bj * 128 + cc0) = pack8(v[bj][0] * QS, v[bj][1] * QS);
                } else if (pn == 2) {
                    *(u32x4*)(K + (size_t)row * 128 + cc0) = pack8(v[0][0], v[0][1]);
                    *(u32x4*)(V + (size_t)row * 128 + cc0) = pack8(v[1][0], v[1][1]);
                    long o = -1;
                    if (row >= MP) { const int s = row - MP; o = (long)((s >> 3) * 128 + 120 + (s & 7)) * 128 + (long)(O_AKS - O_AKP); }
                    else { const int t = row & (SEQ - 1); if (t >= SEQ - 128) o = (long)((row >> 12) * 128 + t - (SEQ - 128)) * 128; }
                    if (o >= 0) {
                        float* ok = out + O_AKP + o + cc0; float* ov = ok + (row >= MP ? (O_AVS - O_AKS) : (O_AVP - O_AKP));
                        *(f32x4*)ok = v[0][0]; *(f32x4*)(ok + 4) = v[0][1]; *(f32x4*)ov = v[1][0]; *(f32x4*)(ov + 4) = v[1][1];
                    }
                } else if (pn < 7) {
                    const int p = pn - 3; const f32x4 c0 = v[0][0] * v[1][0], c1 = v[0][1] * v[1][1];
                    *(u32x4*)(C + (size_t)row * 512 + p * 128 + cc0) = pack8(c0, c1);
                    long o = -1;
                    if (row >= MP) { const int s = row - MP; if ((s & 7) >= 6) o = (long)((s >> 3) * 2 + (s & 7) - 6) * 512 + (long)(O_BCS - O_BCP); }
                    else { const int t = row & (SEQ - 1); if (t >= SEQ - 2) o = (long)((row >> 12) * 2 + t - (SEQ - 2)) * 512; }
                    if (o >= 0) { float* oc = out + O_BCP + o + p * 128 + cc0; *(f32x4*)oc = c0; *(f32x4*)(oc + 4) = c1; }
                } else {
#pragma unroll
                    for (int bj = 0; bj < 2; ++bj) *(u32x4*)(GB + (size_t)row * 512 + (pn - 7) * 256 + bj * 128 + cc0) = pack8(v[bj][0], v[bj][1]);
                }
            }
    }
};

struct EpiIn1 {
    static constexpr bool PERM = true, AFTER_DRAIN = false;
    bf16_t *U, *Q, *K, *V; const float *cs, *bw, *slots; float* out; LAS unsigned char* lds;
    __device__ __forceinline__ void pre(const Unit& u, int wid, int lane) const { epi_pre_slots(slots, u.pm, lds, wid, lane); if (wid == 4) epi_pre_vec(cs, u.pn * 256, 0, lds, lane); if (wid == 5) epi_pre_vec(bw, u.pn * 256, 1, lds, lane); }
    __device__ __forceinline__ void operator()(const f32x4 (&acc)[2][2][4][2], const Unit& u, int wr, int wc, int fr_in, int fq_in) const {
        int fr = fr_in, fq = fq_in; asm volatile("" : "+v"(fr), "+v"(fq));
        const int pn = u.pn, cc0 = wc * 32 + 8 * fq, tid = threadIdx.x;
        f32x4 cv[2][2], bv[2][2];
#pragma unroll
        for (int bj = 0; bj < 2; ++bj)
#pragma unroll
            for (int n = 0; n < 2; ++n) { cv[bj][n] = *(const LAS f32x4*)(lds + EPI_V_OFF + (bj * 128 + cc0 + 4 * n) * 4); bv[bj][n] = *(const LAS f32x4*)(lds + EPI_V_OFF + 1024 + (bj * 128 + cc0 + 4 * n) * 4); }
        epi_stats_lds(lds, tid);
        const LAS f32x2v* S = (const LAS f32x2v*)(lds + EPI_S_OFF);
        const int sel = pn >> 1; bf16_t* dst = sel == 0 ? U : sel == 1 ? Q : sel == 2 ? K : V;
        const float sc = sel == 1 ? QS : 1.0f;
        const size_t obase = sel == 0 ? O_CPP : sel == 2 ? O_DKP : O_DVP;
#pragma unroll
        for (int ai = 0; ai < 2; ++ai)
#pragma unroll
            for (int m = 0; m < 4; ++m) {
                const int rl = ai * 128 + wr * 64 + m * 16 + fr, row = u.pm * 256 + rl;
                const f32x2v st = S[rl];
                f32x4 v[2][2];
#pragma unroll
                for (int bj = 0; bj < 2; ++bj)
#pragma unroll
                    for (int n = 0; n < 2; ++n) v[bj][n] = (acc[ai][bj][m][n] - cv[bj][n] * st.x) * st.y + bv[bj][n];
                const int c512 = (pn & 1) * 256 + cc0;
#pragma unroll
                for (int bj = 0; bj < 2; ++bj) *(u32x4*)(dst + (size_t)row * 512 + c512 + bj * 128) = pack8(v[bj][0] * sc, v[bj][1] * sc);
                if (sel != 1) {
                    long o = -1;
                    if (sel == 0) {
                        if (row >= MP) { const int s = row - MP; o = (long)((s >> 3) * 15 + 7 + (s & 7)) * 512 + (long)(O_CPS - O_CPP); }
                        else { const int t = row & (SEQ - 1); if (t >= SEQ - 15) o = (long)((row >> 12) * 15 + t - (SEQ - 15)) * 512; }
                    } else {
                        if (row >= MP) { const int s = row - MP; o = (long)((s >> 3) * 2048 + 2040 + (s & 7)) * 512 + (sel == 2 ? (long)(O_DKS - O_DKP) : (long)(O_DVS - O_DVP)); }
                        else { const int t = row & (SEQ - 1); if (t >= SEQ - 2048) o = (long)((row >> 12) * 2048 + t - (SEQ - 2048)) * 512; }
                    }
                    if (o >= 0) {
                        float* op = out + obase + o + c512;
#pragma unroll
                        for (int bj = 0; bj < 2; ++bj) { *(f32x4*)(op + bj * 128) = v[bj][0]; *(f32x4*)(op + bj * 128 + 4) = v[bj][1]; }
                    }
                }
            }
    }
};

struct EpiMlp1 {
    static constexpr bool PERM = true, AFTER_DRAIN = false;
    bf16_t* H; const float *cs, *bw, *slots; LAS unsigned char* lds;
    __device__ __forceinline__ void pre(const Unit& u, int wid, int lane) const { epi_pre_slots(slots, u.pm, lds, wid, lane); if (wid == 4) epi_pre_vec(cs, u.pn * 256, 0, lds, lane); if (wid == 5) epi_pre_vec(bw, u.pn * 256, 1, lds, lane); }
    __device__ __forceinline__ void operator()(const f32x4 (&acc)[2][2][4][2], const Unit& u, int wr, int wc, int fr_in, int fq_in) const {
        int fr = fr_in, fq = fq_in; asm volatile("" : "+v"(fr), "+v"(fq));
        const int cc0 = u.pn * 256 + wc * 32 + 8 * fq, tid = threadIdx.x;
        f32x4 cv[2][2], bv[2][2];
        { const int cl = wc * 32 + 8 * fq;
#pragma unroll
        for (int bj = 0; bj < 2; ++bj)
#pragma unroll
            for (int n = 0; n < 2; ++n) { cv[bj][n] = *(const LAS f32x4*)(lds + EPI_V_OFF + (bj * 128 + cl + 4 * n) * 4); bv[bj][n] = *(const LAS f32x4*)(lds + EPI_V_OFF + 1024 + (bj * 128 + cl + 4 * n) * 4); } }
        epi_stats_lds(lds, tid);
        const LAS f32x2v* S = (const LAS f32x2v*)(lds + EPI_S_OFF);
#pragma unroll
        for (int ai = 0; ai < 2; ++ai)
#pragma unroll
            for (int m = 0; m < 4; ++m) {
                const int rl = ai * 128 + wr * 64 + m * 16 + fr, row = u.pm * 256 + rl;
                const f32x2v st = S[rl];
#pragma unroll
                for (int bj = 0; bj < 2; ++bj) {
                    f32x4 v0 = (acc[ai][bj][m][0] - cv[bj][0] * st.x) * st.y + bv[bj][0], v1 = (acc[ai][bj][m][1] - cv[bj][1] * st.x) * st.y + bv[bj][1];
#pragma unroll
                    for (int e = 0; e < 4; ++e) { const float a = fmaxf(v0[e], 0.f), b = fmaxf(v1[e], 0.f); v0[e] = a * a; v1[e] = b * b; }
                    *(u32x4*)(H + (size_t)row * FF + cc0 + bj * 128) = pack8(v0, v1);
                }
            }
    }
};

template <bool LNRES, bool HAS_BIAS, bool F32OUT>
struct EpiRes {
    static constexpr bool PERM = true, AFTER_DRAIN = false;
    const bf16_t* rprev;
    const float *sprev, *g, *b;
    const float* bias; float* zout; bf16_t* zb; float* sout; LAS unsigned char* lds;
    __device__ __forceinline__ void pre(const Unit& u, int wid, int lane) const {
        if (LNRES) { epi_pre_slots(sprev, u.pm, lds, wid, lane); if (wid == 4) epi_pre_vec(g, u.pn * 256, 0, lds, lane); if (wid == 5) epi_pre_vec(b, u.pn * 256, 1, lds, lane); }
        if (HAS_BIAS && wid == 6) epi_pre_vec(bias, u.pn * 256, 2, lds, lane);
    }
    __device__ __forceinline__ void operator()(const f32x4 (&acc)[2][2][4][2], const Unit& u, int wr, int wc, int fr_in, int fq_in) const {
        int fr = fr_in, fq = fq_in; asm volatile("" : "+v"(fr), "+v"(fq));
        const int col0 = u.pn * 256 + wc * 32 + 8 * fq, tid = threadIdx.x;
        const size_t prow = (size_t)u.pm * 256;
        f32x4 gv[2][2], bv[2][2];
#pragma unroll
        for (int bj = 0; bj < 2; ++bj)
#pragma unroll
            for (int n = 0; n < 2; ++n) {
                const int cb = (bj * 128 + wc * 32 + 8 * fq + 4 * n) * 4;
                const f32x4 biv = HAS_BIAS ? *(const LAS f32x4*)(lds + EPI_V_OFF + 2048 + cb) : (f32x4){0.f, 0.f, 0.f, 0.f};
                if (LNRES) { gv[bj][n] = *(const LAS f32x4*)(lds + EPI_V_OFF + cb) * ALPHA; bv[bj][n] = *(const LAS f32x4*)(lds + EPI_V_OFF + 1024 + cb) * ALPHA + biv; }
                else { gv[bj][n] = (f32x4){ALPHA, ALPHA, ALPHA, ALPHA}; bv[bj][n] = biv; }
            }
        if (LNRES) epi_stats_lds(lds, tid);
        const LAS f32x2v* S = (const LAS f32x2v*)(lds + EPI_S_OFF);
#pragma unroll
        for (int ai = 0; ai < 2; ++ai) {
            u32x4 rw[4][2];
#pragma unroll
            for (int m = 0; m < 4; ++m)
#pragma unroll
                for (int bj = 0; bj < 2; ++bj) rw[m][bj] = *(const u32x4*)(rprev + (prow + ai * 128 + wr * 64 + m * 16 + fr) * DM + col0 + bj * 128);
#pragma unroll
            for (int m = 0; m < 4; ++m) {
                const int rl = ai * 128 + wr * 64 + m * 16 + fr; const size_t row = prow + rl;
                f32x2v st = (f32x2v){0.f, 1.f}; if (LNRES) st = S[rl];
                f32x4 z[2][2];
#pragma unroll
                for (int bj = 0; bj < 2; ++bj) {
                    const u32x4 w = rw[m][bj];
                    const f32x4 x0 = (f32x4){bflo(w.x), bfhi(w.x), bflo(w.y), bfhi(w.y)}, x1 = (f32x4){bflo(w.z), bfhi(w.z), bflo(w.w), bfhi(w.w)};
                    z[bj][0] = acc[ai][bj][m][0] + ((x0 - st.x) * st.y) * gv[bj][0] + bv[bj][0];
                    z[bj][1] = acc[ai][bj][m][1] + ((x1 - st.x) * st.y) * gv[bj][1] + bv[bj][1];
                }
#pragma unroll
                for (int bj = 0; bj < 2; ++bj) {
                    if (F32OUT) { float* zo = zout + row * DM + col0 + bj * 128; *(f32x4*)zo = z[bj][0]; *(f32x4*)(zo + 4) = z[bj][1]; }
                    else *(u32x4*)(zb + row * DM + col0 + bj * 128) = pack8(z[bj][0], z[bj][1]);
                }
                epi_row_stats(z, lds, rl, wc, fq);
            }
            asm volatile("" ::: "memory");
        }
        EPI_BAR();
        epi_store_stats(sout, u.pm, u.pn, lds, tid);
    }
};

constexpr int CW_PANEL = 16384;
struct EpiResFinal {
    static constexpr bool PERM = true, AFTER_DRAIN = false;
    const bf16_t* rprev; const float *sprev, *g, *b, *g2, *b2; float* out; float* xslots; gu32* ctl; LAS unsigned char* lds;
    __device__ __forceinline__ void pre(const Unit& u, int wid, int lane) const {
        epi_pre_slots(sprev, u.pm, lds, wid, lane);
        epi_pre_vec(wid == 4 ? g : wid == 5 ? b : wid == 6 ? g2 : b2, u.pn * 256, wid - 4, lds, lane);
    }
    __device__ __forceinline__ void operator()(const f32x4 (&acc_in)[2][2][4][2], const Unit& u, int wr, int wc, int fr_in, int fq_in) const {
        f32x4 (&acc)[2][2][4][2] = const_cast<f32x4 (&)[2][2][4][2]>(acc_in);
        int fr = fr_in, fq = fq_in; asm volatile("" : "+v"(fr), "+v"(fq));
        const int col0 = u.pn * 256 + wc * 32 + 8 * fq, tid = threadIdx.x;
        const size_t prow = (size_t)u.pm * 256;
        const int cb0 = (wc * 32 + 8 * fq) * 4;
        epi_stats_lds(lds, tid);
        const LAS f32x2v* S = (const LAS f32x2v*)(lds + EPI_S_OFF);
        {
            f32x4 gv[2][2], bv[2][2];
#pragma unroll
            for (int bj = 0; bj < 2; ++bj)
#pragma unroll
                for (int n = 0; n < 2; ++n) { const int cb = cb0 + (bj * 128 + 4 * n) * 4; gv[bj][n] = *(const LAS f32x4*)(lds + EPI_V_OFF + cb) * ALPHA; bv[bj][n] = *(const LAS f32x4*)(lds + EPI_V_OFF + 1024 + cb) * ALPHA; }
#pragma unroll
            for (int ai = 0; ai < 2; ++ai) {
                u32x4 rw[4][2];
#pragma unroll
                for (int m = 0; m < 4; ++m)
#pragma unroll
                    for (int bj = 0; bj < 2; ++bj) rw[m][bj] = *(const u32x4*)(rprev + (prow + ai * 128 + wr * 64 + m * 16 + fr) * DM + col0 + bj * 128);
#pragma unroll
                for (int m = 0; m < 4; ++m) {
                    const int rl = ai * 128 + wr * 64 + m * 16 + fr; const f32x2v st = S[rl];
                    f32x4 z[2][2];
#pragma unroll
                    for (int bj = 0; bj < 2; ++bj) {
                        const u32x4 w = rw[m][bj];
                        const f32x4 x0 = (f32x4){bflo(w.x), bfhi(w.x), bflo(w.y), bfhi(w.y)}, x1 = (f32x4){bflo(w.z), bfhi(w.z), bflo(w.w), bfhi(w.w)};
                        z[bj][0] = acc[ai][bj][m][0] + ((x0 - st.x) * st.y) * gv[bj][0] + bv[bj][0];
                        z[bj][1] = acc[ai][bj][m][1] + ((x1 - st.x) * st.y) * gv[bj][1] + bv[bj][1];
                        acc[ai][bj][m][0] = z[bj][0]; acc[ai][bj][m][1] = z[bj][1];
                    }
                    epi_row_stats(z, lds, rl, wc, fq);
                }
                asm volatile("" ::: "memory");
            }
        }
        EPI_BAR();
        if (tid < 256) {
            const LAS f32x2v* P = (const LAS f32x2v*)(lds + EPI_P_OFF) + tid * 4;
            const f32x2v a = P[0], b2_ = P[1], c = P[2], d = P[3];
            const float mt = ((a.x + b2_.x) + (c.x + d.x)) * 0.25f;
            const float da = a.x - mt, db = b2_.x - mt, dc = c.x - mt, dd = d.x - mt;
            const float m2 = ((a.y + b2_.y) + (c.y + d.y)) + 64.0f * ((da * da + db * db) + (dc * dc + dd * dd));
            unsigned long long* slot = (unsigned long long*)(xslots + (prow + tid) * 8 + u.pn * 2);
            __hip_atomic_store(slot, ((unsigned long long)__builtin_bit_cast(unsigned, m2) << 32) | __builtin_bit_cast(unsigned, mt), __ATOMIC_RELAXED, __HIP_MEMORY_SCOPE_AGENT);
        }
        asm volatile("s_waitcnt vmcnt(0)" ::: "memory");
        EPI_BAR();
        if (tid == 0) {
            gu32* cnt = ctl + CW_PANEL + 64 * u.pm;
            __hip_atomic_fetch_add(cnt, 1u, RLX_AGENT);
            unsigned sp = 0;
            while (__hip_atomic_load(cnt, RLX_AGENT) < 4u) { __builtin_amdgcn_s_sleep(1); if (++sp > XB_SPIN_CAP) { atomicAdd((unsigned*)(ctl + CW_BAR) + XB_TMO, 1u); break; } }
            __builtin_amdgcn_fence(__ATOMIC_ACQUIRE, "agent");
            asm volatile("s_waitcnt vmcnt(0)" ::: "memory");
        }
        EPI_BAR();
        if (tid < 256) {
            const unsigned long long* slot = (const unsigned long long*)(xslots + (prow + tid) * 8); float mt[4], m2[4];
#pragma unroll
            for (int t = 0; t < 4; ++t) { const unsigned long long w = __hip_atomic_load(slot + t, __ATOMIC_RELAXED, __HIP_MEMORY_SCOPE_AGENT); mt[t] = __builtin_bit_cast(float, (unsigned)w); m2[t] = __builtin_bit_cast(float, (unsigned)(w >> 32)); }
            const float mean = ((mt[0] + mt[1]) + (mt[2] + mt[3])) * 0.25f;
            float q = 0.f;
#pragma unroll
            for (int t = 0; t < 4; ++t) { const float dm = mt[t] - mean; q += m2[t] + 256.0f * dm * dm; }
            ((LAS f32x2v*)(lds + EPI_S_OFF))[tid] = (f32x2v){mean, 1.0f / sqrtf(q * (1.0f / 1024.0f) + LN_EPS)};
        }
        EPI_BAR();
#pragma unroll
        for (int ai = 0; ai < 2; ++ai)
#pragma unroll
            for (int m = 0; m < 4; ++m) {
                const int rl = ai * 128 + wr * 64 + m * 16 + fr; const f32x2v st = S[rl]; float* yo = out + (prow + rl) * DM + col0;
#pragma unroll
                for (int bj = 0; bj < 2; ++bj)
#pragma unroll
                    for (int n = 0; n < 2; ++n) { const int cb = cb0 + (bj * 128 + 4 * n) * 4;
                        *(f32x4*)(yo + bj * 128 + 4 * n) = ((acc[ai][bj][m][n] - st.x) * st.y) * *(const LAS f32x4*)(lds + EPI_V_OFF + 2048 + cb) + *(const LAS f32x4*)(lds + EPI_V_OFF + 3072 + cb); }
            }
    }
};
struct Args { const float* in[26]; float* out; unsigned char* ws; };
struct Frame {
    LAS unsigned char* lds; gu32* ctl; int tid, lane, wave, vcu, G, gw, NGW, vcu_lt240;
};
__device__ __forceinline__ float wave_sum(float v) {
#pragma unroll
    for (int o = 1; o < 64; o <<= 1) v += __shfl_xor(v, o);
    return v;
}
__device__ __forceinline__ float wave_max(float v) {
#pragma unroll
    for (int o = 1; o < 64; o <<= 1) v = fmaxf(v, __shfl_xor(v, o));
    return v;
}

__device__ __forceinline__ void transpose_tile(const float* W, int ldw, int n0, int k0, const float* gk, bf16_t* WT, int ldt, int drow0, int kdst0, LAS float* scr, int lane) {
    {
        float wv[32];
#pragma unroll
        for (int i = 0; i < 32; ++i) { const int kk = 2 * i + (lane >> 5); wv[i] = W[(size_t)(k0 + kk) * ldw + n0 + (lane & 31)]; }
#pragma unroll
        for (int i = 0; i < 32; ++i) { const int kk = 2 * i + (lane >> 5); float w = wv[i]; if (gk) w *= gk[k0 + kk]; scr[kk * 33 + (lane & 31)] = w; }
    }
    LDS_WAIT(); asm volatile("" ::: "memory");
    const int c = lane & 7;
#pragma unroll
    for (int j = 0; j < 4; ++j) { const int n = (lane >> 3) + 8 * j; const LAS float* s = scr + (8 * c) * 33 + n;
        v4u o; o.x = pk2(s[0 * 33], s[1 * 33]); o.y = pk2(s[2 * 33], s[3 * 33]); o.z = pk2(s[4 * 33], s[5 * 33]); o.w = pk2(s[6 * 33], s[7 * 33]);
        *(GAS v4u*)(WT + (size_t)(drow0 + n) * ldt + kdst0 + k0 + 8 * c) = o; }
    LDS_WAIT(); asm volatile("" ::: "memory");
}
__device__ __forceinline__ int in0_src_col(int np) {
    if (np < 768) return np;
    if (np < 1792) { const int tt = np - 768, p = tt >> 8, w = tt & 255; return w < 128 ? 768 + 128 * p + w : 1792 + 128 * p + (w - 128); }
    return 1280 + (np - 1792);
}
__device__ __forceinline__ void colsum_item(const float* W, int K, int N, const float* g, const float* b, const float* bias, float* cs, float* bw, int item, int lane) {
    const int n = item * 16 + (lane & 15), kq = lane >> 4, kn = K / 4;
    float a = 0.f, c = 0.f;
    for (int k0 = kq * kn; k0 < (kq + 1) * kn; k0 += 32) {
        float w[32], gg[32], bb[32];
#pragma unroll
        for (int u = 0; u < 32; ++u) { w[u] = W[(size_t)(k0 + u) * N + n]; gg[u] = g[k0 + u]; bb[u] = b[k0 + u]; }
#pragma unroll
        for (int u = 0; u < 32; ++u) { a += __builtin_bit_cast(float, f2bf(gg[u] * w[u]) << 16); c += bb[u] * w[u]; }
    }
    a += __shfl_xor(a, 16); a += __shfl_xor(a, 32); c += __shfl_xor(c, 16); c += __shfl_xor(c, 32);
    if (lane < 16) { cs[n] = a; bw[n] = c + (bias ? bias[n] : 0.f); }
}
__device__ __forceinline__ void poolfold_item(const float* Wg, const float* scale, const float* Wo, bf16_t* WT, int item, int lane) {
    const int nb = item & 15, ib = (item >> 4) & 15, g = item >> 8, n = nb * 64 + lane, i0 = ib * 8;
    float acc[8];
#pragma unroll
    for (int ii = 0; ii < 8; ++ii) acc[ii] = 0.f;
    const float* wg = Wg + (size_t)g * 128 * 128 + (size_t)i0 * 128;
    for (int j0 = 0; j0 < 128; j0 += 16) {
        float w[16], wgv[8][16];
#pragma unroll
        for (int u = 0; u < 16; ++u) { w[u] = scale[128 * g + j0 + u] * Wo[(size_t)(128 * g + j0 + u) * DM + n];
#pragma unroll
            for (int ii = 0; ii < 8; ++ii) wgv[ii][u] = wg[ii * 128 + j0 + u]; }
#pragma unroll
        for (int u = 0; u < 16; ++u)
#pragma unroll
            for (int ii = 0; ii < 8; ++ii) acc[ii] += wgv[ii][u] * w[u];
    }
    v4u o; o.x = pk2(acc[0], acc[1]); o.y = pk2(acc[2], acc[3]); o.z = pk2(acc[4], acc[5]); o.w = pk2(acc[6], acc[7]);
    *(GAS v4u*)(WT + (size_t)n * DM + 128 * g + i0) = o;
}
constexpr int CW_COPY_HEAD = 8192, CW_DONE0 = 8256;
constexpr unsigned U_A = 120, U_C = 28, U_DB = NSB * 24, NUNIT = 2 * U_A + U_C + 2 * U_DB;
template <int NT, int NB>
__device__ __forceinline__ void copy_dblock_unit(const float* src, float* dst, unsigned idx, int t) {
    const unsigned b = idx / 24u, q = idx - b * 24u;
    const GAS f32x4* s = (const GAS f32x4*)src + (size_t)b * ND_HIST * 128; GAS f32x4* d = (GAS f32x4*)dst + (size_t)b * ND_HIST * 128;
    constexpr int NPER = 4096 / NT;
#pragma unroll 1
    for (int h = 0; h < NPER; h += NB) {
        f32x4 v[NB]; size_t di[NB];
#pragma unroll
        for (int k = 0; k < NB; ++k) { const unsigned p = (unsigned)(h + k) * (unsigned)NT + (unsigned)t, blk = p >> 10, w = p & 1023u; di[k] = (size_t)(16u * (4u * q + blk)) * 128 + w; v[k] = __builtin_nontemporal_load(s + di[k] + 8 * 128); }
#pragma unroll
        for (int k = 0; k < NB; ++k) __builtin_nontemporal_store(v[k], d + di[k]);
    }
}
template <int BP, int SKIP, int NT, int NB  >
__device__ __forceinline__ void copy_unit(const float* src, float* dst, unsigned unit, int t) {
    const GAS f32x4* s = (const GAS f32x4*)src; GAS f32x4* d = (GAS f32x4*)dst;
    constexpr unsigned PER = BP - SKIP; constexpr int NPER = 4096 / NT;
#pragma unroll 1
    for (int h = 0; h < NPER; h += NB) {
        f32x4 v[NB]; size_t di[NB];
#pragma unroll
        for (int k = 0; k < NB; ++k) { const unsigned i = unit * 4096u + (unsigned)(h + k) * (unsigned)NT + (unsigned)t, b = i / PER, r = i - b * PER; di[k] = (size_t)b * BP + r; v[k] = __builtin_nontemporal_load(s + di[k] + SKIP); }
#pragma unroll
        for (int k = 0; k < NB; ++k) __builtin_nontemporal_store(v[k], d + di[k]);
    }
}
template <int NT, int NB>
__device__ __forceinline__ void copy_unit_any(const Args& A, unsigned c, int t) {
    if (c < U_A) copy_unit<NA_HIST * 32, NST * 32, NT, NB>(A.in[2], A.out + O_AKS, c, t);
    else if (c < 2 * U_A) copy_unit<NA_HIST * 32, NST * 32, NT, NB>(A.in[3], A.out + O_AVS, c - U_A, t);
    else if (c < 2 * U_A + U_C) copy_unit<15 * 128, NST * 128, NT, NB>(A.in[5], A.out + O_CPS, c - 2 * U_A, t);
    else if (c < 2 * U_A + U_C + U_DB) copy_dblock_unit<NT, NB>(A.in[6], A.out + O_DKS, c - (2 * U_A + U_C), t);
    else copy_dblock_unit<NT, NB>(A.in[7], A.out + O_DVS, c - (2 * U_A + U_C + U_DB), t);
}
__device__ __forceinline__ void steal_copy(const Frame& F, const Args& A, int phase, bool until_empty) {
    volatile LAS unsigned* slot = (volatile LAS unsigned*)(F.lds + MISC_OFF) + 12;
    gu32* head = F.ctl + CW_COPY_HEAD; gu32* done = F.ctl + CW_DONE0 + 64 * phase;
    if (F.tid == 0 && !until_empty) __hip_atomic_fetch_add(done, 1u, RLX_AGENT);
    for (;;) {
        if (F.tid == 0) {
            unsigned c = NUNIT;
            if (until_empty || __hip_atomic_load(done, RLX_AGENT) < (unsigned)F.G) c = __hip_atomic_fetch_add(head, 4u, RLX_AGENT);
            *slot = c;
        }
        __syncthreads();
        const unsigned c = *slot;
        __syncthreads();
        if (c >= NUNIT) break;
#pragma unroll 1
        for (unsigned u = c; u < c + 4 && u < NUNIT; ++u) copy_unit_any<512, 8>(A, u, F.tid);
    }
}
__device__ __forceinline__ void stagger_copy(const Frame& F, const Args& A, int nclaim) {
    volatile LAS unsigned* slot = (volatile LAS unsigned*)(F.lds + MISC_OFF) + 12;
    gu32* head = F.ctl + CW_COPY_HEAD;
#pragma unroll 1
    for (int i = 0; i < nclaim; ++i) {
        if (F.tid == 0) *slot = __hip_atomic_fetch_add(head, 4u, RLX_AGENT);
        __syncthreads();
        const unsigned c = *slot;
        __syncthreads();
        if (c >= NUNIT) break;
#pragma unroll 1
        for (unsigned u = c; u < c + 4 && u < NUNIT; ++u) copy_unit_any<512, 8>(A, u, F.tid);
    }
}
__device__ __forceinline__ void wave_copy(const Frame& F, const Args& A, volatile LAS unsigned* fin) {
    gu32* head = F.ctl + CW_COPY_HEAD;
    for (;;) {
        if (*fin >= 7u) break;
        unsigned c = 0; if (F.lane == 0) c = __hip_atomic_fetch_add(head, 1u, RLX_AGENT);
        c = __builtin_amdgcn_readfirstlane(c);
        if (c >= NUNIT) break;
        copy_unit_any<64, 32>(A, c, F.lane);
    }
}
__device__ __forceinline__ void wave_fin(const Frame& F, volatile LAS unsigned* fin) { if (F.lane == 0) __hip_atomic_fetch_add((LAS unsigned*)fin, 1u, __ATOMIC_RELAXED, __HIP_MEMORY_SCOPE_WORKGROUP); }

__device__ __forceinline__ void p0_prologue(const Frame& F, const Args& A) {
    unsigned char* ws = A.ws;
    LAS float* scr = (LAS float*)(F.lds + F.wave * 16384);
    float* vec = (float*)(ws + WS_VEC);
    const int lane = F.lane;
    constexpr int T_IN0 = 16 * 72, T_OUT0 = 16 * 32, T_W1 = 16 * 128, T_W2 = 64 * 32, T_IN1 = 16 * 64, T_OUT1 = 8 * 32;
    constexpr int NT = T_IN0 + T_OUT0 + 2 * T_W1 + 2 * T_W2 + T_IN1 + T_OUT1;
    for (int it = F.gw; it < NT; it += F.NGW) {
        int r = it;
        if (r < T_IN0) { const int kb = r / 72, nb = r % 72; transpose_tile(A.in[8], N_IN0, in0_src_col(32 * nb), 64 * kb, nullptr, (bf16_t*)(ws + WS_WIN0), DM, 32 * nb, 0, scr, lane); continue; } r -= T_IN0;
        if (r < T_OUT0) { const int kb = r / 32, nb = r % 32; transpose_tile(A.in[12], DM, 32 * nb, 64 * kb, nullptr, (bf16_t*)(ws + WS_WOUT0), DM, 32 * nb, 0, scr, lane); continue; } r -= T_OUT0;
        if (r < 2 * T_W1) { const int L = r / T_W1; r %= T_W1; const int kb = r / 128, nb = r % 128;
            transpose_tile(A.in[20] + (size_t)L * DM * FF, FF, 32 * nb, 64 * kb, A.in[22] + L * DM, (bf16_t*)(ws + (L ? WS_W1_1 : WS_W1_0)), DM, 32 * nb, 0, scr, lane); continue; } r -= 2 * T_W1;
        if (r < 2 * T_W2) { const int L = r / T_W2; r %= T_W2; const int kb = r / 32, nb = r % 32;
            transpose_tile(A.in[21] + (size_t)L * FF * DM, DM, 32 * nb, 64 * kb, nullptr, (bf16_t*)(ws + (L ? WS_W2_1 : WS_W2_0)), FF, 32 * nb, 0, scr, lane); continue; } r -= 2 * T_W2;
        if (r < T_IN1) { const int kb = r / 64, nb = r % 64; transpose_tile(A.in[14], N_IN1, 32 * nb, 64 * kb, A.in[24], (bf16_t*)(ws + WS_WIN1), DM, 32 * nb, 0, scr, lane); continue; } r -= T_IN1;
        { const int kb = r / 32, nb = r % 32; transpose_tile(A.in[18] + (size_t)512 * DM, DM, 32 * nb, 64 * kb, nullptr, (bf16_t*)(ws + WS_WOUT1), DM, 32 * nb, 512, scr, lane); }
    }
    if (F.NGW >= 2048) { const int pf = F.gw - 1024; if (pf >= 0 && pf < 1024) poolfold_item(A.in[16], A.in[17], A.in[18], (bf16_t*)(ws + WS_WOUT1), pf, lane); }
    else for (int it = F.gw; it < 1024; it += F.NGW) poolfold_item(A.in[16], A.in[17], A.in[18], (bf16_t*)(ws + WS_WOUT1), it, lane);
    for (int it = F.gw; it < 640; it += F.NGW) {
        if (it < 256) colsum_item(A.in[20], DM, FF, A.in[22], A.in[23], nullptr, vec + V_CS1_0, vec + V_BW1_0, it, lane);
        else if (it < 512) colsum_item(A.in[20] + (size_t)DM * FF, DM, FF, A.in[22] + DM, A.in[23] + DM, nullptr, vec + V_CS1_1, vec + V_BW1_1, it - 256, lane);
        else colsum_item(A.in[14], DM, N_IN1, A.in[24], A.in[25], A.in[15], vec + V_CSIN1, vec + V_BWIN1, it - 512, lane);
    }
    for (int i = F.gw * 64 + lane; i < N_IN0; i += F.NGW * 64) vec[V_BIN0 + i] = A.in[9][in0_src_col(i)];
    gu32* xq = F.ctl + CW_XQ;
    for (;;) {
        unsigned st_ = 0u; if (lane == 0) st_ = __hip_atomic_fetch_add(xq, 1u, RLX_AGENT);
        const int m0 = (int)__builtin_amdgcn_readfirstlane(st_) * 4;
        if (m0 >= M) break;
        const float* xr = m0 < MP ? A.in[0] + (size_t)m0 * DM : A.in[1] + (size_t)(m0 - MP) * DM;
        const GAS f32x4* x4 = (const GAS f32x4*)xr + lane; GAS u32x2v* o = (GAS u32x2v*)((bf16_t*)(ws + WS_XB) + (size_t)m0 * DM) + lane;
        f32x4 v[16];
#pragma unroll
        for (int j = 0; j < 16; ++j) v[j] = x4[64 * j];
#pragma unroll
        for (int j = 0; j < 16; ++j) { u32x2v w; w.x = pk2(v[j][0], v[j][1]); w.y = pk2(v[j][2], v[j][3]); o[64 * j] = w; }
    }
}
__device__ __forceinline__ float alibi_slope(int h) { return __builtin_amdgcn_exp2f(-(float)(h + 1)); }
typedef float f32x16 __attribute__((ext_vector_type(16)));
typedef short s16x4 __attribute__((ext_vector_type(4)));
typedef short v4i16_t __attribute__((ext_vector_type(4)));
using pg8::bf16x8;
constexpr int VROW = 192;
constexpr int VIMG = 32 * VROW;
constexpr int ST_ROW = 136, ST_M_OFF = 512 * ST_ROW, ST_L_OFF = ST_M_OFF + 2048, ST_BYTES = ST_L_OFF + 2048;
__device__ __forceinline__ s16x4 vtr(LAS const unsigned char* p) { return __builtin_bit_cast(s16x4, __builtin_amdgcn_ds_read_tr16_b64_v4i16((LAS v4i16_t*)p)); }
__device__ __forceinline__ unsigned cvtpk(float lo, float hi) { return pg8::cvt_pk_bf16(lo, hi); }
#define DPP_ADD(v, CTRL) ((v) + __builtin_bit_cast(float, __builtin_amdgcn_update_dpp(0, __builtin_bit_cast(int, (v)), (CTRL), 0xf, 0xf, true)))
__device__ __forceinline__ float row16_sum(float d) {
    d = DPP_ADD(d, 0xB1);
    d = DPP_ADD(d, 0x4E);
    d = DPP_ADD(d, 0x141);
    d = DPP_ADD(d, 0x140);
    return d;
}
__device__ __forceinline__ float xhalf_max(float v) { float a = v, b = v; swap32(a, b); return fmaxf(a, b); }
__device__ __forceinline__ float xhalf_sum(float v) { float a = v, b = v; swap32(a, b); return a + b; }

struct AttnCfg {
    const bf16_t *Q, *K, *V; int qpitch, kvpitch;
    long rowbase;
    int i0, dl; float sl2;
    LAS unsigned char* st; int tl0;
    bf16_t* out; int opitch; float sink2;
};
__device__ __forceinline__ void attn_preload_q(const AttnCfg& c, int lane, bf16x8 (&QF)[4]) {
    const int qi = lane & 31, hh = lane >> 5;
    const long qrow = c.rowbase + (long)c.dl * (c.i0 + qi);
#pragma unroll
    for (int kk = 0; kk < 4; ++kk) QF[kk] = *(const bf16x8*)(c.Q + qrow * c.qpitch + 16 * kk + 8 * hh);
}
__device__ __forceinline__ void attn_preload_kv(const AttnCfg& c, int lane, bf16x8 (&KF)[4], u32x4 (&VV)[4]) {
    const int qi = lane & 31, hh = lane >> 5;
    const long qrow = c.rowbase + (long)c.dl * (c.i0 + qi);
    const char* kp = (const char*)(c.K + qrow * c.kvpitch + 8 * hh);
    const char* vp = (const char*)(c.V + (c.rowbase + (long)c.dl * (c.i0 + (lane >> 3))) * c.kvpitch + 8 * (lane & 7));
    const long vrow8 = (long)16 * c.dl * c.kvpitch;
#pragma unroll
    for (int kk = 0; kk < 4; ++kk) KF[kk] = *(const bf16x8*)(kp + 32 * kk);
#pragma unroll
    for (int i = 0; i < 4; ++i) VV[i] = *(const u32x4*)(vp + (long)i * vrow8);
}
template <bool LOADST, bool FINAL, bool SINK>
__device__ __forceinline__ void attn_item(const AttnCfg& c, LAS unsigned char* vimg, int lane_in, bf16x8 (&qf)[4], bf16x8 (&kf)[4], u32x4 (&vv)[4], bool have_next, const AttnCfg& cn) {
    int lane = lane_in; asm volatile("" : "+v"(lane));
    const int qi = lane & 31, hh = lane >> 5;
    const long qrow = c.rowbase + (long)c.dl * (c.i0 + qi);
    float m, l; f32x16 o[2];
    if (LOADST) {
        const int tl = c.dl * (c.i0 + qi) + c.tl0, rho = tl ^ ((tl >> 5) & 15);
        LAS const unsigned char* sp = c.st + rho * ST_ROW + 8 * hh;
        m = *(LAS const float*)(c.st + ST_M_OFF + 4 * rho); l = *(LAS const float*)(c.st + ST_L_OFF + 4 * rho); l = hh == 0 ? l : 0.f;
#pragma unroll
        for (int cb = 0; cb < 2; ++cb)
#pragma unroll
            for (int g = 0; g < 4; ++g) { const u32x2v w = *(LAS const u32x2v*)(sp + 64 * cb + 16 * g); o[cb][4 * g] = bflo(w.x); o[cb][4 * g + 1] = bfhi(w.x); o[cb][4 * g + 2] = bflo(w.y); o[cb][4 * g + 3] = bfhi(w.y); }
    } else {
        m = -INFINITY; l = 0.f;
#pragma unroll
        for (int r = 0; r < 16; ++r) { o[0][r] = 0.f; o[1][r] = 0.f; }
    }
    const int blk = (lane >> 4) & 1, tq = (lane & 15) >> 2, tp = lane & 3;
    LAS const unsigned char* vrd = vimg + (4 * hh + tq) * VROW + (16 * blk + 4 * tp) * 2;
    LAS unsigned char* vwr = vimg + (lane >> 3) * VROW + (lane & 7) * 16;
    const float e3 = 3.0f * c.sl2, e8 = 8.0f * c.sl2;
    const int ktmin = c.i0 >= 97 ? 0 : (128 - c.i0) / 32;
    const bool edge = c.i0 < 128;
    const char* kbase = (const char*)(c.K + (c.rowbase + (long)c.dl * (c.i0 + qi)) * c.kvpitch + 8 * hh);
    const char* vbase = (const char*)(c.V + (c.rowbase + (long)c.dl * (c.i0 + (lane >> 3))) * c.kvpitch + 8 * (lane & 7));
    const long tstep = (long)64 * c.dl * c.kvpitch, vrow8 = (long)16 * c.dl * c.kvpitch;
#define ATT_LOAD(KT, KF, VV) do { if (!edge) { const char* kp_ = kbase - (long)(4 - (KT)) * tstep; const char* vp_ = vbase - (long)(4 - (KT)) * tstep; \
        _Pragma("unroll") for (int kk = 0; kk < 4; ++kk) KF[kk] = *(const bf16x8*)(kp_ + 32 * kk); \
        _Pragma("unroll") for (int i = 0; i < 4; ++i) VV[i] = *(const u32x4*)(vp_ + (long)i * vrow8); \
      } else { const int pk0_ = c.i0 - 128 + 32 * (KT); const int pk_ = pk0_ + qi; const long krow_ = c.rowbase + (long)c.dl * (pk_ < 0 ? 0 : pk_); \
        _Pragma("unroll") for (int kk = 0; kk < 4; ++kk) KF[kk] = *(const bf16x8*)(c.K + krow_ * c.kvpitch + 16 * kk + 8 * hh); \
        _Pragma("unroll") for (int i = 0; i < 4; ++i) { const int pv_ = pk0_ + (lane >> 3) + 8 * i; const long vrow_ = c.rowbase + (long)c.dl * (pv_ < 0 ? 0 : pv_); \
            VV[i] = *(const u32x4*)(c.V + vrow_ * c.kvpitch + 8 * (lane & 7)); } } } while (0)
    for (int kt = 4; kt >= ktmin; --kt) {
        const int pk0 = c.i0 - 128 + 32 * kt;
        bf16x8 kn[4]; u32x4 vn[4];
#pragma unroll
        for (int kk = 0; kk < 4; ++kk) { kn[kk] = kf[kk]; vn[kk] = vv[kk]; }
        if (kt > ktmin) ATT_LOAD(kt - 1, kn, vn);
        else if (have_next) attn_preload_kv(cn, lane, kn, vn);
        {
          const int dq = qi + 128 - 32 * kt;
          float bg = c.sl2 * (float)(4 * hh - dq);
          f32x16 s;
#pragma unroll
          for (int g = 0; g < 4; ++g) { s[4 * g] = bg; s[4 * g + 1] = bg + c.sl2; s[4 * g + 2] = __builtin_fmaf(c.sl2, 2.0f, bg); s[4 * g + 3] = bg + e3; bg += e8; }
          __builtin_amdgcn_s_setprio(1);
#pragma unroll
          for (int kk = 0; kk < 4; ++kk) s = __builtin_amdgcn_mfma_f32_32x32x16_bf16(kf[kk], qf[kk], s, 0, 0, 0);
          __builtin_amdgcn_s_setprio(0);
          asm volatile("" ::: "memory");
          if (kt == ktmin && have_next) attn_preload_q(cn, lane, qf);
#pragma unroll
          for (int i = 0; i < 4; ++i) *(LAS u32x4*)(vwr + 8 * i * VROW) = vv[i];
          if (kt == 4 || kt == 0 || pk0 < 0) {
#pragma unroll
              for (int r = 0; r < 16; ++r) { const int ko = (r & 3) + 8 * (r >> 2) + 4 * hh, dist = dq - ko;
                  const bool ok = (dist >= 0) & (dist <= 128) & (pk0 + ko >= 0);
                  s[r] = ok ? s[r] : -INFINITY; }
          }
          float tmax = fmaxf(fmaxf(s[0], s[1]), fmaxf(s[2], s[3]));
#pragma unroll
          for (int r = 4; r < 16; r += 4) tmax = fmaxf(tmax, fmaxf(fmaxf(s[r], s[r + 1]), fmaxf(s[r + 2], s[r + 3])));
          tmax = xhalf_max(tmax);
          const float mnew = fmaxf(m, tmax), scl = __builtin_amdgcn_exp2f(m - mnew);
          m = mnew; l *= scl;
#pragma unroll
          for (int r = 0; r < 16; ++r) { o[0][r] *= scl; o[1][r] *= scl; }
          float ps = 0.f;
#pragma unroll
          for (int r = 0; r < 16; ++r) { s[r] = __builtin_amdgcn_exp2f(s[r] - mnew); ps += s[r]; }
          l += ps;
          u32x4 pw0, pw1;
          pw0.x = cvtpk(s[0], s[1]); pw0.y = cvtpk(s[2], s[3]); pw0.z = cvtpk(s[4], s[5]); pw0.w = cvtpk(s[6], s[7]);
          pw1.x = cvtpk(s[8], s[9]); pw1.y = cvtpk(s[10], s[11]); pw1.z = cvtpk(s[12], s[13]); pw1.w = cvtpk(s[14], s[15]);
          const bf16x8 pf0 = __builtin_bit_cast(bf16x8, pw0), pf1 = __builtin_bit_cast(bf16x8, pw1);
          asm volatile("s_waitcnt lgkmcnt(0)" ::: "memory");
#pragma unroll
          for (int cb = 0; cb < 2; ++cb) {
              const s16x4 a0 = vtr(vrd + (0) * VROW + cb * 64), a1 = vtr(vrd + (8) * VROW + cb * 64), b0 = vtr(vrd + (16) * VROW + cb * 64), b1 = vtr(vrd + (24) * VROW + cb * 64);
              const bf16x8 vf0 = (bf16x8){a0[0], a0[1], a0[2], a0[3], a1[0], a1[1], a1[2], a1[3]}, vf1 = (bf16x8){b0[0], b0[1], b0[2], b0[3], b1[0], b1[1], b1[2], b1[3]};
              __builtin_amdgcn_s_setprio(1);
              o[cb] = __builtin_amdgcn_mfma_f32_32x32x16_bf16(vf0, pf0, o[cb], 0, 0, 0);
              o[cb] = __builtin_amdgcn_mfma_f32_32x32x16_bf16(vf1, pf1, o[cb], 0, 0, 0);
              __builtin_amdgcn_s_setprio(0);
          }
          asm volatile("s_waitcnt lgkmcnt(0)" ::: "memory");
        }
#pragma unroll
        for (int kk = 0; kk < 4; ++kk) { kf[kk] = kn[kk]; vv[kk] = vn[kk]; }
    }
#undef ATT_LOAD
    float lt = xhalf_sum(l);
    if (FINAL) {
        if (SINK) lt += __builtin_amdgcn_exp2f(c.sink2 - m);
        const float inv = 1.0f / lt;
        bf16_t* op = c.out + qrow * c.opitch;
#pragma unroll
        for (int cb = 0; cb < 2; ++cb)
#pragma unroll
            for (int gp = 0; gp < 4; gp += 2) {
                unsigned ax = cvtpk(o[cb][4 * gp] * inv, o[cb][4 * gp + 1] * inv), ay = cvtpk(o[cb][4 * gp + 2] * inv, o[cb][4 * gp + 3] * inv);
                unsigned bx = cvtpk(o[cb][4 * gp + 4] * inv, o[cb][4 * gp + 5] * inv), by = cvtpk(o[cb][4 * gp + 6] * inv, o[cb][4 * gp + 7] * inv);
                swap32(ax, bx); swap32(ay, by);
                *(u32x4*)(op + 32 * cb + 8 * (gp + hh)) = (u32x4){ax, ay, bx, by}; }
    } else {
        const int tl = c.dl * (c.i0 + qi) + c.tl0, rho = tl ^ ((tl >> 5) & 15);
        LAS unsigned char* sp = c.st + rho * ST_ROW + 8 * hh;
#pragma unroll
        for (int cb = 0; cb < 2; ++cb)
#pragma unroll
            for (int g = 0; g < 4; ++g) { u32x2v w; w.x = cvtpk(o[cb][4 * g], o[cb][4 * g + 1]); w.y = cvtpk(o[cb][4 * g + 2], o[cb][4 * g + 3]); *(LAS u32x2v*)(sp + 64 * cb + 16 * g) = w; }
        if (hh == 0) { *(LAS float*)(c.st + ST_M_OFF + 4 * rho) = m; *(LAS float*)(c.st + ST_L_OFF + 4 * rho) = lt; }
    }
}

struct SAttnCfg {
    const bf16_t* q;
    const float *kc, *vc; int cpitch;
    const bf16_t *kn, *vn; int npitch;
    int nh, i, dl; float sl2;
};
template <bool SINK>
__device__ __forceinline__ void sattn_item(const SAttnCfg& c, float sink2, bf16_t* out, float& m_io, float& l_io, f32x4& o_io, bool first, bool last, int lane_in) {
    int lane = lane_in; asm volatile("" : "+v"(lane));
    int qd = lane >> 4; const int sub = lane & 15;
    asm volatile("" : "+v"(qd));
    f32x4 qv; { const u32x2v w = *(const u32x2v*)(c.q + 4 * sub); qv = (f32x4){bflo(w.x), bfhi(w.x), bflo(w.y), bfhi(w.y)}; }
#define SA_ROW(IT, CACHE, NEW, DST) do { const int j_ = 4 * (IT) + qd, row_ = c.nh + c.i - j_ * c.dl; const int rc_ = row_ < 0 ? 0 : (row_ >= c.nh ? c.nh - 1 : row_); \
        DST = *(const f32x4*)((CACHE) + (size_t)rc_ * c.cpitch + 4 * sub); \
        if ((IT) < 3) { const int rn_ = row_ - c.nh; const u32x2v w_ = *(const u32x2v*)((NEW) + (size_t)(rn_ < 0 ? 0 : rn_) * c.npitch + 4 * sub); \
            if (rn_ >= 0) DST = (f32x4){bflo(w_.x), bfhi(w_.x), bflo(w_.y), bfhi(w_.y)}; } } while (0)
    float sc[33];
    {
        f32x4 kv[33];
#pragma unroll
        for (int it = 0; it < 33; ++it) SA_ROW(it, c.kc, c.kn, kv[it]);
#pragma unroll
        for (int it = 0; it < 33; ++it) {
            const int j = 4 * it + qd;
            float d = (qv[0] * kv[it][0] + qv[1] * kv[it][1]) + (qv[2] * kv[it][2] + qv[3] * kv[it][3]);
            d = row16_sum(d);
            sc[it] = j <= 128 ? d - c.sl2 * (float)j : -INFINITY;
        }
    }
    float tm = sc[0];
#pragma unroll
    for (int it = 1; it < 33; ++it) tm = fmaxf(tm, sc[it]);
    tm = fmaxf(tm, __shfl_xor(tm, 16)); tm = fmaxf(tm, __shfl_xor(tm, 32));
    float m = first ? tm : fmaxf(m_io, tm);
    const float scl = first ? 0.f : __builtin_amdgcn_exp2f(m_io - m);
    float l = first ? 0.f : l_io * scl; f32x4 o = first ? (f32x4){0.f, 0.f, 0.f, 0.f} : o_io * scl;
    float ps = 0.f; f32x4 oa = (f32x4){0.f, 0.f, 0.f, 0.f};
    {
        f32x4 vv[33];
#pragma unroll
        for (int it = 0; it < 33; ++it) SA_ROW(it, c.vc, c.vn, vv[it]);
#pragma unroll
        for (int it = 0; it < 33; ++it) { const float p = __builtin_amdgcn_exp2f(sc[it] - m); ps += p; oa += vv[it] * p; }
    }
#undef SA_ROW
    ps += __shfl_xor(ps, 16); ps += __shfl_xor(ps, 32);
#pragma unroll
    for (int e = 0; e < 4; ++e) { float t = oa[e]; t += __shfl_xor(t, 16); t += __shfl_xor(t, 32); oa[e] = t; }
    l += ps; o += oa;
    if (last) {
        if (SINK) l += __builtin_amdgcn_exp2f(sink2 - m);
        const float inv = 1.0f / l;
        if (qd == 0) { u32x2v w; w.x = cvtpk(o[0] * inv, o[1] * inv); w.y = cvtpk(o[2] * inv, o[3] * inv); *(u32x2v*)(out + 4 * sub) = w; }
    }
    m_io = m; l_io = l; o_io = o;
}

__device__ __forceinline__ bf16x8 cvt8(const f32x4 a, const f32x4 b) { u32x4 w; w.x = cvtpk(a[0], a[1]); w.y = cvtpk(a[2], a[3]); w.z = cvtpk(b[0], b[1]); w.w = cvtpk(b[2], b[3]); return __builtin_bit_cast(bf16x8, w); }
__device__ __forceinline__ void sattn_a_item(const bf16_t* Q, const float* kc, const float* vc, const bf16_t* KN, const bf16_t* VN, const float* sinks, bf16_t* MIX, int b, int kvh, LAS unsigned char* vimg, int lane_in) {
    int lane = lane_in; asm volatile("" : "+v"(lane));
    const int qi = lane & 31, hh = lane >> 5, g = qi >> 3, i = qi & 7, h = kvh * 4 + g;
    const long row0 = MP + (long)b * NST;
    bf16x8 qf[4];
#pragma unroll
    for (int kk = 0; kk < 4; ++kk) qf[kk] = *(const bf16x8*)(Q + (row0 + i) * 512 + h * 64 + 16 * kk + 8 * hh);
    const float sl2 = alibi_slope(h) * LOG2E, sink2 = sinks[h] * LOG2E;
    float cko[16];
#pragma unroll
    for (int r = 0; r < 16; ++r) cko[r] = sl2 * (float)((r & 3) + 8 * (r >> 2) + 4 * hh);
    float m = -INFINITY, l = 0.f; f32x16 o[2];
#pragma unroll
    for (int r = 0; r < 16; ++r) { o[0][r] = 0.f; o[1][r] = 0.f; }
    const int blk = (lane >> 4) & 1, tq = (lane & 15) >> 2, tp = lane & 3;
    LAS const unsigned char* vrd = vimg + (4 * hh + tq) * VROW + (16 * blk + 4 * tp) * 2;
    LAS unsigned char* vwr = vimg + (lane >> 3) * VROW + (lane & 7) * 16;
    const float* kcb = kc + (size_t)b * NA_HIST * 128 + kvh * 64; const float* vcb = vc + (size_t)b * NA_HIST * 128 + kvh * 64;
#pragma unroll 1
    for (int kt = 4; kt >= 0; --kt) {
        bf16x8 kf[4]; u32x4 vv[4];
        if (kt == 4) {
            const int ko = lane & 31;
#pragma unroll
            for (int kk = 0; kk < 4; ++kk) kf[kk] = *(const bf16x8*)(KN + (row0 + (ko < 8 ? ko : 0)) * 128 + kvh * 64 + 16 * kk + 8 * hh);
#pragma unroll
            for (int q4 = 0; q4 < 4; ++q4) { const int vr = (lane >> 3) + 8 * q4; vv[q4] = *(const u32x4*)(VN + (row0 + (vr < 8 ? vr : 0)) * 128 + kvh * 64 + 8 * (lane & 7)); }
        } else {
            const int r = 32 * kt + (lane & 31);
#pragma unroll
            for (int kk = 0; kk < 4; ++kk) { const float* p = kcb + (size_t)r * 128 + 16 * kk + 8 * hh; kf[kk] = cvt8(*(const f32x4*)p, *(const f32x4*)(p + 4)); }
#pragma unroll
            for (int q4 = 0; q4 < 4; ++q4) { const int vr = 32 * kt + (lane >> 3) + 8 * q4; const float* p = vcb + (size_t)vr * 128 + 8 * (lane & 7); vv[q4] = __builtin_bit_cast(u32x4, cvt8(*(const f32x4*)p, *(const f32x4*)(p + 4))); }
        }
        const float base = -sl2 * (float)(128 + i - 32 * kt);
        f32x16 s;
#pragma unroll
        for (int r = 0; r < 16; ++r) s[r] = base + cko[r];
#pragma unroll
        for (int kk = 0; kk < 4; ++kk) s = __builtin_amdgcn_mfma_f32_32x32x16_bf16(kf[kk], qf[kk], s, 0, 0, 0);
        asm volatile("" ::: "memory");
#pragma unroll
        for (int q4 = 0; q4 < 4; ++q4) *(LAS u32x4*)(vwr + 8 * q4 * VROW) = vv[q4];
        if (kt == 4 || kt == 0) {
#pragma unroll
            for (int r = 0; r < 16; ++r) { const int ko = (r & 3) + 8 * (r >> 2) + 4 * hh; const bool ok = kt == 4 ? (ko <= i) : (ko >= i); s[r] = ok ? s[r] : -INFINITY; }
        }
        float tmax = fmaxf(fmaxf(s[0], s[1]), fmaxf(s[2], s[3]));
#pragma unroll
        for (int r = 4; r < 16; r += 4) tmax = fmaxf(tmax, fmaxf(fmaxf(s[r], s[r + 1]), fmaxf(s[r + 2], s[r + 3])));
        tmax = xhalf_max(tmax);
        const float mnew = fmaxf(m, tmax), scl = __builtin_amdgcn_exp2f(m - mnew);
        m = mnew; l *= scl;
#pragma unroll
        for (int r = 0; r < 16; ++r) { o[0][r] *= scl; o[1][r] *= scl; }
        float ps = 0.f;
#pragma unroll
        for (int r = 0; r < 16; ++r) { s[r] = __builtin_amdgcn_exp2f(s[r] - mnew); ps += s[r]; }
        l += ps;
        u32x4 pw0, pw1;
        pw0.x = cvtpk(s[0], s[1]); pw0.y = cvtpk(s[2], s[3]); pw0.z = cvtpk(s[4], s[5]); pw0.w = cvtpk(s[6], s[7]);
        pw1.x = cvtpk(s[8], s[9]); pw1.y = cvtpk(s[10], s[11]); pw1.z = cvtpk(s[12], s[13]); pw1.w = cvtpk(s[14], s[15]);
        const bf16x8 pf0 = __builtin_bit_cast(bf16x8, pw0), pf1 = __builtin_bit_cast(bf16x8, pw1);
        asm volatile("s_waitcnt lgkmcnt(0)" ::: "memory");
#pragma unroll
        for (int cb = 0; cb < 2; ++cb) {
            const s16x4 a0 = vtr(vrd + (0) * VROW + cb * 64), a1 = vtr(vrd + (8) * VROW + cb * 64), b0 = vtr(vrd + (16) * VROW + cb * 64), b1 = vtr(vrd + (24) * VROW + cb * 64);
            const bf16x8 vf0 = (bf16x8){a0[0], a0[1], a0[2], a0[3], a1[0], a1[1], a1[2], a1[3]}, vf1 = (bf16x8){b0[0], b0[1], b0[2], b0[3], b1[0], b1[1], b1[2], b1[3]};
            o[cb] = __builtin_amdgcn_mfma_f32_32x32x16_bf16(vf0, pf0, o[cb], 0, 0, 0);
            o[cb] = __builtin_amdgcn_mfma_f32_32x32x16_bf16(vf1, pf1, o[cb], 0, 0, 0);
        }
        asm volatile("s_waitcnt lgkmcnt(0)" ::: "memory");
    }
    float lt = xhalf_sum(l) + __builtin_amdgcn_exp2f(sink2 - m);
    const float inv = 1.0f / lt;
    bf16_t* op = MIX + (row0 + i) * DM + h * 64;
#pragma unroll
    for (int cb = 0; cb < 2; ++cb)
#pragma unroll
        for (int gq = 0; gq < 4; ++gq) { u32x2v w; w.x = cvtpk(o[cb][4 * gq] * inv, o[cb][4 * gq + 1] * inv); w.y = cvtpk(o[cb][4 * gq + 2] * inv, o[cb][4 * gq + 3] * inv);
            *(u32x2v*)(op + 32 * cb + 8 * gq + 4 * hh) = w; }
}
constexpr int FD_LDS = 3 * 8 * 132 * 4;
__device__ __forceinline__ f32x4 ldq4(const bf16_t* p) { const u32x2v w = *(const u32x2v*)p; return (f32x4){bflo(w.x), bfhi(w.x), bflo(w.y), bfhi(w.y)}; }
__device__ __forceinline__ float dot4(const f32x4 a, const f32x4 b) { return (a[0] * b[0] + a[1] * b[1]) + (a[2] * b[2] + a[3] * b[3]); }
template <bool VPASS>
__device__ __forceinline__ void fd_stream(const float* cc, float* co, const f32x4 qa, const f32x4 qb, f32x4& oa, f32x4& ob, LAS float* Sc, float sl4, float sl16, int qd, int sub) {
#pragma unroll 1
    for (int s0 = 0; s0 < 192; s0 += 16) {
        f32x4 rv[16];
#pragma unroll
        for (int u = 0; u < 16; ++u) { const int it = 4 * ((s0 + u) >> 1) + (u & 1); rv[u] = __builtin_nontemporal_load((const f32x4*)(cc + (size_t)(4 * it + qd) * 512 + 4 * sub)); }
#pragma unroll
        for (int u = 0; u < 16; ++u) {
            const int it = 4 * ((s0 + u) >> 1) + (u & 1), pos = 4 * it + qd, j16 = 128 - (it >> 2);
            if (s0 > 0 || u >= 2) __builtin_nontemporal_store(rv[u], (f32x4*)(co + (size_t)(pos - 8) * 512 + 4 * sub));
            if (!VPASS) {
                const float d = row16_sum(dot4((u & 1) ? qb : qa, rv[u]));
                if (sub == 0) Sc[(16 + qd + 4 * (u & 1)) * 132 + j16] = d - sl16 * (float)j16;
            } else {
                if (u & 1) ob += rv[u] * Sc[(16 + qd + 4) * 132 + j16]; else oa += rv[u] * Sc[(16 + qd) * 132 + j16];
            }
        }
    }
#pragma unroll 1
    for (int it0 = 384; it0 < 512; it0 += 16) {
        f32x4 rv[16];
#pragma unroll
        for (int u = 0; u < 16; ++u) rv[u] = __builtin_nontemporal_load((const f32x4*)(cc + (size_t)(4 * (it0 + u) + qd) * 512 + 4 * sub));
#pragma unroll
        for (int u = 0; u < 16; ++u) {
            const int it = it0 + u, pos = 4 * it + qd;
            __builtin_nontemporal_store(rv[u], (f32x4*)(co + (size_t)(pos - 8) * 512 + 4 * sub));
            const int ph = u & 3, j16 = 128 - (it >> 2), j1 = 512 - it, j2 = 513 - it;
            if (!VPASS) {
                const float da = row16_sum(dot4(qa, rv[u])), db = row16_sum(dot4(qb, rv[u]));
                if (sub == 0) {
                    if (ph == 0) Sc[(16 + qd) * 132 + j16] = da - sl16 * (float)j16;
                    if (ph == 1) Sc[(16 + qd + 4) * 132 + j16] = db - sl16 * (float)j16;
                    Sc[(8 + qd) * 132 + j1] = da - sl4 * (float)j1; if (j2 <= 128) Sc[(8 + qd + 4) * 132 + j2] = db - sl4 * (float)j2;
                }
            } else {
                if (ph == 0) oa += rv[u] * Sc[(16 + qd) * 132 + j16];
                if (ph == 1) ob += rv[u] * Sc[(16 + qd + 4) * 132 + j16];
                oa += rv[u] * Sc[(8 + qd) * 132 + j1]; if (j2 <= 128) ob += rv[u] * Sc[(8 + qd + 4) * 132 + j2];
            }
        }
    }
}
__device__ __forceinline__ void fused_d_item(const Args& A, int b, int h, LAS float* Sc, int lane_in) {
    int lane = lane_in; asm volatile("" : "+v"(lane));
    const int qd = lane >> 4, sub = lane & 15;
    unsigned char* ws = A.ws;
    const bf16_t* Q = (const bf16_t*)(ws + WS_Q); const bf16_t* KN = (const bf16_t*)(ws + WS_K); const bf16_t* VN = (const bf16_t*)(ws + WS_V); bf16_t* MIX = (bf16_t*)(ws + WS_MIX);
    const long row0 = MP + (long)b * NST;
    const float* kc = A.in[6] + (size_t)b * ND_HIST * 512 + h * 64; const float* vc = A.in[7] + (size_t)b * ND_HIST * 512 + h * 64;
    float* ko = A.out + O_DKS + (size_t)b * ND_HIST * 512 + h * 64; float* vo = A.out + O_DVS + (size_t)b * ND_HIST * 512 + h * 64;
    const float slope = alibi_slope(h) * LOG2E, sl1 = slope, sl4 = 4.f * slope, sl16 = 16.f * slope;
    for (int e = lane; e < 3 * 8 * 132; e += 64) Sc[e] = -INFINITY;
    f32x4 q[8];
#pragma unroll
    for (int i = 0; i < 8; ++i) q[i] = ldq4(Q + (row0 + i) * 512 + h * 64 + 4 * sub);
    const f32x4 qa = qd == 0 ? q[0] : qd == 1 ? q[1] : qd == 2 ? q[2] : q[3], qb = qd == 0 ? q[4] : qd == 1 ? q[5] : qd == 2 ? q[6] : q[7];
    asm volatile("s_waitcnt lgkmcnt(0)" ::: "memory");
    f32x4 oa = (f32x4){0.f, 0.f, 0.f, 0.f}, ob = oa;
    fd_stream<false>(kc, ko, qa, qb, oa, ob, Sc, sl4, sl16, qd, sub);
#pragma unroll 1
    for (int it0 = 480; it0 < 512; it0 += 8) {
        f32x4 rv[8];
#pragma unroll
        for (int u = 0; u < 8; ++u) rv[u] = *(const f32x4*)(kc + (size_t)(4 * (it0 + u) + qd) * 512 + 4 * sub);
#pragma unroll
        for (int u = 0; u < 8; ++u) { const int pos = 4 * (it0 + u) + qd;
#pragma unroll
            for (int i = 0; i < 8; ++i) { const float d = row16_sum(dot4(q[i], rv[u])); const int j = 2048 + i - pos; if (sub == 0 && j <= 128) Sc[i * 132 + j] = d - sl1 * (float)j; } }
    }
#pragma unroll
    for (int s2 = 0; s2 < 2; ++s2) { const int r = 4 * s2 + qd; const f32x4 kn = ldq4(KN + (row0 + r) * 512 + h * 64 + 4 * sub);
#pragma unroll
        for (int i = 0; i < 8; ++i) { const float d = row16_sum(dot4(q[i], kn)); const int dd = i - r;
            if (sub == 0 && dd >= 0) { Sc[i * 132 + dd] = d - sl1 * (float)dd; if ((dd & 3) == 0) Sc[(8 + i) * 132 + (dd >> 2)] = d - sl4 * (float)(dd >> 2); if (dd == 0) Sc[(16 + i) * 132] = d; } } }
    asm volatile("s_waitcnt lgkmcnt(0)" ::: "memory");
    float linv[8];
#pragma unroll
    for (int i = 0; i < 8; ++i) {
        float sv[7], mx = -INFINITY;
#pragma unroll
        for (int t = 0; t < 7; ++t) { const int e = lane + 64 * t, br = e / 129, j = e - br * 129; sv[t] = e < 387 ? Sc[(br * 8 + i) * 132 + j] : -INFINITY; mx = fmaxf(mx, sv[t]); }
        mx = wave_max(mx);
        float ps = 0.f;
#pragma unroll
        for (int t = 0; t < 7; ++t) { const int e = lane + 64 * t, br = e / 129, j = e - br * 129; const float p = __builtin_amdgcn_exp2f(sv[t] - mx); if (e < 387) { Sc[(br * 8 + i) * 132 + j] = p; ps += p; } }
        linv[i] = 1.0f / wave_sum(ps);
    }
    asm volatile("s_waitcnt lgkmcnt(0)" ::: "memory");
    fd_stream<true>(vc, vo, qa, qb, oa, ob, Sc, sl4, sl16, qd, sub);
    f32x4 o1[8];
#pragma unroll
    for (int i = 0; i < 8; ++i) o1[i] = (f32x4){0.f, 0.f, 0.f, 0.f};
#pragma unroll 1
    for (int it0 = 480; it0 < 512; it0 += 8) {
        f32x4 rv[8];
#pragma unroll
        for (int u = 0; u < 8; ++u) rv[u] = *(const f32x4*)(vc + (size_t)(4 * (it0 + u) + qd) * 512 + 4 * sub);
#pragma unroll
        for (int u = 0; u < 8; ++u) { const int pos = 4 * (it0 + u) + qd;
#pragma unroll
            for (int i = 0; i < 8; ++i) { const int j = 2048 + i - pos; const float p = j <= 128 ? Sc[i * 132 + j] : 0.f; o1[i] += rv[u] * p; } }
    }
#pragma unroll
    for (int s2 = 0; s2 < 2; ++s2) { const int r = 4 * s2 + qd; const f32x4 vn = ldq4(VN + (row0 + r) * 512 + h * 64 + 4 * sub);
#pragma unroll
        for (int i = 0; i < 8; ++i) { const int dd = i - r; float p = 0.f;
            if (dd >= 0) { p = Sc[i * 132 + dd]; if ((dd & 3) == 0) p += Sc[(8 + i) * 132 + (dd >> 2)]; if (dd == 0) p += Sc[(16 + i) * 132]; }
            o1[i] += vn * p; } }
#pragma unroll
    for (int i = 0; i < 8; ++i) {
        f32x4 t = o1[i];
#pragma unroll
        for (int e = 0; e < 4; ++e) { float x = t[e]; x += __shfl_xor(x, 16); x += __shfl_xor(x, 32); t[e] = x; }
        if (qd == (i & 3)) { t += (i < 4 ? oa : ob); t = t * linv[i];
            u32x2v w; w.x = cvtpk(t[0], t[1]); w.y = cvtpk(t[2], t[3]); *(u32x2v*)(MIX + (row0 + i) * DM + 512 + h * 64 + 4 * sub) = w; }
    }
}
__device__ __forceinline__ void ld8(const bf16_t* p, float (&v)[8]) { const u32x4 w = *(const u32x4*)p; v[0] = bflo(w.x); v[1] = bfhi(w.x); v[2] = bflo(w.y); v[3] = bfhi(w.y); v[4] = bflo(w.z); v[5] = bfhi(w.z); v[6] = bflo(w.w); v[7] = bfhi(w.w); }
__device__ __forceinline__ void ld8f(const float* p, float (&v)[8]) { const f32x4 a = *(const f32x4*)p, b = *(const f32x4*)(p + 4); v[0] = a[0]; v[1] = a[1]; v[2] = a[2]; v[3] = a[3]; v[4] = b[0]; v[5] = b[1]; v[6] = b[2]; v[7] = b[3]; }
__device__ __forceinline__ void st8(bf16_t* p, const float (&v)[8]) { u32x4 w; w.x = cvtpk(v[0], v[1]); w.y = cvtpk(v[2], v[3]); w.z = cvtpk(v[4], v[5]); w.w = cvtpk(v[6], v[7]); *(u32x4*)p = w; }
__device__ __forceinline__ void conv_item(const Args& A, int item, int lane_in) {
    int lane = lane_in; asm volatile("" : "+v"(lane));
    unsigned char* ws = A.ws; const bf16_t* C = (const bf16_t*)(ws + WS_C); const bf16_t* GB = (const bf16_t*)(ws + WS_GB); bf16_t* MIX = (bf16_t*)(ws + WS_MIX);
    const int c0 = 8 * lane;
    float w0[8], w1[8], w2[8], cm2[8], cm1[8];
    ld8f(A.in[11] + c0, w0); ld8f(A.in[11] + 512 + c0, w1); ld8f(A.in[11] + 1024 + c0, w2);
    long row0; int nrow;
    if (item < 1024) {
        const int b = item >> 7, t0 = (item & 127) * 32; row0 = (long)b * SEQ + t0; nrow = 32;
        if (t0 == 0) {
#pragma unroll
            for (int e = 0; e < 8; ++e) { cm2[e] = 0.f; cm1[e] = 0.f; }
        } else { ld8(C + (row0 - 2) * 512 + c0, cm2); ld8(C + (row0 - 1) * 512 + c0, cm1); }
    } else {
        const int b = item - 1024; row0 = MP + (long)b * NST; nrow = NST;
        ld8f(A.in[4] + (size_t)(b * 2 + 0) * 512 + c0, cm2); ld8f(A.in[4] + (size_t)(b * 2 + 1) * 512 + c0, cm1);
    }
    for (int t0 = 0; t0 < nrow; t0 += 4) {
        u32x4 cw[4], gw[4];
#pragma unroll
        for (int k = 0; k < 4; ++k) { cw[k] = *(const u32x4*)(C + (row0 + t0 + k) * 512 + c0); gw[k] = *(const u32x4*)(GB + (row0 + t0 + k) * 512 + c0); }
#pragma unroll
        for (int k = 0; k < 4; ++k) {
            float cc[8], gb[8], y[8];
            cc[0] = bflo(cw[k].x); cc[1] = bfhi(cw[k].x); cc[2] = bflo(cw[k].y); cc[3] = bfhi(cw[k].y); cc[4] = bflo(cw[k].z); cc[5] = bfhi(cw[k].z); cc[6] = bflo(cw[k].w); cc[7] = bfhi(cw[k].w);
            gb[0] = bflo(gw[k].x); gb[1] = bfhi(gw[k].x); gb[2] = bflo(gw[k].y); gb[3] = bfhi(gw[k].y); gb[4] = bflo(gw[k].z); gb[5] = bfhi(gw[k].z); gb[6] = bflo(gw[k].w); gb[7] = bfhi(gw[k].w);
#pragma unroll
            for (int e = 0; e < 8; ++e) { y[e] = gb[e] * (w0[e] * cm2[e] + w1[e] * cm1[e] + w2[e] * cc[e]); cm2[e] = cm1[e]; cm1[e] = cc[e]; }
            st8(MIX + (row0 + t0 + k) * DM + 512 + c0, y);
        }
    }
}

__device__ __forceinline__ void pool_item(const Args& A, int item, int lane_in) {
    int lane = lane_in; asm volatile("" : "+v"(lane));
    unsigned char* ws = A.ws; const bf16_t* U = (const bf16_t*)(ws + WS_C); bf16_t* MIX = (bf16_t*)(ws + WS_MIX);
    const int c0 = 8 * lane, w = 2 << (lane >> 4);
    if (item < 1024) {
        const int b = item >> 7, t0 = (item & 127) * 32; const long rb = (long)b * SEQ;
        float S[8];
#pragma unroll
        for (int e = 0; e < 8; ++e) S[e] = 0.f;
        for (int k = 1; k < w; ++k) { const int t = t0 - k; if (t >= 0) { float u[8]; ld8(U + (rb + t) * 512 + c0, u);
#pragma unroll
            for (int e = 0; e < 8; ++e) S[e] += u[e]; } }
        for (int tb = t0; tb < t0 + 32; tb += 4) {
            u32x4 uw[4], ow[4];
#pragma unroll
            for (int k = 0; k < 4; ++k) { const int t = tb + k, tl = t - w + 1; uw[k] = *(const u32x4*)(U + (rb + t) * 512 + c0); ow[k] = *(const u32x4*)(U + (rb + (tl < 0 ? 0 : tl)) * 512 + c0); }
#pragma unroll
            for (int k = 0; k < 4; ++k) {
                const int t = tb + k; float u[8], o[8], y[8];
                u[0] = bflo(uw[k].x); u[1] = bfhi(uw[k].x); u[2] = bflo(uw[k].y); u[3] = bfhi(uw[k].y); u[4] = bflo(uw[k].z); u[5] = bfhi(uw[k].z); u[6] = bflo(uw[k].w); u[7] = bfhi(uw[k].w);
                o[0] = bflo(ow[k].x); o[1] = bfhi(ow[k].x); o[2] = bflo(ow[k].y); o[3] = bfhi(ow[k].y); o[4] = bflo(ow[k].z); o[5] = bfhi(ow[k].z); o[6] = bflo(ow[k].w); o[7] = bfhi(ow[k].w);
                const float inv = 1.0f / (float)(t + 1 < w ? t + 1 : w); const bool sub = t - w + 1 >= 0;
#pragma unroll
                for (int e = 0; e < 8; ++e) { S[e] += u[e]; y[e] = S[e] * inv - u[e]; if (sub) S[e] -= o[e]; }
                st8(MIX + (rb + t) * DM + c0, y);
            }
        }
    } else {
        const int b = item - 1024; const long rb = MP + (long)b * NST; const float inv = 1.0f / (float)w;
        for (int i = 0; i < NST; ++i) {
            float S[8], ui[8], y[8];
#pragma unroll
            for (int e = 0; e < 8; ++e) S[e] = 0.f;
            for (int k = 0; k < w; ++k) { const int idx = 15 + i - k; float u[8];
                if (idx >= 15) ld8(U + (rb + idx - 15) * 512 + c0, u); else ld8f(A.in[5] + ((size_t)b * 15 + idx) * 512 + c0, u);
#pragma unroll
                for (int e = 0; e < 8; ++e) S[e] += u[e]; }
            ld8(U + (rb + i) * 512 + c0, ui);
#pragma unroll
            for (int e = 0; e < 8; ++e) y[e] = S[e] * inv - ui[e];
            st8(MIX + (rb + i) * DM + c0, y);
        }
    }
}

#ifndef REP_ATT
#define REP_ATT 1
#endif
#ifndef REP_FUSED
#define REP_FUSED 1
#endif
#ifndef REP_CP
#define REP_CP 1
#endif
#ifndef REP_SATT
#define REP_SATT 1
#endif

__device__ __forceinline__ void mixer0(const Frame& F, const Args& A) {
    unsigned char* ws = A.ws; const int lane = F.lane;
    const bf16_t* Q = (const bf16_t*)(ws + WS_Q); const bf16_t* K = (const bf16_t*)(ws + WS_K); const bf16_t* V = (const bf16_t*)(ws + WS_V); bf16_t* MIX = (bf16_t*)(ws + WS_MIX);
    LAS unsigned char* vimg = F.lds + F.wave * VIMG;
    const int gw7 = F.gw, NGW7 = F.NGW;
    const bool conv_first = F.wave >= 4;
    if (conv_first) { for (int it = gw7; it < 1024 + NSB; it += NGW7) conv_item(A, it, lane); }
    {
        const int nun = (512 - (int)blockIdx.x + F.G - 1) / F.G, nit = 2 * nun;
        auto acfg = [&](int idx) {
            const int un = blockIdx.x + (idx >> 1) * F.G, k = idx & 1;
            const int kvh = un & 1, ch = (un >> 1) & 31, b = un >> 6;
            const int it = F.wave * 2 + k, g = it >> 2, qt = it & 3, h = kvh * 4 + g;
            AttnCfg c; c.Q = Q + h * 64; c.K = K + kvh * 64; c.V = V + kvh * 64; c.qpitch = 512; c.kvpitch = 128; c.rowbase = (long)b * SEQ; c.i0 = ch * 128 + qt * 32; c.dl = 1;
            c.sl2 = alibi_slope(h) * LOG2E; c.st = nullptr; c.tl0 = 0; c.out = MIX + h * 64; c.opitch = DM; c.sink2 = A.in[10][h] * LOG2E;
            return c;
        };
        bf16x8 qf[4], kf[4]; u32x4 vv[4];
        AttnCfg c = acfg(0); attn_preload_q(c, lane, qf); attn_preload_kv(c, lane, kf, vv);
#pragma unroll 1
        for (int idx = 0; idx < nit; ++idx) {
            const bool hn = idx + 1 < nit; const AttnCfg cn = acfg(hn ? idx + 1 : idx);
            attn_item<false, true, true>(c, vimg, lane, qf, kf, vv, hn, cn);
            c = cn;
        }
    }
    if (!conv_first) { for (int it = gw7; it < 1024 + NSB; it += NGW7) conv_item(A, it, lane); }
    for (int rep_ = 0; rep_ < REP_SATT; ++rep_)
    {
        const int free0 = 1024 + NSB;
        if (NGW7 >= free0 + 3 * NSB * 2) { const int q = gw7 - free0; if (q >= 0 && q % 3 == 0 && q / 3 < NSB * 2) { const int it = q / 3; sattn_a_item(Q, A.in[2], A.in[3], K, V, A.in[10], MIX, it >> 1, it & 1, vimg, lane); } }
        else for (int it = gw7; it < NSB * 2; it += NGW7) sattn_a_item(Q, A.in[2], A.in[3], K, V, A.in[10], MIX, it >> 1, it & 1, vimg, lane);
    }
}

__device__ __forceinline__ void mixer1(const Frame& F, const Args& A) {
    unsigned char* ws = A.ws; const int lane = F.lane;
    const bf16_t* Q = (const bf16_t*)(ws + WS_Q); const bf16_t* K = (const bf16_t*)(ws + WS_K); const bf16_t* V = (const bf16_t*)(ws + WS_V); bf16_t* MIX = (bf16_t*)(ws + WS_MIX);
    LAS unsigned char* stlds = F.lds + NWAVES * VIMG;
    static_assert(NWAVES * VIMG + ST_BYTES <= RING_BYTES, "attention LDS map");
    LAS unsigned char* vimg = F.lds + F.wave * VIMG;
    {
        const int nun = (512 - (int)blockIdx.x + F.G - 1) / F.G, nit = 6 * nun;
        auto dcfg = [&](int idx) {
            const int j = idx / 6, w6 = idx - 6 * j, br = w6 >> 1, k = w6 & 1, un = blockIdx.x + j * F.G;
            const int h = un & 7, ch = (un >> 3) & 7, b = un >> 6, T0 = ch * 512;
            const int dl = br == 0 ? 16 : br == 1 ? 4 : 1, it = F.wave * 2 + k;
            int r, i0; if (br == 0) { r = it; i0 = T0 / 16; } else if (br == 1) { r = it & 3; i0 = T0 / 4 + 32 * (it >> 2); } else { r = 0; i0 = T0 + 32 * it; }
            AttnCfg c; c.Q = Q + h * 64; c.K = K + h * 64; c.V = V + h * 64; c.qpitch = 512; c.kvpitch = 512; c.rowbase = (long)b * SEQ + r; c.i0 = i0; c.dl = dl;
            c.sl2 = alibi_slope(h) * (float)dl * LOG2E; c.st = stlds; c.tl0 = r - T0; c.out = MIX + 512 + h * 64; c.opitch = DM; c.sink2 = 0.f;
            return c;
        };
        bf16x8 qf[4], kf[4]; u32x4 vv[4];
        AttnCfg c = dcfg(0); attn_preload_q(c, lane, qf); attn_preload_kv(c, lane, kf, vv);
        int br = 0, k = 0;
#pragma unroll 1
        for (int idx = 0; idx < nit; ++idx) {
            const bool hn = idx + 1 < nit; const AttnCfg cn = dcfg(hn ? idx + 1 : idx);
            if (br == 0) attn_item<false, false, false>(c, vimg, lane, qf, kf, vv, hn, cn);
            else if (br == 1) attn_item<true, false, false>(c, vimg, lane, qf, kf, vv, hn, cn);
            else attn_item<true, true, false>(c, vimg, lane, qf, kf, vv, hn, cn);
            if (k == 1) { __syncthreads(); br = br == 2 ? 0 : br + 1; }
            k ^= 1;
            c = cn;
        }
    }
    __syncthreads();
    if (F.wave < 4) {
        const int item = F.vcu * 4 + F.wave;
        for (int rep_ = 0; rep_ < REP_FUSED; ++rep_)
        for (int it = item; it < NSB * 8; it += F.G * 4) fused_d_item(A, it >> 3, it & 7, (LAS float*)(F.lds + F.wave * FD_LDS), lane);
    } else {
        const int gw4 = F.vcu * 4 + (F.wave - 4), NGW4 = F.G * 4;
        for (int rep_ = 0; rep_ < REP_CP; ++rep_)
        for (int it = gw4; it < 1024 + NSB; it += NGW4) pool_item(A, it, lane);
    }
}

__device__ __forceinline__ void final_ln(const Frame& F, const Args& A, float* dstbase, bool desig, int dsg) {
    const float* g = A.in[24] + DM; const float* bb = A.in[25] + DM;
    f32x4 gv[4], bv[4];
#pragma unroll
    for (int j = 0; j < 4; ++j) { gv[j] = ((const f32x4*)g)[F.lane + 64 * j]; bv[j] = ((const f32x4*)bb)[F.lane + 64 * j]; }
    const int m0 = desig ? MP + dsg * 64 + F.wave : F.vcu_lt240 * NWAVES + F.wave, mstep = desig ? NWAVES : 240 * NWAVES, mend = desig ? MP + dsg * 64 + 64 : MP;
    for (int m = m0; m < mend; m += mstep) {
        GAS f32x4* xr = (GAS f32x4*)(A.out + O_Y + (size_t)m * DM) + F.lane;
        f32x4 v[4]; float s = 0.f;
#pragma unroll
        for (int j = 0; j < 4; ++j) { v[j] = xr[64 * j]; s += (v[j][0] + v[j][1]) + (v[j][2] + v[j][3]); }
        const float mean = wave_sum(s) * (1.f / DM); float s2 = 0.f;
#pragma unroll
        for (int j = 0; j < 4; ++j) { v[j] = v[j] - mean; s2 += (v[j][0] * v[j][0] + v[j][1] * v[j][1]) + (v[j][2] * v[j][2] + v[j][3] * v[j][3]); }
        const float rstd = 1.f / sqrtf(wave_sum(s2) * (1.f / DM) + LN_EPS);
        GAS f32x4* xo = (GAS f32x4*)(dstbase + (size_t)m * DM) + F.lane;
#pragma unroll
        for (int j = 0; j < 4; ++j) xo[64 * j] = v[j] * rstd * gv[j] + bv[j];
    }
}
#ifndef LAST_PHASE
#define LAST_PHASE 11
#endif
constexpr int CW_DEFER = 12288;
struct UOrder {
    int nN, c, npre, pm0, pn0, nmain, extraL, rev;
    __device__ __forceinline__ static void map(int L, int nN, Unit& u) {
        const int nM = MP / 256, nwg = nM * nN; int wgid = L;
        { const int q = nwg / 8, r = nwg % 8, xcd = wgid % 8, off = wgid / 8; wgid = (xcd < r ? xcd * (q + 1) : r * (q + 1) + (xcd - r) * q) + off; }
        const int nig = 8 * nN, gid = wgid / nig, fm = gid * 8, gsz = (nM - fm) < 8 ? (nM - fm) : 8;
        u.pm = fm + ((wgid % nig) % gsz); u.pn = (wgid % nig) / gsz;
    }
    __device__ __forceinline__ bool next(int i, Unit& u) const {
        if (i < npre) { u.pm = pm0; u.pn = pn0 + i; return true; }
        const int k = i - npre; int L;
        if (k < nmain) L = (rev ? nmain - 1 - k : k) * 256 + c; else if (k == nmain && extraL >= 0) L = extraL; else return false;
        map(L, nN, u); return true;
    }
    __device__ __forceinline__ void a_ready(const Unit&) const {}
    __device__ __forceinline__ void done(const Unit&) const {}
    __device__ __forceinline__ static UOrder prompt_rounds(int nN, int c, int rounds, int rev = 0) { return UOrder{nN, c, 0, 0, 0, rounds, -1, rev}; }
    __device__ __forceinline__ static UOrder sample_units(int nN, int pm, int pn0, int n) { return UOrder{nN, 0, n, pm, pn0, 0, -1, 0}; }
    __device__ __forceinline__ static UOrder mlp1(int c) {
        if (c >= 240) { const int d = c - 240; return UOrder{16, c, 4, 128 + (d >> 2), 4 * (d & 3), 0, -1, 0}; }
        const int g8 = c >> 3, a = (g8 & 1) == 0 ? (g8 >> 1) * 8 + (c & 7) : (g8 == 29 ? 120 + (c & 7) : -1);
        return UOrder{16, c, 0, 0, 0, 8, a >= 0 ? (a / 16) * 256 + 240 + (a % 16) : -1, 0};
    }
    __device__ __forceinline__ static UOrder in1(int c) {
        if (c >= 240) { const int d = c - 240; return UOrder{8, c, 2, 128 + (d >> 2), 2 * (d & 3), 2, -1, 0}; }
        return UOrder{8, c, 0, 0, 0, 4, c < 32 ? (2 + c / 16) * 256 + 240 + (c % 16) : -1, 0};
    }
};
__device__ __forceinline__ void sync16(const Frame& F, gu32* cnt) {
    asm volatile("s_waitcnt vmcnt(0)" ::: "memory");
    __syncthreads();
    if (F.tid == 0) {
        __builtin_amdgcn_fence(__ATOMIC_RELEASE, "agent");
        asm volatile("s_waitcnt vmcnt(0)" ::: "memory");
        __hip_atomic_fetch_add(cnt, 1u, RLX_AGENT);
        unsigned sp = 0;
        while (__hip_atomic_load(cnt, RLX_AGENT) < 16u) { __builtin_amdgcn_s_sleep(1); if (++sp > XB_SPIN_CAP) { atomicAdd((unsigned*)(F.ctl + CW_BAR) + XB_TMO, 1u); break; } }
        __builtin_amdgcn_fence(__ATOMIC_ACQUIRE, "agent");
        asm volatile("s_waitcnt vmcnt(0)" ::: "memory");
    }
    __syncthreads();
}
constexpr int ARG_OFF = LDSCTL_OFF + 512;
__device__ __forceinline__ const float* lds_arg(const Frame& F, int i) {
    const LAS unsigned* t = (const LAS unsigned*)(F.lds + ARG_OFF) + 2 * i;
    const unsigned lo = __builtin_amdgcn_readfirstlane(t[0]), hi = __builtin_amdgcn_readfirstlane(t[1]);
    return (const float*)(const GAS float*)(((unsigned long long)hi << 32) | lo);
}
#define LOAD_ARGS(A) Args A; { int t_ = threadIdx.x; asm volatile("" : "+v"(t_)); F.tid = t_; F.lane = t_ & 63; } {     _Pragma("unroll") for (int i_ = 0; i_ < 26; ++i_) A.in[i_] = lds_arg(F, i_); A.out = (float*)lds_arg(F, 26); A.ws = (unsigned char*)lds_arg(F, 27); }
__global__ void __launch_bounds__(NWAVES * 64, 2) hybrid_fwd(Args args) {
    extern __shared__ __attribute__((aligned(16))) unsigned char lds[];
    Frame F;
    F.lds = (LAS unsigned char*)lds;
    F.tid = threadIdx.x; F.lane = F.tid & 63; F.wave = __builtin_amdgcn_readfirstlane(F.tid >> 6);
    F.G = gridDim.x; { const int bx = blockIdx.x; F.vcu = (F.G % 8 == 0) ? (bx % 8) * (F.G / 8) + bx / 8 : bx; }
    F.gw = F.vcu * NWAVES + F.wave; F.NGW = F.G * NWAVES; F.vcu_lt240 = (int)blockIdx.x;
    F.ctl = (gu32*)(args.ws + WS_CTL);
    volatile LAS unsigned* MISC = (volatile LAS unsigned*)(F.lds + MISC_OFF);
    for (int u = F.tid; u < (LDS_BYTES - LDSCTL_OFF) / 4; u += NWAVES * 64) ((LAS unsigned*)(F.lds + LDSCTL_OFF))[u] = 0u;
    __syncthreads();
    if (F.tid == 0) {
        LAS unsigned long long* t = (LAS unsigned long long*)(F.lds + ARG_OFF);
#pragma unroll
        for (int i = 0; i < 26; ++i) t[i] = (unsigned long long)args.in[i];
        t[26] = (unsigned long long)args.out; t[27] = (unsigned long long)args.ws;
    }
    __syncthreads();
    XcdBarrier bar = xcd_barrier_post((unsigned*)(F.ctl + CW_BAR), MISC + 8);
    const int bid = (int)blockIdx.x;
#ifdef REP_BAR
#define PHASE_END(k) do { { LOAD_ARGS(Ac_); steal_copy(F, Ac_, (k), false); } xcd_barrier(bar); xcd_barrier(bar); } while (0)
#else
#define PHASE_END(k) do { { LOAD_ARGS(Ac_); steal_copy(F, Ac_, (k), false); } xcd_barrier(bar); } while (0)
#endif
#define PHASE_END_NS(k) do { xcd_barrier(bar); } while (0)
#define WSP(T, off) ((T*)(A.ws + (off)))
#define VECP(off) ((float*)(A.ws + WS_VEC) + (off))

    const bool desig = bid >= 240; const int dsg = bid - 240;
    gu32* dcnt = F.ctl + CW_DEFER;

#define STAGGER if (!desig && ((bid >> 3) & 1) && (bid >> 3) != 29) { LOAD_ARGS(As_); stagger_copy(F, As_, 2); }
    { LOAD_ARGS(A); p0_prologue(F, A); }
    PHASE_END_NS(0);
    { LOAD_ARGS(A); pg8::Gemm g{WSP(bf16_t, WS_XB), WSP(const bf16_t, WS_WIN0), M, N_IN0, DM}; pg8::StaticOrder S; S.init(M, N_IN0, F.G, bid);
      EpiIn0 E{WSP(bf16_t, WS_Q), WSP(bf16_t, WS_K), WSP(bf16_t, WS_V), WSP(bf16_t, WS_C), WSP(bf16_t, WS_GB), VECP(V_BIN0), A.out};
      pg8::gemm_phase<EpiIn0, pg8::StaticOrder, true, true>(F.lds, g, S, E); }
    PHASE_END(1);
    { LOAD_ARGS(A); mixer0(F, A); }
    PHASE_END_NS(2);
#define GEMM_MLP2_0(ORD) { LOAD_ARGS(A); pg8::Gemm g{WSP(bf16_t, WS_H), WSP(const bf16_t, WS_W2_0), M, DM, FF}; \
      EpiRes<true, false, false> E{WSP(const bf16_t, WS_ZH0), WSP(float, WS_STA), A.in[22], A.in[23], nullptr, nullptr, WSP(bf16_t, WS_ZH1), WSP(float, WS_STB), F.lds}; \
      pg8::gemm_phase<EpiRes<true, false, false>, UOrder, true, true>(F.lds, g, ORD, E); }
#define GEMM_MLP2_0_SAMPLE if (desig) { sync16(F, dcnt + 64); { UOrder S = UOrder::sample_units(4, 128 + (dsg >> 2), dsg & 3, 1); GEMM_MLP2_0(S) } }
#define GEMM_OUT0(ORD) { LOAD_ARGS(A); pg8::Gemm g{WSP(bf16_t, WS_MIX), WSP(const bf16_t, WS_WOUT0), M, DM, DM}; \
      EpiRes<false, true, false> E{WSP(const bf16_t, WS_XB), nullptr, nullptr, nullptr, A.in[13], nullptr, WSP(bf16_t, WS_ZH0), WSP(float, WS_STA), F.lds}; \
      pg8::gemm_phase<EpiRes<false, true, false>, UOrder, true, true>(F.lds, g, ORD, E); }
    { UOrder S = UOrder::prompt_rounds(4, bid, 2); GEMM_OUT0(S) }
    PHASE_END_NS(3);
    if (desig) { { UOrder S = UOrder::sample_units(4, 128 + (dsg >> 2), dsg & 3, 1); GEMM_OUT0(S) } sync16(F, dcnt + 0); }
#define GEMM_MLP1(WOFF, CSO, BWO, ORD) { LOAD_ARGS(A); pg8::Gemm g{WSP(bf16_t, WS_ZH0), WSP(const bf16_t, WOFF), M, FF, DM}; \
      EpiMlp1 E{WSP(bf16_t, WS_H), VECP(CSO), VECP(BWO), WSP(float, WS_STA), F.lds}; \
      pg8::gemm_phase<EpiMlp1, UOrder, true, true>(F.lds, g, ORD, E); }
    STAGGER
    { UOrder S = UOrder::mlp1(bid); GEMM_MLP1(WS_W1_0, V_CS1_0, V_BW1_0, S) }
    GEMM_MLP2_0_SAMPLE
    PHASE_END(4);
    { UOrder S = UOrder::prompt_rounds(4, bid, 2, 1); GEMM_MLP2_0(S) }
    PHASE_END_NS(5);
    { LOAD_ARGS(A); pg8::Gemm g{WSP(bf16_t, WS_ZH1), WSP(const bf16_t, WS_WIN1), M, N_IN1, DM}; UOrder S = UOrder::in1(bid);
      EpiIn1 E{WSP(bf16_t, WS_C), WSP(bf16_t, WS_Q), WSP(bf16_t, WS_K), WSP(bf16_t, WS_V), VECP(V_CSIN1), VECP(V_BWIN1), WSP(float, WS_STB), A.out, F.lds};
      pg8::gemm_phase<EpiIn1, UOrder, true, true>(F.lds, g, S, E); }
    PHASE_END(6);
    { LOAD_ARGS(A); mixer1(F, A); }
    PHASE_END_NS(7);
#define GEMM_MLP2_1(ORD) { LOAD_ARGS(A); pg8::Gemm g{WSP(bf16_t, WS_H), WSP(const bf16_t, WS_W2_1), M, DM, FF}; \
      EpiResFinal E{WSP(const bf16_t, WS_ZH0), WSP(float, WS_STA), A.in[22] + DM, A.in[23] + DM, A.in[24] + DM, A.in[25] + DM, A.out + O_Y, WSP(float, WS_STB), F.ctl, F.lds}; \
      pg8::gemm_phase<EpiResFinal, UOrder, true, true>(F.lds, g, ORD, E); }
#define GEMM_MLP2_1_SAMPLE if (desig) { sync16(F, dcnt + 192); { UOrder S = UOrder::sample_units(4, 128 + (dsg >> 2), dsg & 3, 1); GEMM_MLP2_1(S) } }
#define GEMM_OUT1(ORD) { LOAD_ARGS(A); pg8::Gemm g{WSP(bf16_t, WS_MIX), WSP(const bf16_t, WS_WOUT1), M, DM, DM}; \
      EpiRes<true, true, false> E{WSP(const bf16_t, WS_ZH1), WSP(float, WS_STB), A.in[24], A.in[25], A.in[19], nullptr, WSP(bf16_t, WS_ZH0), WSP(float, WS_STA), F.lds}; \
      pg8::gemm_phase<EpiRes<true, true, false>, UOrder, true, true>(F.lds, g, ORD, E); }
    { UOrder S = UOrder::prompt_rounds(4, bid, 2); GEMM_OUT1(S) }
    PHASE_END_NS(8);
    if (desig) { { UOrder S = UOrder::sample_units(4, 128 + (dsg >> 2), dsg & 3, 1); GEMM_OUT1(S) } sync16(F, dcnt + 128); }
    STAGGER
    { UOrder S = UOrder::mlp1(bid); GEMM_MLP1(WS_W1_1, V_CS1_1, V_BW1_1, S) }
    GEMM_MLP2_1_SAMPLE
    PHASE_END(9);
    { UOrder S = UOrder::prompt_rounds(4, bid, 2, 1); GEMM_MLP2_1(S) }
    { LOAD_ARGS(A); steal_copy(F, A, 11, true); }
#undef GEMM_OUT0
#undef GEMM_MLP1
#undef GEMM_MLP2_0
#undef GEMM_OUT1
#undef GEMM_MLP2_1
#undef GEMM_MLP2_0_SAMPLE
#undef GEMM_MLP2_1_SAMPLE
#undef PHASE_END
#undef WSP
#undef VECP
}

extern "C" void kernel_launch(void* const* d_in, const int* in_sizes, int n_in, void* d_out, int out_size, void* d_ws, size_t ws_size, hipStream_t stream) {
    static int grid = 0;
    if (grid == 0) {
        if (n_in != 26 || in_sizes[0] != MP * DM || (size_t)out_size != O_TOTAL || ws_size < WS_END) {
            fprintf(stderr, "kernel_launch: unexpected shapes (n_in %d, in0 %d, out %d, ws %zu); nothing launched\n", n_in, n_in > 0 ? in_sizes[0] : -1, out_size, ws_size); grid = -1; return; }
        int dev = 0, cus = 0, per_cu = 0;
        if (hipGetDevice(&dev) != hipSuccess || hipDeviceGetAttribute(&cus, hipDeviceAttributeMultiprocessorCount, dev) != hipSuccess) { grid = -1; return; }
        if (hipFuncSetAttribute((const void*)hybrid_fwd, hipFuncAttributeMaxDynamicSharedMemorySize, LDS_BYTES) != hipSuccess) { fprintf(stderr, "kernel_launch: hipFuncSetAttribute failed\n"); grid = -1; return; }
        if (hipOccupancyMaxActiveBlocksPerMultiprocessor(&per_cu, (const void*)hybrid_fwd, NWAVES * 64, LDS_BYTES) != hipSuccess || per_cu < 1) {
            fprintf(stderr, "kernel_launch: occupancy query reports %d workgroups per CU; nothing launched\n", per_cu); (void)hipGetLastError(); grid = -1; return; }
        grid = cus;
        if (grid != 256) { fprintf(stderr, "kernel_launch: the unit schedule is built for 256 workgroups, this device has %d CUs; nothing launched\n", cus); grid = -1; return; }
    }
    if (grid < 0) return;
    if (hipMemsetAsync((char*)d_ws + WS_CTL, 0, CTL_ZERO_BYTES, stream) != hipSuccess) return;
    Args a{};
    for (int i = 0; i < 26; ++i) a.in[i] = (const float*)d_in[i];
    a.out = (float*)d_out; a.ws = (unsigned char*)d_ws;
    hipLaunchKernelGGL(hybrid_fwd, dim3(grid), dim3(NWAVES * 64), LDS_BYTES, stream, a);
}
```

```cpp
#include <hip/hip_runtime.h>
#include <cstdio>
#include <cstdint>
namespace pg8 {
#define PG8_LAS __attribute__((address_space(3)))
typedef unsigned short bf16_t;
typedef short bf16x8 __attribute__((ext_vector_type(8)));
typedef float f32x4 __attribute__((ext_vector_type(4)));
typedef unsigned u32x4 __attribute__((ext_vector_type(4)));
constexpr int BM = 256, BK = 64, HALF = 128, HTB = HALF * BK * 2  , STAGE_BYTES = 8 * HTB, NXCD = 8, WGM = 8;

__host__ __device__ __forceinline__ int lds_byte(int r, int c) { const int st = (r >> 4) * 2 + (c >> 5), rr = r & 15, cc = c & 31, ob = rr * 64 + cc * 2; return st * 1024 + (ob ^ (((ob >> 9) & 1) << 5)); }
__host__ __device__ __forceinline__ void stage_rc(int b, int& R, int& C) { const int st = b / 1024, sb = b % 1024, swz = sb ^ (((sb >> 9) & 1) << 5); R = (st >> 1) * 16 + swz / 64; C = (st & 1) * 32 + (swz % 64) / 2; }
__host__ __device__ __forceinline__ int perm32(int rho) { const int n = rho >> 4, i = rho & 15; return 8 * (i >> 2) + 4 * n + (i & 3); }

struct Unit { int pm, pn; };
struct Gemm { const bf16_t* A; const bf16_t* Bt; int M, N, K; };

struct StaticOrder {
    int nM, nN, nwg, G, c;
    __host__ __device__ void init(int M, int N, int G_, int c_) { nM = M / BM; nN = N / BM; nwg = nM * nN; G = G_; c = c_; }
    __host__ __device__ bool next(int i, Unit& u) const {
        const long L = (long)i * G + c; if (L >= nwg) return false;
        int wgid = (int)L; { const int q = nwg / NXCD, r = nwg % NXCD, xcd = wgid % NXCD, off = wgid / NXCD; wgid = (xcd < r ? xcd * (q + 1) : r * (q + 1) + (xcd - r) * q) + off; }
        const int nig = WGM * nN, gid = wgid / nig, fm = gid * WGM, gsz = (nM - fm) < WGM ? (nM - fm) : WGM;
        u.pm = fm + ((wgid % nig) % gsz); u.pn = (wgid % nig) / gsz; return true;
    }
    __device__ __forceinline__ void a_ready(const Unit&) const {}
    __device__ __forceinline__ void done(const Unit&) const {}
};

__device__ __forceinline__ unsigned cvt_pk_bf16(float lo, float hi) { unsigned r; asm volatile("v_cvt_pk_bf16_f32 %0, %1, %2" : "=v"(r) : "v"(lo), "v"(hi)); return r; }
typedef float f32x2 __attribute__((ext_vector_type(2)));
template <class Epi, class Sched, bool ALIGN_EPI = false, bool SP2 = false>
__device__ __forceinline__ void gemm_phase(PG8_LAS unsigned char* lds, const Gemm g, const Sched& S, const Epi& E) {
    int tid_ = threadIdx.x; asm volatile("" : "+v"(tid_));
    const int tid = tid_, wid = __builtin_amdgcn_readfirstlane(tid >> 6), lane = tid & 63, wr = wid >> 2, wc = wid & 3, fr = lane & 15, fq = lane >> 4;
    const int K = g.K, nt = K / BK;
    unsigned voffA[2], voffB[2];
#pragma unroll
    for (int i = 0; i < 2; ++i) { int R, C; stage_rc(tid * 16 + i * 8192, R, C); const int Rb = Epi::PERM ? ((R & ~31) + perm32(R & 31)) : R;
        voffA[i] = (unsigned)(R * K + C) * 2u; voffB[i] = (unsigned)(Rb * K + C) * 2u; }
    const size_t kstep = (size_t)(BK * 2);
    const size_t hstep = (size_t)HALF * K * 2;
    const size_t tstep = 2 * hstep;
    const unsigned ldsw = (unsigned)wid * 1024u;
    const int aoff = lds_byte(wr * 64 + fr, fq * 8), boff = lds_byte(wc * 32 + fr, fq * 8);
#define PG8_SA(b, h) (((b) * 2 + (h)) * HTB)
#define PG8_SB(b, h) ((4 + (b) * 2 + (h)) * HTB)
#define PG8_STAGE(bufoff, gbase, voff) do { _Pragma("unroll") for (int _i = 0; _i < 2; ++_i) \
        __builtin_amdgcn_global_load_lds((const unsigned*)((const char*)(gbase) + (voff)[_i]), (PG8_LAS unsigned*)(lds + (bufoff) + ldsw + _i * 8192), 16, 0, 0); } while (0)
#define PG8_LDA(dst, b, h) do { _Pragma("unroll") for (int m = 0; m < 4; ++m) _Pragma("unroll") for (int k = 0; k < 2; ++k) dst[m][k] = *(const PG8_LAS bf16x8*)(lds + PG8_SA(b, h) + aoff + m * 2048 + k * 1024); } while (0)
#define PG8_LDB(dst, b, h) do { _Pragma("unroll") for (int n = 0; n < 2; ++n) _Pragma("unroll") for (int k = 0; k < 2; ++k) dst[n][k] = *(const PG8_LAS bf16x8*)(lds + PG8_SB(b, h) + boff + n * 2048 + k * 1024); } while (0)
#define PG8_MMA(ai, bj, At, Bt) do { __builtin_amdgcn_s_setprio(1); _Pragma("unroll") for (int m = 0; m < 4; ++m) _Pragma("unroll") for (int n = 0; n < 2; ++n) _Pragma("unroll") for (int k = 0; k < 2; ++k) \
        acc[ai][bj][m][n] = __builtin_amdgcn_mfma_f32_16x16x32_bf16(Bt[n][k], At[m][k], acc[ai][bj][m][n], 0, 0, 0); __builtin_amdgcn_s_setprio(0); } while (0)
#define PG8_WAIT_V(n) asm volatile("s_waitcnt vmcnt(" #n ")" ::: "memory")
#define PG8_WAIT_L(n) asm volatile("s_waitcnt lgkmcnt(" #n ")" ::: "memory")
#define PG8_BAR __builtin_amdgcn_s_barrier()
#define PG8_SCHED __builtin_amdgcn_sched_barrier(0)
    Unit cur, nxt; int ui = 0;
    if (!S.next(0, cur)) return;
    f32x4 acc[2][2][4][2];
#pragma unroll
    for (int a = 0; a < 2; ++a)
#pragma unroll
        for (int b = 0; b < 2; ++b)
#pragma unroll
            for (int m = 0; m < 4; ++m)
#pragma unroll
                for (int n = 0; n < 2; ++n) acc[a][b][m][n] = (f32x4){0.f, 0.f, 0.f, 0.f};
    bf16x8 At[4][2], B0[2][2], B1[2][2];
    const char* cA = (const char*)g.A + (size_t)cur.pm * tstep; const char* cB = (const char*)g.Bt + (size_t)cur.pn * tstep;
    S.a_ready(cur);
    if (wr == 1) E.pre(cur, wid, lane);
    if constexpr (SP2) {
        PG8_STAGE(PG8_SB(0, 0), cB, voffB); PG8_STAGE(PG8_SB(0, 1), cB + hstep, voffB); PG8_STAGE(PG8_SA(0, 0), cA, voffA); PG8_STAGE(PG8_SA(0, 1), cA + hstep, voffA);
        if (wr == 1) PG8_BAR;
        PG8_WAIT_V(2); PG8_BAR;
        PG8_STAGE(PG8_SB(1, 0), cB + kstep, voffB); PG8_STAGE(PG8_SA(1, 0), cA + kstep, voffA); PG8_STAGE(PG8_SB(1, 1), cB + hstep + kstep, voffB);
        PG8_WAIT_V(6); PG8_BAR;
    } else {
        PG8_STAGE(PG8_SB(0, 0), cB, voffB); PG8_STAGE(PG8_SA(0, 0), cA, voffA); PG8_STAGE(PG8_SB(0, 1), cB + hstep, voffB); PG8_STAGE(PG8_SA(0, 1), cA + hstep, voffA);
        if (wr == 1) PG8_BAR;
        PG8_WAIT_V(4); PG8_BAR;
        PG8_STAGE(PG8_SB(1, 0), cB + kstep, voffB); PG8_STAGE(PG8_SA(1, 0), cA + kstep, voffA); PG8_STAGE(PG8_SB(1, 1), cB + hstep + kstep, voffB);
        PG8_WAIT_V(6); PG8_BAR;
    }
    for (;;) {
        const bool has_next = S.next(ui + 1, nxt);
        const char* nA = has_next ? (const char*)g.A + (size_t)nxt.pm * tstep : cA; const char* nB = has_next ? (const char*)g.Bt + (size_t)nxt.pn * tstep : cB;
        for (int t = 0; t < nt; t += 2) {
            const bool last = (t == nt - 2);
            const char* a1 = cA + (size_t)(t + 1) * kstep;
            const char* a2 = last ? nA : cA + (size_t)(t + 2) * kstep; const char* b2 = last ? nB : cB + (size_t)(t + 2) * kstep;
            const char* a3 = a2 + kstep; const char* b3 = b2 + kstep;
            if (last && has_next) S.a_ready(nxt);
            if constexpr (SP2) {
            PG8_LDB(B0, 0, 0); PG8_LDB(B1, 0, 1); PG8_SCHED; PG8_LDA(At, 0, 0); PG8_STAGE(PG8_SA(1, 1), a1 + hstep, voffA);
            PG8_WAIT_V(8); PG8_WAIT_L(0); PG8_BAR; PG8_MMA(0, 0, At, B0); PG8_MMA(0, 1, At, B1); PG8_BAR; PG8_SCHED;
            PG8_LDA(At, 0, 1); PG8_STAGE(PG8_SB(0, 0), b2, voffB); PG8_STAGE(PG8_SB(0, 1), b2 + hstep, voffB); PG8_STAGE(PG8_SA(0, 0), a2, voffA);
            PG8_WAIT_V(8); PG8_WAIT_L(0); PG8_BAR; PG8_MMA(1, 0, At, B0); PG8_MMA(1, 1, At, B1); PG8_BAR; PG8_SCHED;
            PG8_LDB(B0, 1, 0); PG8_LDB(B1, 1, 1); PG8_SCHED; PG8_LDA(At, 1, 0); PG8_STAGE(PG8_SA(0, 1), a2 + hstep, voffA);
            PG8_WAIT_V(8); PG8_WAIT_L(0); PG8_BAR; PG8_MMA(0, 0, At, B0); PG8_MMA(0, 1, At, B1); PG8_BAR; PG8_SCHED;
            PG8_LDA(At, 1, 1); PG8_STAGE(PG8_SB(1, 0), b3, voffB); PG8_STAGE(PG8_SB(1, 1), b3 + hstep, voffB); PG8_STAGE(PG8_SA(1, 0), a3, voffA);
            PG8_WAIT_V(8); PG8_WAIT_L(0); PG8_BAR; PG8_MMA(1, 0, At, B0); PG8_MMA(1, 1, At, B1); PG8_BAR; PG8_SCHED;
            } else {
            PG8_LDB(B0, 0, 0); PG8_SCHED; PG8_LDA(At, 0, 0); PG8_STAGE(PG8_SA(1, 1), a1 + hstep, voffA);
            PG8_WAIT_L(8); PG8_BAR; PG8_WAIT_L(0); PG8_MMA(0, 0, At, B0); PG8_BAR; PG8_SCHED;
            PG8_LDB(B1, 0, 1); PG8_STAGE(PG8_SB(0, 0), b2, voffB);
            PG8_BAR; PG8_WAIT_L(0); PG8_MMA(0, 1, At, B1); PG8_BAR;
            PG8_LDA(At, 0, 1); PG8_STAGE(PG8_SA(0, 0), a2, voffA);
            PG8_BAR; PG8_WAIT_L(0); PG8_MMA(1, 0, At, B0); PG8_BAR; PG8_SCHED;
            PG8_STAGE(PG8_SB(0, 1), b2 + hstep, voffB);
            PG8_WAIT_V(6); PG8_BAR; PG8_MMA(1, 1, At, B1); PG8_BAR;
            PG8_LDB(B0, 1, 0); PG8_SCHED; PG8_LDA(At, 1, 0); PG8_STAGE(PG8_SA(0, 1), a2 + hstep, voffA);
            PG8_WAIT_L(8); PG8_BAR; PG8_WAIT_L(0); PG8_MMA(0, 0, At, B0); PG8_BAR; PG8_SCHED;
            PG8_LDB(B1, 1, 1); PG8_STAGE(PG8_SB(1, 0), b3, voffB);
            PG8_BAR; PG8_WAIT_L(0); PG8_MMA(0, 1, At, B1); PG8_BAR;
            PG8_LDA(At, 1, 1); PG8_STAGE(PG8_SA(1, 0), a3, voffA);
            PG8_BAR; PG8_WAIT_L(0); PG8_MMA(1, 0, At, B0); PG8_BAR; PG8_SCHED;
            PG8_STAGE(PG8_SB(1, 1), b3 + hstep, voffB);
            PG8_WAIT_V(6); PG8_BAR; PG8_MMA(1, 1, At, B1); PG8_BAR;
            }
        }
        if constexpr (ALIGN_EPI) { if (wr == 0) PG8_BAR; }
        if constexpr (!Epi::AFTER_DRAIN) { E(acc, cur, wr, wc, fr, fq); S.done(cur); }
        if (!has_next) break;
#pragma unroll
        for (int a = 0; a < 2; ++a)
#pragma unroll
            for (int b = 0; b < 2; ++b)
#pragma unroll
                for (int m = 0; m < 4; ++m)
#pragma unroll
                    for (int n = 0; n < 2; ++n) acc[a][b][m][n] = (f32x4){0.f, 0.f, 0.f, 0.f};
        cur = nxt; cA = nA; cB = nB; ++ui;
        if constexpr (ALIGN_EPI) { if (wr == 1) { PG8_BAR; E.pre(cur, wid, lane); } }
    }
    PG8_WAIT_V(0);
    if constexpr (!ALIGN_EPI) { if (wr == 0) PG8_BAR; }
    PG8_BAR;
    if constexpr (Epi::AFTER_DRAIN) { E.fused(acc, cur, wr, wc, fr, fq, lds, wid, lane); S.done(cur); }
#undef PG8_SA
#undef PG8_SB
#undef PG8_STAGE
#undef PG8_LDA
#undef PG8_LDB
#undef PG8_MMA
#undef PG8_WAIT_V
#undef PG8_WAIT_L
#undef PG8_BAR
#undef PG8_SCHED
}
}
#define GAS __attribute__((address_space(1)))
#define LAS __attribute__((address_space(3)))
typedef unsigned short bf16;
typedef unsigned v4u __attribute__((ext_vector_type(4)));
typedef float f32x4 __attribute__((ext_vector_type(4)));
typedef short bf16x8 __attribute__((ext_vector_type(8)));
typedef GAS unsigned gu32;
typedef GAS unsigned long long gu64;
#define RLX_AGENT __ATOMIC_RELAXED, __HIP_MEMORY_SCOPE_AGENT
#define LDS_WAIT() asm volatile("s_waitcnt lgkmcnt(0)" ::: "memory")
#define VM_WAIT() asm volatile("s_waitcnt vmcnt(0)" ::: "memory")
__device__ __forceinline__ unsigned long long rt() { return __builtin_amdgcn_s_memrealtime(); }
__device__ __forceinline__ unsigned f2bf(float f) { unsigned u = __builtin_bit_cast(unsigned, f); return (u + 0x7fffu + ((u >> 16) & 1u)) >> 16; }
__device__ __forceinline__ unsigned pk2(float lo, float hi) { return f2bf(lo) | (f2bf(hi) << 16); }

#define XB_TMO      128
#define XB_XCNT(j)  (256  + 64 * (j))
#define XB_XSUB(j)  (1280 + 64 * (j))
#define XB_XGEN(j)  (2304 + 64 * (j))
#define XB_TOP      3328
#define XB_TOPGEN   3392
#define XCD_BAR_WORDS 3456
#define XB_SPIN_CAP (1u << 22)

__device__ __forceinline__ unsigned xb_ld(unsigned* p)              { return __hip_atomic_load(p, __ATOMIC_RELAXED, __HIP_MEMORY_SCOPE_AGENT); }
__device__ __forceinline__ unsigned xb_add(unsigned* p, unsigned v) { return __hip_atomic_fetch_add(p, v, __ATOMIC_RELAXED, __HIP_MEMORY_SCOPE_AGENT); }
__device__ __forceinline__ unsigned xb_xcc_id() { return (unsigned)__builtin_amdgcn_s_getreg((3 << 11) | 20) & 0xFu; }
#define XB_SPIN(cond, bar) do { unsigned _sp = 0; while (cond) { __builtin_amdgcn_s_sleep(1); \
    if ((++_sp & 255u) == 0u) { if (xb_ld(&(bar)[XB_TMO])) break; if (_sp > XB_SPIN_CAP) { atomicAdd(&(bar)[XB_TMO], 1u); break; } } } } while (0)

struct XcdBarrier {
    unsigned* bar; unsigned x;
    volatile LAS unsigned* st;
};

__device__ __forceinline__ XcdBarrier xcd_barrier_post(unsigned* bar, volatile LAS unsigned* st) {
    XcdBarrier b; b.bar = bar; b.x = xb_xcc_id(); b.st = st;
    if (threadIdx.x == 0) (void)xb_add(&bar[XB_XCNT(b.x)], 1u);
    return b;
}
__device__ __forceinline__ void xcd_barrier_complete(unsigned* bar, unsigned x, unsigned& nloc, unsigned& nx) {
    const unsigned G = gridDim.x * gridDim.y * gridDim.z;
    unsigned sum, cnt, mine, sp = 0u;
    for (;;) {
        sum = 0u; cnt = 0u; mine = 0u;
#pragma unroll
        for (unsigned j = 0; j < 16; ++j) { const unsigned c = xb_ld(&bar[XB_XCNT(j)]); sum += c; cnt += (c > 0u) ? 1u : 0u; mine = (j == x) ? c : mine; }
        if (sum == G) break;
        __builtin_amdgcn_s_sleep(1);
        if ((++sp & 255u) == 0u) { if (xb_ld(&bar[XB_TMO])) break; if (sp > XB_SPIN_CAP) { atomicAdd(&bar[XB_TMO], 1u); break; } }
    }
    nloc = mine > 0u ? mine : 1u; nx = cnt > 0u ? cnt : 1u;
}

__device__ __forceinline__ void xcd_barrier(const XcdBarrier& b) {
    asm volatile("s_waitcnt vmcnt(0)" ::: "memory");
    __syncthreads();
    if (threadIdx.x == 0) {
        unsigned* bar = b.bar;
        __builtin_amdgcn_s_waitcnt(0);
        unsigned nloc = b.st[0], nx = b.st[1];
        if (nloc == 0u) { xcd_barrier_complete(bar, b.x, nloc, nx); b.st[0] = nloc; b.st[1] = nx; }
        const unsigned old = xb_add(&bar[XB_XSUB(b.x)], 1u);
        const unsigned gen = old / nloc;
        if (old + 1u == (gen + 1u) * nloc) {
            __builtin_amdgcn_fence(__ATOMIC_RELEASE, "agent");
            asm volatile("s_waitcnt vmcnt(0)" ::: "memory");
            const unsigned og = xb_add(&bar[XB_TOP], 1u);
            const unsigned tg = og / nx;
            if (og + 1u == (tg + 1u) * nx) xb_add(&bar[XB_TOPGEN], 1u);
            else XB_SPIN(xb_ld(&bar[XB_TOPGEN]) == tg, bar);
            __builtin_amdgcn_fence(__ATOMIC_ACQUIRE, "agent");
            xb_add(&bar[XB_XGEN(b.x)], 1u);
            asm volatile("s_waitcnt vmcnt(0)" ::: "memory");
        } else {
            XB_SPIN(xb_ld(&bar[XB_XGEN(b.x)]) == gen, bar);
            __builtin_amdgcn_fence(__ATOMIC_ACQUIRE, "agent");
            asm volatile("s_waitcnt vmcnt(0)" ::: "memory");
        }
    }
    __syncthreads();
}
constexpr int NWAVES = 8;
constexpr int DM = 1024, SEQ = 4096, NB = 8, NSB = 128, NST = 8, FF = 4096;
constexpr int MP = NB * SEQ;
constexpr int MS = NSB * NST;
constexpr int M = MP + MS;
constexpr int N_IN0 = 2304, N_IN1 = 2048;
constexpr float LN_EPS = 1e-5f;
constexpr float ALPHA = 1.4142135623730951f;
constexpr float LOG2E = 1.4426950408889634f;
constexpr float QS = 0.125f * LOG2E;
constexpr int NA_HIST = 128, ND_HIST = 2048;

constexpr size_t O_Y = 0, O_AKP = 34603008, O_AVP = 34734080, O_BCP = 34865152, O_CPP = 34873344, O_DKP = 34934784, O_DVP = 43323392,
                 O_AKS = 51712000, O_AVS = 53809152, O_BCS = 55906304, O_CPS = 56037376, O_DKS = 57020416, O_DVS = 191238144, O_TOTAL = 325455872;

constexpr size_t MiB = 1u << 20;
constexpr size_t WS_CTL = 0, CTL_ZERO_BYTES = 1 * MiB;
constexpr size_t WS_WIN0 = 2 * MiB, WS_WOUT0 = 8 * MiB, WS_W1_0 = 10 * MiB, WS_W2_0 = 18 * MiB, WS_WIN1 = 26 * MiB, WS_WOUT1 = 30 * MiB, WS_W1_1 = 32 * MiB, WS_W2_1 = 40 * MiB;
constexpr size_t WS_VEC = 48 * MiB;
constexpr int V_BIN0 = 0, V_CS1_0 = 4096, V_BW1_0 = 8192, V_CSIN1 = 12288, V_BWIN1 = 16384, V_CS1_1 = 20480, V_BW1_1 = 24576;
constexpr size_t WS_STA = 49 * MiB, WS_STB = 51 * MiB;
constexpr size_t WS_XB = 64 * MiB;
constexpr size_t WS_Q = 130 * MiB, WS_K = 163 * MiB, WS_V = 196 * MiB, WS_C = 229 * MiB, WS_GB = 262 * MiB;
constexpr size_t WS_MIX = 295 * MiB;
constexpr size_t WS_ZH0 = 361 * MiB, WS_ZH1 = 493 * MiB;
constexpr size_t WS_ZB = 559 * MiB;
constexpr size_t WS_H = 691 * MiB;
constexpr size_t WS_STO = 955 * MiB;
constexpr size_t WS_STML = 1021 * MiB;
constexpr size_t WS_END = 1024 * MiB;
constexpr int CW_BAR = 4096;

constexpr int RING_BYTES = 131072;
constexpr int LDSCTL_OFF = RING_BYTES, MISC_OFF = LDSCTL_OFF + 320;
constexpr int EPI_P_OFF = RING_BYTES + 1024;
constexpr int EPI_S_OFF = EPI_P_OFF + 8192;
constexpr int EPI_R_OFF = EPI_S_OFF + 2048;
constexpr int EPI_V_OFF = EPI_R_OFF + 8192;
constexpr int LDS_BYTES = 154624;
static_assert(EPI_V_OFF + 4096 <= LDS_BYTES && LDS_BYTES <= 163840, "LDS map");

typedef float f32x2v __attribute__((ext_vector_type(2)));
typedef unsigned u32x2v __attribute__((ext_vector_type(2)));
using pg8::bf16_t; using pg8::Unit; using pg8::u32x4;
#define EPI_BAR() do { asm volatile("s_waitcnt lgkmcnt(0)" ::: "memory"); __builtin_amdgcn_s_barrier(); asm volatile("" ::: "memory"); } while (0)

__device__ __forceinline__ u32x4 pack8(const f32x4 a, const f32x4 b) { u32x4 w; w.x = pg8::cvt_pk_bf16(a[0], a[1]); w.y = pg8::cvt_pk_bf16(a[2], a[3]); w.z = pg8::cvt_pk_bf16(b[0], b[1]); w.w = pg8::cvt_pk_bf16(b[2], b[3]); return w; }
__device__ __forceinline__ float bf2f(unsigned short h) { return __builtin_bit_cast(float, (unsigned)h << 16); }
__device__ __forceinline__ float bflo(unsigned w) { return __builtin_bit_cast(float, w << 16); }
__device__ __forceinline__ float bfhi(unsigned w) { return __builtin_bit_cast(float, w & 0xffff0000u); }

__device__ __forceinline__ void swap32(float& a, float& b) { asm volatile("s_nop 1\n\tv_permlane32_swap_b32 %0, %1\n\ts_nop 1" : "+v"(a), "+v"(b)); }
__device__ __forceinline__ void swap32(unsigned& a, unsigned& b) { asm volatile("s_nop 1\n\tv_permlane32_swap_b32 %0, %1\n\ts_nop 1" : "+v"(a), "+v"(b)); }
__device__ __forceinline__ void swap16(float& a, float& b) { asm volatile("s_nop 1\n\tv_permlane16_swap_b32 %0, %1\n\ts_nop 1" : "+v"(a), "+v"(b)); }
__device__ __forceinline__ float rows16_sum(float v) { float a = v, b = v; swap16(a, b); const float s2 = a + b; a = s2; b = s2; swap32(a, b); return a + b; }
__device__ __forceinline__ void epi_dma1k(const void* g, LAS unsigned char* l, int lane) { __builtin_amdgcn_global_load_lds((const unsigned*)((const char*)g + lane * 16), (LAS unsigned*)l, 16, 0, 0); }
__device__ __forceinline__ void epi_pre_slots(const float* slots, int pm, LAS unsigned char* lds, int wid, int lane) {
    const char* src = (const char*)(slots + (size_t)pm * 256 * 8); const int c = 2 * (wid - 4);
    epi_dma1k(src + c * 1024, lds + EPI_R_OFF + c * 1024, lane); epi_dma1k(src + (c + 1) * 1024, lds + EPI_R_OFF + (c + 1) * 1024, lane);
}
__device__ __forceinline__ void epi_pre_vec(const float* v, int col0, int slot, LAS unsigned char* lds, int lane) { epi_dma1k(v + col0, lds + EPI_V_OFF + slot * 1024, lane); }
__device__ __forceinline__ void epi_stats_lds(LAS unsigned char* lds, int tid) {
    LAS f32x2v* S = (LAS f32x2v*)(lds + EPI_S_OFF);
    if (tid < 256) {
        const LAS f32x4* sp = (const LAS f32x4*)(lds + EPI_R_OFF + tid * 32);
        const f32x4 a = sp[0], b = sp[1];
        const float mean = ((a[0] + a[2]) + (b[0] + b[2])) * 0.25f;
        const float d0 = a[0] - mean, d1 = a[2] - mean, d2 = b[0] - mean, d3 = b[2] - mean;
        const float q = ((a[1] + a[3]) + (b[1] + b[3])) + 256.0f * ((d0 * d0 + d1 * d1) + (d2 * d2 + d3 * d3));
        S[tid] = (f32x2v){mean, 1.0f / sqrtf(q * (1.0f / 1024.0f) + LN_EPS)};
    }
    EPI_BAR();
}
__device__ __forceinline__ void epi_load_stats(const float* slots, int pm, LAS unsigned char* lds, int tid) {
    LAS f32x2v* S = (LAS f32x2v*)(lds + EPI_S_OFF);
    if (tid < 256) {
        const f32x4* sp = (const f32x4*)(slots + (size_t)(pm * 256 + tid) * 8);
        const f32x4 a = sp[0], b = sp[1];
        const float mean = ((a[0] + a[2]) + (b[0] + b[2])) * 0.25f;
        const float d0 = a[0] - mean, d1 = a[2] - mean, d2 = b[0] - mean, d3 = b[2] - mean;
        const float q = ((a[1] + a[3]) + (b[1] + b[3])) + 256.0f * ((d0 * d0 + d1 * d1) + (d2 * d2 + d3 * d3));
        S[tid] = (f32x2v){mean, 1.0f / sqrtf(q * (1.0f / 1024.0f) + LN_EPS)};
    }
    EPI_BAR();
}
__device__ __forceinline__ void epi_row_stats(const f32x4 (&z)[2][2], LAS unsigned char* lds, int rl, int wc, int fq) {
    float s = 0.f;
#pragma unroll
    for (int bj = 0; bj < 2; ++bj)
#pragma unroll
        for (int n = 0; n < 2; ++n) s += (z[bj][n][0] + z[bj][n][1]) + (z[bj][n][2] + z[bj][n][3]);
    s = rows16_sum(s);
    const float mw = s * (1.0f / 64.0f); float q = 0.f;
#pragma unroll
    for (int bj = 0; bj < 2; ++bj)
#pragma unroll
        for (int n = 0; n < 2; ++n) { const f32x4 d = z[bj][n] - mw; q += (d[0] * d[0] + d[1] * d[1]) + (d[2] * d[2] + d[3] * d[3]); }
    q = rows16_sum(q);
    if (fq == 0) ((LAS f32x2v*)(lds + EPI_P_OFF))[rl * 4 + wc] = (f32x2v){mw, q};
}
__device__ __forceinline__ void epi_store_stats(float* slots, int pm, int pn, LAS unsigned char* lds, int tid) {
    if (tid < 256) {
        const LAS f32x2v* P = (const LAS f32x2v*)(lds + EPI_P_OFF) + tid * 4;
        const f32x2v a = P[0], b = P[1], c = P[2], d = P[3];
        const float mt = ((a.x + b.x) + (c.x + d.x)) * 0.25f;
        const float da = a.x - mt, db = b.x - mt, dc = c.x - mt, dd = d.x - mt;
        const float m2 = ((a.y + b.y) + (c.y + d.y)) + 64.0f * ((da * da + db * db) + (dc * dc + dd * dd));
        *(f32x2v*)(slots + (size_t)(pm * 256 + tid) * 8 + pn * 2) = (f32x2v){mt, m2};
    }
}


struct EpiIn0 {
    static constexpr bool PERM = true, AFTER_DRAIN = false;
    bf16_t *Q, *K, *V, *C, *GB; const float* bias; float* out;
    __device__ __forceinline__ void pre(const Unit&, int, int) const {}
    __device__ __forceinline__ void operator()(const f32x4 (&acc)[2][2][4][2], const Unit& u, int wr, int wc, int fr_in, int fq_in) const {
        int fr = fr_in, fq = fq_in; asm volatile("" : "+v"(fr), "+v"(fq));
        const int pn = u.pn, cc0 = wc * 32 + 8 * fq;
        f32x4 bv[2][2];
#pragma unroll
        for (int bj = 0; bj < 2; ++bj)
#pragma unroll
            for (int n = 0; n < 2; ++n) bv[bj][n] = *(const f32x4*)(bias + pn * 256 + bj * 128 + cc0 + 4 * n);
#pragma unroll
        for (int ai = 0; ai < 2; ++ai)
#pragma unroll
            for (int m = 0; m < 4; ++m) {
                const int row = u.pm * 256 + ai * 128 + wr * 64 + m * 16 + fr;
                f32x4 v[2][2];
#pragma unroll
                for (int bj = 0; bj < 2; ++bj)
#pragma unroll
                    for (int n = 0; n < 2; ++n) v[bj][n] = acc[ai][bj][m][n] + bv[bj][n];
                if (pn < 2) {
#pragma unroll
                    for (int bj = 0; bj < 2; ++bj) *(u32x4*)(Q + (size_t)row * 512 + pn * 256 + bj * 128 + cc0) = pack8(v[bj][0] * QS, v[bj][1] * QS);
                } else if (pn == 2) {
                    *(u32x4*)(K + (size_t)row * 128 + cc0) = pack8(v[0][0], v[0][1]);
                    *(u32x4*)(V + (size_t)row * 128 + cc0) = pack8(v[1][0], v[1][1]);
                    long o = -1;
                    if (row >= MP) { const int s = row - MP; o = (long)((s >> 3) * 128 + 120 + (s & 7)) * 128 + (long)(O_AKS - O_AKP); }
                    else { const int t = row & (SEQ - 1); if (t >= SEQ - 128) o = (long)((row >> 12) * 128 + t - (SEQ - 128)) * 128; }
                    if (o >= 0) {
                        float* ok = out + O_AKP + o + cc0; float* ov = ok + (row >= MP ? (O_AVS - O_AKS) : (O_AVP - O_AKP));
                        *(f32x4*)ok = v[0][0]; *(f32x4*)(ok + 4) = v[0][1]; *(f32x4*)ov = v[1][0]; *(f32x4*)(ov + 4) = v[1][1];
                    }
                } else if (pn < 7) {
                    const int p = pn - 3; const f32x4 c0 = v[0][0] * v[1][0], c1 = v[0][1] * v[1][1];
                    *(u32x4*)(C + (size_t)row * 512 + p * 128 + cc0) = pack8(c0, c1);
                    long o = -1;
                    if (row >= MP) { const int s = row - MP; if ((s & 7) >= 6) o = (long)((s >> 3) * 2 + (s & 7) - 6) * 512 + (long)(O_BCS - O_BCP); }
                    else { const int t = row & (SEQ - 1); if (t >= SEQ - 2) o = (long)((row >> 12) * 2 + t - (SEQ - 2)) * 512; }
                    if (o >= 0) { float* oc = out + O_BCP + o + p * 128 + cc0; *(f32x4*)oc = c0; *(f32x4*)(oc + 4) = c1; }
                } else {
#pragma unroll
                    for (int bj = 0; bj < 2; ++bj) *(u32x4*)(GB + (size_t)row * 512 + (pn - 7) * 256 + bj * 128 + cc0) = pack8(v[bj][0], v[bj][1]);
                }
            }
    }
};

struct EpiIn1 {
    static constexpr bool PERM = true, AFTER_DRAIN = false;
    bf16_t *U, *Q, *K, *V; const float *cs, *bw, *slots; float* out; LAS unsigned char* lds;
    __device__ __forceinline__ void pre(const Unit& u, int wid, int lane) const { epi_pre_slots(slots, u.pm, lds, wid, lane); if (wid == 4) epi_pre_vec(cs, u.pn * 256, 0, lds, lane); if (wid == 5) epi_pre_vec(bw, u.pn * 256, 1, lds, lane); }
    __device__ __forceinline__ void operator()(const f32x4 (&acc)[2][2][4][2], const Unit& u, int wr, int wc, int fr_in, int fq_in) const {
        int fr = fr_in, fq = fq_in; asm volatile("" : "+v"(fr), "+v"(fq));
        const int pn = u.pn, cc0 = wc * 32 + 8 * fq, tid = threadIdx.x;
        f32x4 cv[2][2], bv[2][2];
#pragma unroll
        for (int bj = 0; bj < 2; ++bj)
#pragma unroll
            for (int n = 0; n < 2; ++n) { cv[bj][n] = *(const LAS f32x4*)(lds + EPI_V_OFF + (bj * 128 + cc0 + 4 * n) * 4); bv[bj][n] = *(const LAS f32x4*)(lds + EPI_V_OFF + 1024 + (bj * 128 + cc0 + 4 * n) * 4); }
        epi_stats_lds(lds, tid);
        const LAS f32x2v* S = (const LAS f32x2v*)(lds + EPI_S_OFF);
        const int sel = pn >> 1; bf16_t* dst = sel == 0 ? U : sel == 1 ? Q : sel == 2 ? K : V;
        const float sc = sel == 1 ? QS : 1.0f;
        const size_t obase = sel == 0 ? O_CPP : sel == 2 ? O_DKP : O_DVP;
#pragma unroll
        for (int ai = 0; ai < 2; ++ai)
#pragma unroll
            for (int m = 0; m < 4; ++m) {
                const int rl = ai * 128 + wr * 64 + m * 16 + fr, row = u.pm * 256 + rl;
                const f32x2v st = S[rl];
                f32x4 v[2][2];
#pragma unroll
                for (int bj = 0; bj < 2; ++bj)
#pragma unroll
                    for (int n = 0; n < 2; ++n) v[bj][n] = (acc[ai][bj][m][n] - cv[bj][n] * st.x) * st.y + bv[bj][n];
                const int c512 = (pn & 1) * 256 + cc0;
#pragma unroll
                for (int bj = 0; bj < 2; ++bj) *(u32x4*)(dst + (size_t)row * 512 + c512 + bj * 128) = pack8(v[bj][0] * sc, v[bj][1] * sc);
                if (sel != 1) {
                    long o = -1;
                    if (sel == 0) {
                        if (row >= MP) { const int s = row - MP; o = (long)((s >> 3) * 15 + 7 + (s & 7)) * 512 + (long)(O_CPS - O_CPP); }
                        else { const int t = row & (SEQ - 1); if (t >= SEQ - 15) o = (long)((row >> 12) * 15 + t - (SEQ - 15)) * 512; }
                    } else {
                        if (row >= MP) { const int s = row - MP; o = (long)((s >> 3) * 2048 + 2040 + (s & 7)) * 512 + (sel == 2 ? (long)(O_DKS - O_DKP) : (long)(O_DVS - O_DVP)); }
                        else { const int t = row & (SEQ - 1); if (t >= SEQ - 2048) o = (long)((row >> 12) * 2048 + t - (SEQ - 2048)) * 512; }
                    }
                    if (o >= 0) {
                        float* op = out + obase + o + c512;
#pragma unroll
                        for (int bj = 0; bj < 2; ++bj) { *(f32x4*)(op + bj * 128) = v[bj][0]; *(f32x4*)(op + bj * 128 + 4) = v[bj][1]; }
                    }
                }
            }
    }
};

struct EpiMlp1 {
    static constexpr bool PERM = true, AFTER_DRAIN = false;
    bf16_t* H; const float *cs, *bw, *slots; LAS unsigned char* lds;
    __device__ __forceinline__ void pre(const Unit& u, int wid, int lane) const { epi_pre_slots(slots, u.pm, lds, wid, lane); if (wid == 4) epi_pre_vec(cs, u.pn * 256, 0, lds, lane); if (wid == 5) epi_pre_vec(bw, u.pn * 256, 1, lds, lane); }
    __device__ __forceinline__ void operator()(const f32x4 (&acc)[2][2][4][2], const Unit& u, int wr, int wc, int fr_in, int fq_in) const {
        int fr = fr_in, fq = fq_in; asm volatile("" : "+v"(fr), "+v"(fq));
        const int cc0 = u.pn * 256 + wc * 32 + 8 * fq, tid = threadIdx.x;
        f32x4 cv[2][2], bv[2][2];
        { const int cl = wc * 32 + 8 * fq;
#pragma unroll
        for (int bj = 0; bj < 2; ++bj)
#pragma unroll
            for (int n = 0; n < 2; ++n) { cv[bj][n] = *(const LAS f32x4*)(lds + EPI_V_OFF + (bj * 128 + cl + 4 * n) * 4); bv[bj][n] = *(const LAS f32x4*)(lds + EPI_V_OFF + 1024 + (bj * 128 + cl + 4 * n) * 4); } }
        epi_stats_lds(lds, tid);
        const LAS f32x2v* S = (const LAS f32x2v*)(lds + EPI_S_OFF);
#pragma unroll
        for (int ai = 0; ai < 2; ++ai)
#pragma unroll
            for (int m = 0; m < 4; ++m) {
                const int rl = ai * 128 + wr * 64 + m * 16 + fr, row = u.pm * 256 + rl;
                const f32x2v st = S[rl];
#pragma unroll
                for (int bj = 0; bj < 2; ++bj) {
                    f32x4 v0 = (acc[ai][bj][m][0] - cv[bj][0] * st.x) * st.y + bv[bj][0], v1 = (acc[ai][bj][m][1] - cv[bj][1] * st.x) * st.y + bv[bj][1];
#pragma unroll
                    for (int e = 0; e < 4; ++e) { const float a = fmaxf(v0[e], 0.f), b = fmaxf(v1[e], 0.f); v0[e] = a * a; v1[e] = b * b; }
                    *(u32x4*)(H + (size_t)row * FF + cc0 + bj * 128) = pack8(v0, v1);
                }
            }
    }
};

template <bool LNRES, bool HAS_BIAS, bool F32OUT>
struct EpiRes {
    static constexpr bool PERM = true, AFTER_DRAIN = false;
    const bf16_t* rprev;
    const float *sprev, *g, *b;
    const float* bias; float* zout; bf16_t* zb; float* sout; LAS unsigned char* lds;
    __device__ __forceinline__ void pre(const Unit& u, int wid, int lane) const {
        if (LNRES) { epi_pre_slots(sprev, u.pm, lds, wid, lane); if (wid == 4) epi_pre_vec(g, u.pn * 256, 0, lds, lane); if (wid == 5) epi_pre_vec(b, u.pn * 256, 1, lds, lane); }
        if (HAS_BIAS && wid == 6) epi_pre_vec(bias, u.pn * 256, 2, lds, lane);
    }
    __device__ __forceinline__ void operator()(const f32x4 (&acc)[2][2][4][2], const Unit& u, int wr, int wc, int fr_in, int fq_in) const {
        int fr = fr_in, fq = fq_in; asm volatile("" : "+v"(fr), "+v"(fq));
        const int col0 = u.pn * 256 + wc * 32 + 8 * fq, tid = threadIdx.x;
        const size_t prow = (size_t)u.pm * 256;
        f32x4 gv[2][2], bv[2][2];
#pragma unroll
        for (int bj = 0; bj < 2; ++bj)
#pragma unroll
            for (int n = 0; n < 2; ++n) {
                const int cb = (bj * 128 + wc * 32 + 8 * fq + 4 * n) * 4;
                const f32x4 biv = HAS_BIAS ? *(const LAS f32x4*)(lds + EPI_V_OFF + 2048 + cb) : (f32x4){0.f, 0.f, 0.f, 0.f};
                if (LNRES) { gv[bj][n] = *(const LAS f32x4*)(lds + EPI_V_OFF + cb) * ALPHA; bv[bj][n] = *(const LAS f32x4*)(lds + EPI_V_OFF + 1024 + cb) * ALPHA + biv; }
                else { gv[bj][n] = (f32x4){ALPHA, ALPHA, ALPHA, ALPHA}; bv[bj][n] = biv; }
            }
        if (LNRES) epi_stats_lds(lds, tid);
        const LAS f32x2v* S = (const LAS f32x2v*)(lds + EPI_S_OFF);
#pragma unroll
        for (int ai = 0; ai < 2; ++ai) {
            u32x4 rw[4][2];
#pragma unroll
            for (int m = 0; m < 4; ++m)
#pragma unroll
                for (int bj = 0; bj < 2; ++bj) rw[m][bj] = *(const u32x4*)(rprev + (prow + ai * 128 + wr * 64 + m * 16 + fr) * DM + col0 + bj * 128);
#pragma unroll
            for (int m = 0; m < 4; ++m) {
                const int rl = ai * 128 + wr * 64 + m * 16 + fr; const size_t row = prow + rl;
                f32x2v st = (f32x2v){0.f, 1.f}; if (LNRES) st = S[rl];
                f32x4 z[2][2];
#pragma unroll
                for (int bj = 0; bj < 2; ++bj) {
                    const u32x4 w = rw[m][bj];
                    const f32x4 x0 = (f32x4){bflo(w.x), bfhi(w.x), bflo(w.y), bfhi(w.y)}, x1 = (f32x4){bflo(w.z), bfhi(w.z), bflo(w.w), bfhi(w.w)};
                    z[bj][0] = acc[ai][bj][m][0] + ((x0 - st.x) * st.y) * gv[bj][0] + bv[bj][0];
                    z[bj][1] = acc[ai][bj][m][1] + ((x1 - st.x) * st.y) * gv[bj][1] + bv[bj][1];
                }
#pragma unroll
                for (int bj = 0; bj < 2; ++bj) {
                    if (F32OUT) { float* zo = zout + row * DM + col0 + bj * 128; *(f32x4*)zo = z[bj][0]; *(f32x4*)(zo + 4) = z[bj][1]; }
                    else *(u32x4*)(zb + row * DM + col0 + bj * 128) = pack8(z[bj][0], z[bj][1]);
                }
                epi_row_stats(z, lds, rl, wc, fq);
            }
            asm volatile("" ::: "memory");
        }
        EPI_BAR();
        epi_store_stats(sout, u.pm, u.pn, lds, tid);
    }
};

constexpr int CW_PANEL = 16384;
struct EpiResFinal {
    static constexpr bool PERM = true, AFTER_DRAIN = false;
    const bf16_t* rprev; const float *sprev, *g, *b, *g2, *b2; float* out; float* xslots; gu32* ctl; LAS unsigned char* lds;
    __device__ __forceinline__ void pre(const Unit& u, int wid, int lane) const {
        epi_pre_slots(sprev, u.pm, lds, wid, lane);
        epi_pre_vec(wid == 4 ? g : wid == 5 ? b : wid == 6 ? g2 : b2, u.pn * 256, wid - 4, lds, lane);
    }
    __device__ __forceinline__ void operator()(const f32x4 (&acc_in)[2][2][4][2], const Unit& u, int wr, int wc, int fr_in, int fq_in) const {
        f32x4 (&acc)[2][2][4][2] = const_cast<f32x4 (&)[2][2][4][2]>(acc_in);
        int fr = fr_in, fq = fq_in; asm volatile("" : "+v"(fr), "+v"(fq));
        const int col0 = u.pn * 256 + wc * 32 + 8 * fq, tid = threadIdx.x;
        const size_t prow = (size_t)u.pm * 256;
        const int cb0 = (wc * 32 + 8 * fq) * 4;
        epi_stats_lds(lds, tid);
        const LAS f32x2v* S = (const LAS f32x2v*)(lds + EPI_S_OFF);
        {
            f32x4 gv[2][2], bv[2][2];
#pragma unroll
            for (int bj = 0; bj < 2; ++bj)
#pragma unroll
                for (int n = 0; n < 2; ++n) { const int cb = cb0 + (bj * 128 + 4 * n) * 4; gv[bj][n] = *(const LAS f32x4*)(lds + EPI_V_OFF + cb) * ALPHA; bv[bj][n] = *(const LAS f32x4*)(lds + EPI_V_OFF + 1024 + cb) * ALPHA; }
#pragma unroll
            for (int ai = 0; ai < 2; ++ai) {
                u32x4 rw[4][2];
#pragma unroll
                for (int m = 0; m < 4; ++m)
#pragma unroll
                    for (int bj = 0; bj < 2; ++bj) rw[m][bj] = *(const u32x4*)(rprev + (prow + ai * 128 + wr * 64 + m * 16 + fr) * DM + col0 + bj * 128);
#pragma unroll
                for (int m = 0; m < 4; ++m) {
                    const int rl = ai * 128 + wr * 64 + m * 16 + fr; const f32x2v st = S[rl];
                    f32x4 z[2][2];
#pragma unroll
                    for (int bj = 0; bj < 2; ++bj) {
                        const u32x4 w = rw[m][bj];
                        const f32x4 x0 = (f32x4){bflo(w.x), bfhi(w.x), bflo(w.y), bfhi(w.y)}, x1 = (f32x4){bflo(w.z), bfhi(w.z), bflo(w.w), bfhi(w.w)};
                        z[bj][0] = acc[ai][bj][m][0] + ((x0 - st.x) * st.y) * gv[bj][0] + bv[bj][0];
                        z[bj][1] = acc[ai][bj][m][1] + ((x1 - st.x) * st.y) * gv[bj][1] + bv[bj][1];
                        acc[ai][bj][m][0] = z[bj][0]; acc[ai][bj][m][1] = z[bj][1];
                    }
                    epi_row_stats(z, lds, rl, wc, fq);
                }
                asm volatile("" ::: "memory");
            }
        }
        EPI_BAR();
        if (tid < 256) {
            const LAS f32x2v* P = (const LAS f32x2v*)(lds + EPI_P_OFF) + tid * 4;
            const f32x2v a = P[0], b2_ = P[1], c = P[2], d = P[3];
            const float mt = ((a.x + b2_.x) + (c.x + d.x)) * 0.25f;
            const float da = a.x - mt, db = b2_.x - mt, dc = c.x - mt, dd = d.x - mt;
            const float m2 = ((a.y + b2_.y) + (c.y + d.y)) + 64.0f * ((da * da + db * db) + (dc * dc + dd * dd));
            unsigned long long* slot = (unsigned long long*)(xslots + (prow + tid) * 8 + u.pn * 2);
            __hip_atomic_store(slot, ((unsigned long long)__builtin_bit_cast(unsigned, m2) << 32) | __builtin_bit_cast(unsigned, mt), __ATOMIC_RELAXED, __HIP_MEMORY_SCOPE_AGENT);
        }
        asm volatile("s_waitcnt vmcnt(0)" ::: "memory");
        EPI_BAR();
        if (tid == 0) {
            gu32* cnt = ctl + CW_PANEL + 64 * u.pm;
            __hip_atomic_fetch_add(cnt, 1u, RLX_AGENT);
            unsigned sp = 0;
            while (__hip_atomic_load(cnt, RLX_AGENT) < 4u) { __builtin_amdgcn_s_sleep(1); if (++sp > XB_SPIN_CAP) { atomicAdd((unsigned*)(ctl + CW_BAR) + XB_TMO, 1u); break; } }
            __builtin_amdgcn_fence(__ATOMIC_ACQUIRE, "agent");
            asm volatile("s_waitcnt vmcnt(0)" ::: "memory");
        }
        EPI_BAR();
        if (tid < 256) {
            const unsigned long long* slot = (const unsigned long long*)(xslots + (prow + tid) * 8); float mt[4], m2[4];
#pragma unroll
            for (int t = 0; t < 4; ++t) { const unsigned long long w = __hip_atomic_load(slot + t, __ATOMIC_RELAXED, __HIP_MEMORY_SCOPE_AGENT); mt[t] = __builtin_bit_cast(float, (unsigned)w); m2[t] = __builtin_bit_cast(float, (unsigned)(w >> 32)); }
            const float mean = ((mt[0] + mt[1]) + (mt[2] + mt[3])) * 0.25f;
            float q = 0.f;
#pragma unroll
            for (int t = 0; t < 4; ++t) { const float dm = mt[t] - mean; q += m2[t] + 256.0f * dm * dm; }
            ((LAS f32x2v*)(lds + EPI_S_OFF))[tid] = (f32x2v){mean, 1.0f / sqrtf(q * (1.0f / 1024.0f) + LN_EPS)};
        }
        EPI_BAR();
#pragma unroll
        for (int ai = 0; ai < 2; ++ai)
#pragma unroll
            for (int m = 0; m < 4; ++m) {
                const int rl = ai * 128 + wr * 64 + m * 16 + fr; const f32x2v st = S[rl]; float* yo = out + (prow + rl) * DM + col0;
#pragma unroll
                for (int bj = 0; bj < 2; ++bj)
#pragma unroll
                    for (int n = 0; n < 2; ++n) { const int cb = cb0 + (bj * 128 + 4 * n) * 4;
                        *(f32x4*)(yo + bj * 128 + 4 * n) = ((acc[ai][bj][m][n] - st.x) * st.y) * *(const LAS f32x4*)(lds + EPI_V_OFF + 2048 + cb) + *(const LAS f32x4*)(lds + EPI_V_OFF + 3072 + cb); }
            }
    }
};
struct Args { const float* in[26]; float* out; unsigned char* ws; };
struct Frame {
    LAS unsigned char* lds; gu32* ctl; int tid, lane, wave, vcu, G, gw, NGW, vcu_lt240;
};
__device__ __forceinline__ float wave_sum(float v) {
#pragma unroll
    for (int o = 1; o < 64; o <<= 1) v += __shfl_xor(v, o);
    return v;
}
__device__ __forceinline__ float wave_max(float v) {
#pragma unroll
    for (int o = 1; o < 64; o <<= 1) v = fmaxf(v, __shfl_xor(v, o));
    return v;
}

__device__ __forceinline__ void transpose_tile(const float* W, int ldw, int n0, int k0, const float* gk, bf16_t* WT, int ldt, int drow0, int kdst0, LAS float* scr, int lane) {
    {
        float wv[32];
#pragma unroll
        for (int i = 0; i < 32; ++i) { const int kk = 2 * i + (lane >> 5); wv[i] = W[(size_t)(k0 + kk) * ldw + n0 + (lane & 31)]; }
#pragma unroll
        for (int i = 0; i < 32; ++i) { const int kk = 2 * i + (lane >> 5); float w = wv[i]; if (gk) w *= gk[k0 + kk]; scr[kk * 33 + (lane & 31)] = w; }
    }
    LDS_WAIT(); asm volatile("" ::: "memory");
    const int c = lane & 7;
#pragma unroll
    for (int j = 0; j < 4; ++j) { const int n = (lane >> 3) + 8 * j; const LAS float* s = scr + (8 * c) * 33 + n;
        v4u o; o.x = pk2(s[0 * 33], s[1 * 33]); o.y = pk2(s[2 * 33], s[3 * 33]); o.z = pk2(s[4 * 33], s[5 * 33]); o.w = pk2(s[6 * 33], s[7 * 33]);
        *(GAS v4u*)(WT + (size_t)(drow0 + n) * ldt + kdst0 + k0 + 8 * c) = o; }
    LDS_WAIT(); asm volatile("" ::: "memory");
}
__device__ __forceinline__ int in0_src_col(int np) {
    if (np < 768) return np;
    if (np < 1792) { const int tt = np - 768, p = tt >> 8, w = tt & 255; return w < 128 ? 768 + 128 * p + w : 1792 + 128 * p + (w - 128); }
    return 1280 + (np - 1792);
}
__device__ __forceinline__ void colsum_item(const float* W, int K, int N, const float* g, const float* b, const float* bias, float* cs, float* bw, int item, int lane) {
    const int n = item * 16 + (lane & 15), kq = lane >> 4, kn = K / 4;
    float a = 0.f, c = 0.f;
    for (int k0 = kq * kn; k0 < (kq + 1) * kn; k0 += 32) {
        float w[32], gg[32], bb[32];
#pragma unroll
        for (int u = 0; u < 32; ++u) { w[u] = W[(size_t)(k0 + u) * N + n]; gg[u] = g[k0 + u]; bb[u] = b[k0 + u]; }
#pragma unroll
        for (int u = 0; u < 32; ++u) { a += __builtin_bit_cast(float, f2bf(gg[u] * w[u]) << 16); c += bb[u] * w[u]; }
    }
    a += __shfl_xor(a, 16); a += __shfl_xor(a, 32); c += __shfl_xor(c, 16); c += __shfl_xor(c, 32);
    if (lane < 16) { cs[n] = a; bw[n] = c + (bias ? bias[n] : 0.f); }
}
__device__ __forceinline__ void poolfold_item(const float* Wg, const float* scale, const float* Wo, bf16_t* WT, int item, int lane) {
    const int nb = item & 15, ib = (item >> 4) & 15, g = item >> 8, n = nb * 64 + lane, i0 = ib * 8;
    float acc[8];
#pragma unroll
    for (int ii = 0; ii < 8; ++ii) acc[ii] = 0.f;
    const float* wg = Wg + (size_t)g * 128 * 128 + (size_t)i0 * 128;
    for (int j0 = 0; j0 < 128; j0 += 16) {
        float w[16], wgv[8][16];
#pragma unroll
        for (int u = 0; u < 16; ++u) { w[u] = scale[128 * g + j0 + u] * Wo[(size_t)(128 * g + j0 + u) * DM + n];
#pragma unroll
            for (int ii = 0; ii < 8; ++ii) wgv[ii][u] = wg[ii * 128 + j0 + u]; }
#pragma unroll
        for (int u = 0; u < 16; ++u)
#pragma unroll
            for (int ii = 0; ii < 8; ++ii) acc[ii] += wgv[ii][u] * w[u];
    }
    v4u o; o.x = pk2(acc[0], acc[1]); o.y = pk2(acc[2], acc[3]); o.z = pk2(acc[4], acc[5]); o.w = pk2(acc[6], acc[7]);
    *(GAS v4u*)(WT + (size_t)n * DM + 128 * g + i0) = o;
}
constexpr int CW_COPY_HEAD = 8192, CW_DONE0 = 8256;
constexpr unsigned U_A = 120, U_C = 28, U_DB = NSB * 24, NUNIT = 2 * U_A + U_C + 2 * U_DB;
template <int NT, int NB>
__device__ __forceinline__ void copy_dblock_unit(const float* src, float* dst, unsigned idx, int t) {
    const unsigned b = idx / 24u, q = idx - b * 24u;
    const GAS f32x4* s = (const GAS f32x4*)src + (size_t)b * ND_HIST * 128; GAS f32x4* d = (GAS f32x4*)dst + (size_t)b * ND_HIST * 128;
    constexpr int NPER = 4096 / NT;
#pragma unroll 1
    for (int h = 0; h < NPER; h += NB) {
        f32x4 v[NB]; size_t di[NB];
#pragma unroll
        for (int k = 0; k < NB; ++k) { const unsigned p = (unsigned)(h + k) * (unsigned)NT + (unsigned)t, blk = p >> 10, w = p & 1023u; di[k] = (size_t)(16u * (4u * q + blk)) * 128 + w; v[k] = __builtin_nontemporal_load(s + di[k] + 8 * 128); }
#pragma unroll
        for (int k = 0; k < NB; ++k) __builtin_nontemporal_store(v[k], d + di[k]);
    }
}
template <int BP, int SKIP, int NT, int NB  >
__device__ __forceinline__ void copy_unit(const float* src, float* dst, unsigned unit, int t) {
    const GAS f32x4* s = (const GAS f32x4*)src; GAS f32x4* d = (GAS f32x4*)dst;
    constexpr unsigned PER = BP - SKIP; constexpr int NPER = 4096 / NT;
#pragma unroll 1
    for (int h = 0; h < NPER; h += NB) {
        f32x4 v[NB]; size_t di[NB];
#pragma unroll
        for (int k = 0; k < NB; ++k) { const unsigned i = unit * 4096u + (unsigned)(h + k) * (unsigned)NT + (unsigned)t, b = i / PER, r = i - b * PER; di[k] = (size_t)b * BP + r; v[k] = __builtin_nontemporal_load(s + di[k] + SKIP); }
#pragma unroll
        for (int k = 0; k < NB; ++k) __builtin_nontemporal_store(v[k], d + di[k]);
    }
}
template <int NT, int NB>
__device__ __forceinline__ void copy_unit_any(const Args& A, unsigned c, int t) {
    if (c < U_A) copy_unit<NA_HIST * 32, NST * 32, NT, NB>(A.in[2], A.out + O_AKS, c, t);
    else if (c < 2 * U_A) copy_unit<NA_HIST * 32, NST * 32, NT, NB>(A.in[3], A.out + O_AVS, c - U_A, t);
    else if (c < 2 * U_A + U_C) copy_unit<15 * 128, NST * 128, NT, NB>(A.in[5], A.out + O_CPS, c - 2 * U_A, t);
    else if (c < 2 * U_A + U_C + U_DB) copy_dblock_unit<NT, NB>(A.in[6], A.out + O_DKS, c - (2 * U_A + U_C), t);
    else copy_dblock_unit<NT, NB>(A.in[7], A.out + O_DVS, c - (2 * U_A + U_C + U_DB), t);
}
__device__ __forceinline__ void steal_copy(const Frame& F, const Args& A, int phase, bool until_empty) {
    volatile LAS unsigned* slot = (volatile LAS unsigned*)(F.lds + MISC_OFF) + 12;
    gu32* head = F.ctl + CW_COPY_HEAD; gu32* done = F.ctl + CW_DONE0 + 64 * phase;
    if (F.tid == 0 && !until_empty) __hip_atomic_fetch_add(done, 1u, RLX_AGENT);
    for (;;) {
        if (F.tid == 0) {
            unsigned c = NUNIT;
            if (until_empty || __hip_atomic_load(done, RLX_AGENT) < (unsigned)F.G) c = __hip_atomic_fetch_add(head, 4u, RLX_AGENT);
            *slot = c;
        }
        __syncthreads();
        const unsigned c = *slot;
        __syncthreads();
        if (c >= NUNIT) break;
#pragma unroll 1
        for (unsigned u = c; u < c + 4 && u < NUNIT; ++u) copy_unit_any<512, 8>(A, u, F.tid);
    }
}
__device__ __forceinline__ void stagger_copy(const Frame& F, const Args& A, int nclaim) {
    volatile LAS unsigned* slot = (volatile LAS unsigned*)(F.lds + MISC_OFF) + 12;
    gu32* head = F.ctl + CW_COPY_HEAD;
#pragma unroll 1
    for (int i = 0; i < nclaim; ++i) {
        if (F.tid == 0) *slot = __hip_atomic_fetch_add(head, 4u, RLX_AGENT);
        __syncthreads();
        const unsigned c = *slot;
        __syncthreads();
        if (c >= NUNIT) break;
#pragma unroll 1
        for (unsigned u = c; u < c + 4 && u < NUNIT; ++u) copy_unit_any<512, 8>(A, u, F.tid);
    }
}
__device__ __forceinline__ void wave_copy(const Frame& F, const Args& A, volatile LAS unsigned* fin) {
    gu32* head = F.ctl + CW_COPY_HEAD;
    for (;;) {
        if (*fin >= 7u) break;
        unsigned c = 0; if (F.lane == 0) c = __hip_atomic_fetch_add(head, 1u, RLX_AGENT);
        c = __builtin_amdgcn_readfirstlane(c);
        if (c >= NUNIT) break;
        copy_unit_any<64, 32>(A, c, F.lane);
    }
}
__device__ __forceinline__ void wave_fin(const Frame& F, volatile LAS unsigned* fin) { if (F.lane == 0) __hip_atomic_fetch_add((LAS unsigned*)fin, 1u, __ATOMIC_RELAXED, __HIP_MEMORY_SCOPE_WORKGROUP); }

__device__ __forceinline__ void p0_prologue(const Frame& F, const Args& A) {
    unsigned char* ws = A.ws;
    LAS float* scr = (LAS float*)(F.lds + F.wave * 16384);
    float* vec = (float*)(ws + WS_VEC);
    const int lane = F.lane;
    constexpr int T_IN0 = 16 * 72, T_OUT0 = 16 * 32, T_W1 = 16 * 128, T_W2 = 64 * 32, T_IN1 = 16 * 64, T_OUT1 = 8 * 32;
    constexpr int NT = T_IN0 + T_OUT0 + 2 * T_W1 + 2 * T_W2 + T_IN1 + T_OUT1;
    for (int it = F.gw; it < NT; it += F.NGW) {
        int r = it;
        if (r < T_IN0) { const int kb = r / 72, nb = r % 72; transpose_tile(A.in[8], N_IN0, in0_src_col(32 * nb), 64 * kb, nullptr, (bf16_t*)(ws + WS_WIN0), DM, 32 * nb, 0, scr, lane); continue; } r -= T_IN0;
        if (r < T_OUT0) { const int kb = r / 32, nb = r % 32; transpose_tile(A.in[12], DM, 32 * nb, 64 * kb, nullptr, (bf16_t*)(ws + WS_WOUT0), DM, 32 * nb, 0, scr, lane); continue; } r -= T_OUT0;
        if (r < 2 * T_W1) { const int L = r / T_W1; r %= T_W1; const int kb = r / 128, nb = r % 128;
            transpose_tile(A.in[20] + (size_t)L * DM * FF, FF, 32 * nb, 64 * kb, A.in[22] + L * DM, (bf16_t*)(ws + (L ? WS_W1_1 : WS_W1_0)), DM, 32 * nb, 0, scr, lane); continue; } r -= 2 * T_W1;
        if (r < 2 * T_W2) { const int L = r / T_W2; r %= T_W2; const int kb = r / 32, nb = r % 32;
            transpose_tile(A.in[21] + (size_t)L * FF * DM, DM, 32 * nb, 64 * kb, nullptr, (bf16_t*)(ws + (L ? WS_W2_1 : WS_W2_0)), FF, 32 * nb, 0, scr, lane); continue; } r -= 2 * T_W2;
        if (r < T_IN1) { const int kb = r / 64, nb = r % 64; transpose_tile(A.in[14], N_IN1, 32 * nb, 64 * kb, A.in[24], (bf16_t*)(ws + WS_WIN1), DM, 32 * nb, 0, scr, lane); continue; } r -= T_IN1;
        { const int kb = r / 32, nb = r % 32; transpose_tile(A.in[18] + (size_t)512 * DM, DM, 32 * nb, 64 * kb, nullptr, (bf16_t*)(ws + WS_WOUT1), DM, 32 * nb, 512, scr, lane); }
    }
    if (F.NGW >= 2048) { const int pf = F.gw - 1024; if (pf >= 0 && pf < 1024) poolfold_item(A.in[16], A.in[17], A.in[18], (bf16_t*)(ws + WS_WOUT1), pf, lane); }
    else for (int it = F.gw; it < 1024; it += F.NGW) poolfold_item(A.in[16], A.in[17], A.in[18], (bf16_t*)(ws + WS_WOUT1), it, lane);
    for (int it = F.gw; it < 640; it += F.NGW) {
        if (it < 256) colsum_item(A.in[20], DM, FF, A.in[22], A.in[23], nullptr, vec + V_CS1_0, vec + V_BW1_0, it, lane);
        else if (it < 512) colsum_item(A.in[20] + (size_t)DM * FF, DM, FF, A.in[22] + DM, A.in[23] + DM, nullptr, vec + V_CS1_1, vec + V_BW1_1, it - 256, lane);
        else colsum_item(A.in[14], DM, N_IN1, A.in[24], A.in[25], A.in[15], vec + V_CSIN1, vec + V_BWIN1, it - 512, lane);
    }
    for (int i = F.gw * 64 + lane; i < N_IN0; i += F.NGW * 64) vec[V_BIN0 + i] = A.in[9][in0_src_col(i)];
    for (int m0 = F.gw * 4; m0 < M; m0 += F.NGW * 4) {
        const float* xr = m0 < MP ? A.in[0] + (size_t)m0 * DM : A.in[1] + (size_t)(m0 - MP) * DM;
        const GAS f32x4* x4 = (const GAS f32x4*)xr + lane; GAS u32x2v* o = (GAS u32x2v*)((bf16_t*)(ws + WS_XB) + (size_t)m0 * DM) + lane;
        f32x4 v[16];
#pragma unroll
        for (int j = 0; j < 16; ++j) v[j] = x4[64 * j];
#pragma unroll
        for (int j = 0; j < 16; ++j) { u32x2v w; w.x = pk2(v[j][0], v[j][1]); w.y = pk2(v[j][2], v[j][3]); o[64 * j] = w; }
    }
}
__device__ __forceinline__ float alibi_slope(int h) { return __builtin_amdgcn_exp2f(-(float)(h + 1)); }
typedef float f32x16 __attribute__((ext_vector_type(16)));
typedef short s16x4 __attribute__((ext_vector_type(4)));
typedef short v4i16_t __attribute__((ext_vector_type(4)));
using pg8::bf16x8;
constexpr int VROW = 192;
constexpr int VIMG = 32 * VROW;
constexpr int ST_ROW = 136, ST_M_OFF = 512 * ST_ROW, ST_L_OFF = ST_M_OFF + 2048, ST_BYTES = ST_L_OFF + 2048;
__device__ __forceinline__ s16x4 vtr(LAS const unsigned char* p) { return __builtin_bit_cast(s16x4, __builtin_amdgcn_ds_read_tr16_b64_v4i16((LAS v4i16_t*)p)); }
__device__ __forceinline__ unsigned cvtpk(float lo, float hi) { return pg8::cvt_pk_bf16(lo, hi); }
#define DPP_ADD(v, CTRL) ((v) + __builtin_bit_cast(float, __builtin_amdgcn_update_dpp(0, __builtin_bit_cast(int, (v)), (CTRL), 0xf, 0xf, true)))
__device__ __forceinline__ float row16_sum(float d) {
    d = DPP_ADD(d, 0xB1);
    d = DPP_ADD(d, 0x4E);
    d = DPP_ADD(d, 0x141);
    d = DPP_ADD(d, 0x140);
    return d;
}
__device__ __forceinline__ float xhalf_max(float v) { float a = v, b = v; swap32(a, b); return fmaxf(a, b); }
__device__ __forceinline__ float xhalf_sum(float v) { float a = v, b = v; swap32(a, b); return a + b; }

struct AttnCfg {
    const bf16_t *Q, *K, *V; int qpitch, kvpitch;
    long rowbase;
    int i0, dl; float sl2;
    LAS unsigned char* st; int tl0;
    bf16_t* out; int opitch; float sink2;
};
__device__ __forceinline__ void attn_preload_q(const AttnCfg& c, int lane, bf16x8 (&QF)[4]) {
    const int qi = lane & 31, hh = lane >> 5;
    const long qrow = c.rowbase + (long)c.dl * (c.i0 + qi);
#pragma unroll
    for (int kk = 0; kk < 4; ++kk) QF[kk] = *(const bf16x8*)(c.Q + qrow * c.qpitch + 16 * kk + 8 * hh);
}
__device__ __forceinline__ void attn_preload_kv(const AttnCfg& c, int lane, bf16x8 (&KF)[4], u32x4 (&VV)[4]) {
    const int qi = lane & 31, hh = lane >> 5;
    const long qrow = c.rowbase + (long)c.dl * (c.i0 + qi);
    const char* kp = (const char*)(c.K + qrow * c.kvpitch + 8 * hh);
    const char* vp = (const char*)(c.V + (c.rowbase + (long)c.dl * (c.i0 + (lane >> 3))) * c.kvpitch + 8 * (lane & 7));
    const long vrow8 = (long)16 * c.dl * c.kvpitch;
#pragma unroll
    for (int kk = 0; kk < 4; ++kk) KF[kk] = *(const bf16x8*)(kp + 32 * kk);
#pragma unroll
    for (int i = 0; i < 4; ++i) VV[i] = *(const u32x4*)(vp + (long)i * vrow8);
}
template <bool LOADST, bool FINAL, bool SINK>
__device__ __forceinline__ void attn_item(const AttnCfg& c, LAS unsigned char* vimg, int lane_in, bf16x8 (&qf)[4], bf16x8 (&kf)[4], u32x4 (&vv)[4], bool have_next, const AttnCfg& cn) {
    int lane = lane_in; asm volatile("" : "+v"(lane));
    const int qi = lane & 31, hh = lane >> 5;
    const long qrow = c.rowbase + (long)c.dl * (c.i0 + qi);
    float m, l; f32x16 o[2];
    if (LOADST) {
        const int tl = c.dl * (c.i0 + qi) + c.tl0, rho = tl ^ ((tl >> 5) & 15);
        LAS const unsigned char* sp = c.st + rho * ST_ROW + 8 * hh;
        m = *(LAS const float*)(c.st + ST_M_OFF + 4 * rho); l = *(LAS const float*)(c.st + ST_L_OFF + 4 * rho); l = hh == 0 ? l : 0.f;
#pragma unroll
        for (int cb = 0; cb < 2; ++cb)
#pragma unroll
            for (int g = 0; g < 4; ++g) { const u32x2v w = *(LAS const u32x2v*)(sp + 64 * cb + 16 * g); o[cb][4 * g] = bflo(w.x); o[cb][4 * g + 1] = bfhi(w.x); o[cb][4 * g + 2] = bflo(w.y); o[cb][4 * g + 3] = bfhi(w.y); }
    } else {
        m = -INFINITY; l = 0.f;
#pragma unroll
        for (int r = 0; r < 16; ++r) { o[0][r] = 0.f; o[1][r] = 0.f; }
    }
    const int blk = (lane >> 4) & 1, tq = (lane & 15) >> 2, tp = lane & 3;
    LAS const unsigned char* vrd = vimg + (4 * hh + tq) * VROW + (16 * blk + 4 * tp) * 2;
    LAS unsigned char* vwr = vimg + (lane >> 3) * VROW + (lane & 7) * 16;
    const float e3 = 3.0f * c.sl2, e8 = 8.0f * c.sl2;
    const int ktmin = c.i0 >= 97 ? 0 : (128 - c.i0) / 32;
    const bool edge = c.i0 < 128;
    const char* kbase = (const char*)(c.K + (c.rowbase + (long)c.dl * (c.i0 + qi)) * c.kvpitch + 8 * hh);
    const char* vbase = (const char*)(c.V + (c.rowbase + (long)c.dl * (c.i0 + (lane >> 3))) * c.kvpitch + 8 * (lane & 7));
    const long tstep = (long)64 * c.dl * c.kvpitch, vrow8 = (long)16 * c.dl * c.kvpitch;
#define ATT_LOAD(KT, KF, VV) do { if (!edge) { const char* kp_ = kbase - (long)(4 - (KT)) * tstep; const char* vp_ = vbase - (long)(4 - (KT)) * tstep; \
        _Pragma("unroll") for (int kk = 0; kk < 4; ++kk) KF[kk] = *(const bf16x8*)(kp_ + 32 * kk); \
        _Pragma("unroll") for (int i = 0; i < 4; ++i) VV[i] = *(const u32x4*)(vp_ + (long)i * vrow8); \
      } else { const int pk0_ = c.i0 - 128 + 32 * (KT); const int pk_ = pk0_ + qi; const long krow_ = c.rowbase + (long)c.dl * (pk_ < 0 ? 0 : pk_); \
        _Pragma("unroll") for (int kk = 0; kk < 4; ++kk) KF[kk] = *(const bf16x8*)(c.K + krow_ * c.kvpitch + 16 * kk + 8 * hh); \
        _Pragma("unroll") for (int i = 0; i < 4; ++i) { const int pv_ = pk0_ + (lane >> 3) + 8 * i; const long vrow_ = c.rowbase + (long)c.dl * (pv_ < 0 ? 0 : pv_); \
            VV[i] = *(const u32x4*)(c.V + vrow_ * c.kvpitch + 8 * (lane & 7)); } } } while (0)
    for (int kt = 4; kt >= ktmin; --kt) {
        const int pk0 = c.i0 - 128 + 32 * kt;
        bf16x8 kn[4]; u32x4 vn[4];
#pragma unroll
        for (int kk = 0; kk < 4; ++kk) { kn[kk] = kf[kk]; vn[kk] = vv[kk]; }
        if (kt > ktmin) ATT_LOAD(kt - 1, kn, vn);
        else if (have_next) attn_preload_kv(cn, lane, kn, vn);
        {
          const int dq = qi + 128 - 32 * kt;
          float bg = c.sl2 * (float)(4 * hh - dq);
          f32x16 s;
#pragma unroll
          for (int g = 0; g < 4; ++g) { s[4 * g] = bg; s[4 * g + 1] = bg + c.sl2; s[4 * g + 2] = __builtin_fmaf(c.sl2, 2.0f, bg); s[4 * g + 3] = bg + e3; bg += e8; }
          __builtin_amdgcn_s_setprio(1);
#pragma unroll
          for (int kk = 0; kk < 4; ++kk) s = __builtin_amdgcn_mfma_f32_32x32x16_bf16(kf[kk], qf[kk], s, 0, 0, 0);
          __builtin_amdgcn_s_setprio(0);
          asm volatile("" ::: "memory");
          if (kt == ktmin && have_next) attn_preload_q(cn, lane, qf);
#pragma unroll
          for (int i = 0; i < 4; ++i) *(LAS u32x4*)(vwr + 8 * i * VROW) = vv[i];
          if (kt == 4 || kt == 0 || pk0 < 0) {
#pragma unroll
              for (int r = 0; r < 16; ++r) { const int ko = (r & 3) + 8 * (r >> 2) + 4 * hh, dist = dq - ko;
                  const bool ok = (dist >= 0) & (dist <= 128) & (pk0 + ko >= 0);
                  s[r] = ok ? s[r] : -INFINITY; }
          }
          float tmax = fmaxf(fmaxf(s[0], s[1]), fmaxf(s[2], s[3]));
#pragma unroll
          for (int r = 4; r < 16; r += 4) tmax = fmaxf(tmax, fmaxf(fmaxf(s[r], s[r + 1]), fmaxf(s[r + 2], s[r + 3])));
          tmax = xhalf_max(tmax);
          const float mnew = fmaxf(m, tmax), scl = __builtin_amdgcn_exp2f(m - mnew);
          m = mnew; l *= scl;
#pragma unroll
          for (int r = 0; r < 16; ++r) { o[0][r] *= scl; o[1][r] *= scl; }
          float ps = 0.f;
#pragma unroll
          for (int r = 0; r < 16; ++r) { s[r] = __builtin_amdgcn_exp2f(s[r] - mnew); ps += s[r]; }
          l += ps;
          u32x4 pw0, pw1;
          pw0.x = cvtpk(s[0], s[1]); pw0.y = cvtpk(s[2], s[3]); pw0.z = cvtpk(s[4], s[5]); pw0.w = cvtpk(s[6], s[7]);
          pw1.x = cvtpk(s[8], s[9]); pw1.y = cvtpk(s[10], s[11]); pw1.z = cvtpk(s[12], s[13]); pw1.w = cvtpk(s[14], s[15]);
          const bf16x8 pf0 = __builtin_bit_cast(bf16x8, pw0), pf1 = __builtin_bit_cast(bf16x8, pw1);
          asm volatile("s_waitcnt lgkmcnt(0)" ::: "memory");
#pragma unroll
          for (int cb = 0; cb < 2; ++cb) {
              const s16x4 a0 = vtr(vrd + (0) * VROW + cb * 64), a1 = vtr(vrd + (8) * VROW + cb * 64), b0 = vtr(vrd + (16) * VROW + cb * 64), b1 = vtr(vrd + (24) * VROW + cb * 64);
              const bf16x8 vf0 = (bf16x8){a0[0], a0[1], a0[2], a0[3], a1[0], a1[1], a1[2], a1[3]}, vf1 = (bf16x8){b0[0], b0[1], b0[2], b0[3], b1[0], b1[1], b1[2], b1[3]};
              __builtin_amdgcn_s_setprio(1);
              o[cb] = __builtin_amdgcn_mfma_f32_32x32x16_bf16(vf0, pf0, o[cb], 0, 0, 0);
              o[cb] = __builtin_amdgcn_mfma_f32_32x32x16_bf16(vf1, pf1, o[cb], 0, 0, 0);
              __builtin_amdgcn_s_setprio(0);
          }
          asm volatile("s_waitcnt lgkmcnt(0)" ::: "memory");
        }
#pragma unroll
        for (int kk = 0; kk < 4; ++kk) { kf[kk] = kn[kk]; vv[kk] = vn[kk]; }
    }
#undef ATT_LOAD
    float lt = xhalf_sum(l);
    if (FINAL) {
        if (SINK) lt += __builtin_amdgcn_exp2f(c.sink2 - m);
        const float inv = 1.0f / lt;
        bf16_t* op = c.out + qrow * c.opitch;
#pragma unroll
        for (int cb = 0; cb < 2; ++cb)
#pragma unroll
            for (int gp = 0; gp < 4; gp += 2) {
                unsigned ax = cvtpk(o[cb][4 * gp] * inv, o[cb][4 * gp + 1] * inv), ay = cvtpk(o[cb][4 * gp + 2] * inv, o[cb][4 * gp + 3] * inv);
                unsigned bx = cvtpk(o[cb][4 * gp + 4] * inv, o[cb][4 * gp + 5] * inv), by = cvtpk(o[cb][4 * gp + 6] * inv, o[cb][4 * gp + 7] * inv);
                swap32(ax, bx); swap32(ay, by);
                *(u32x4*)(op + 32 * cb + 8 * (gp + hh)) = (u32x4){ax, ay, bx, by}; }
    } else {
        const int tl = c.dl * (c.i0 + qi) + c.tl0, rho = tl ^ ((tl >> 5) & 15);
        LAS unsigned char* sp = c.st + rho * ST_ROW + 8 * hh;
#pragma unroll
        for (int cb = 0; cb < 2; ++cb)
#pragma unroll
            for (int g = 0; g < 4; ++g) { u32x2v w; w.x = cvtpk(o[cb][4 * g], o[cb][4 * g + 1]); w.y = cvtpk(o[cb][4 * g + 2], o[cb][4 * g + 3]); *(LAS u32x2v*)(sp + 64 * cb + 16 * g) = w; }
        if (hh == 0) { *(LAS float*)(c.st + ST_M_OFF + 4 * rho) = m; *(LAS float*)(c.st + ST_L_OFF + 4 * rho) = lt; }
    }
}

struct SAttnCfg {
    const bf16_t* q;
    const float *kc, *vc; int cpitch;
    const bf16_t *kn, *vn; int npitch;
    int nh, i, dl; float sl2;
};
template <bool SINK>
__device__ __forceinline__ void sattn_item(const SAttnCfg& c, float sink2, bf16_t* out, float& m_io, float& l_io, f32x4& o_io, bool first, bool last, int lane_in) {
    int lane = lane_in; asm volatile("" : "+v"(lane));
    int qd = lane >> 4; const int sub = lane & 15;
    asm volatile("" : "+v"(qd));
    f32x4 qv; { const u32x2v w = *(const u32x2v*)(c.q + 4 * sub); qv = (f32x4){bflo(w.x), bfhi(w.x), bflo(w.y), bfhi(w.y)}; }
#define SA_ROW(IT, CACHE, NEW, DST) do { const int j_ = 4 * (IT) + qd, row_ = c.nh + c.i - j_ * c.dl; const int rc_ = row_ < 0 ? 0 : (row_ >= c.nh ? c.nh - 1 : row_); \
        DST = *(const f32x4*)((CACHE) + (size_t)rc_ * c.cpitch + 4 * sub); \
        if ((IT) < 3) { const int rn_ = row_ - c.nh; const u32x2v w_ = *(const u32x2v*)((NEW) + (size_t)(rn_ < 0 ? 0 : rn_) * c.npitch + 4 * sub); \
            if (rn_ >= 0) DST = (f32x4){bflo(w_.x), bfhi(w_.x), bflo(w_.y), bfhi(w_.y)}; } } while (0)
    float sc[33];
    {
        f32x4 kv[33];
#pragma unroll
        for (int it = 0; it < 33; ++it) SA_ROW(it, c.kc, c.kn, kv[it]);
#pragma unroll
        for (int it = 0; it < 33; ++it) {
            const int j = 4 * it + qd;
            float d = (qv[0] * kv[it][0] + qv[1] * kv[it][1]) + (qv[2] * kv[it][2] + qv[3] * kv[it][3]);
            d = row16_sum(d);
            sc[it] = j <= 128 ? d - c.sl2 * (float)j : -INFINITY;
        }
    }
    float tm = sc[0];
#pragma unroll
    for (int it = 1; it < 33; ++it) tm = fmaxf(tm, sc[it]);
    tm = fmaxf(tm, __shfl_xor(tm, 16)); tm = fmaxf(tm, __shfl_xor(tm, 32));
    float m = first ? tm : fmaxf(m_io, tm);
    const float scl = first ? 0.f : __builtin_amdgcn_exp2f(m_io - m);
    float l = first ? 0.f : l_io * scl; f32x4 o = first ? (f32x4){0.f, 0.f, 0.f, 0.f} : o_io * scl;
    float ps = 0.f; f32x4 oa = (f32x4){0.f, 0.f, 0.f, 0.f};
    {
        f32x4 vv[33];
#pragma unroll
        for (int it = 0; it < 33; ++it) SA_ROW(it, c.vc, c.vn, vv[it]);
#pragma unroll
        for (int it = 0; it < 33; ++it) { const float p = __builtin_amdgcn_exp2f(sc[it] - m); ps += p; oa += vv[it] * p; }
    }
#undef SA_ROW
    ps += __shfl_xor(ps, 16); ps += __shfl_xor(ps, 32);
#pragma unroll
    for (int e = 0; e < 4; ++e) { float t = oa[e]; t += __shfl_xor(t, 16); t += __shfl_xor(t, 32); oa[e] = t; }
    l += ps; o += oa;
    if (last) {
        if (SINK) l += __builtin_amdgcn_exp2f(sink2 - m);
        const float inv = 1.0f / l;
        if (qd == 0) { u32x2v w; w.x = cvtpk(o[0] * inv, o[1] * inv); w.y = cvtpk(o[2] * inv, o[3] * inv); *(u32x2v*)(out + 4 * sub) = w; }
    }
    m_io = m; l_io = l; o_io = o;
}

__device__ __forceinline__ bf16x8 cvt8(const f32x4 a, const f32x4 b) { u32x4 w; w.x = cvtpk(a[0], a[1]); w.y = cvtpk(a[2], a[3]); w.z = cvtpk(b[0], b[1]); w.w = cvtpk(b[2], b[3]); return __builtin_bit_cast(bf16x8, w); }
__device__ __forceinline__ void sattn_a_item(const bf16_t* Q, const float* kc, const float* vc, const bf16_t* KN, const bf16_t* VN, const float* sinks, bf16_t* MIX, int b, int kvh, LAS unsigned char* vimg, int lane_in) {
    int lane = lane_in; asm volatile("" : "+v"(lane));
    const int qi = lane & 31, hh = lane >> 5, g = qi >> 3, i = qi & 7, h = kvh * 4 + g;
    const long row0 = MP + (long)b * NST;
    bf16x8 qf[4];
#pragma unroll
    for (int kk = 0; kk < 4; ++kk) qf[kk] = *(const bf16x8*)(Q + (row0 + i) * 512 + h * 64 + 16 * kk + 8 * hh);
    const float sl2 = alibi_slope(h) * LOG2E, sink2 = sinks[h] * LOG2E;
    float cko[16];
#pragma unroll
    for (int r = 0; r < 16; ++r) cko[r] = sl2 * (float)((r & 3) + 8 * (r >> 2) + 4 * hh);
    float m = -INFINITY, l = 0.f; f32x16 o[2];
#pragma unroll
    for (int r = 0; r < 16; ++r) { o[0][r] = 0.f; o[1][r] = 0.f; }
    const int blk = (lane >> 4) & 1, tq = (lane & 15) >> 2, tp = lane & 3;
    LAS const unsigned char* vrd = vimg + (4 * hh + tq) * VROW + (16 * blk + 4 * tp) * 2;
    LAS unsigned char* vwr = vimg + (lane >> 3) * VROW + (lane & 7) * 16;
    const float* kcb = kc + (size_t)b * NA_HIST * 128 + kvh * 64; const float* vcb = vc + (size_t)b * NA_HIST * 128 + kvh * 64;
#pragma unroll 1
    for (int kt = 4; kt >= 0; --kt) {
        bf16x8 kf[4]; u32x4 vv[4];
        if (kt == 4) {
            const int ko = lane & 31;
#pragma unroll
            for (int kk = 0; kk < 4; ++kk) kf[kk] = *(const bf16x8*)(KN + (row0 + (ko < 8 ? ko : 0)) * 128 + kvh * 64 + 16 * kk + 8 * hh);
#pragma unroll
            for (int q4 = 0; q4 < 4; ++q4) { const int vr = (lane >> 3) + 8 * q4; vv[q4] = *(const u32x4*)(VN + (row0 + (vr < 8 ? vr : 0)) * 128 + kvh * 64 + 8 * (lane & 7)); }
        } else {
            const int r = 32 * kt + (lane & 31);
#pragma unroll
            for (int kk = 0; kk < 4; ++kk) { const float* p = kcb + (size_t)r * 128 + 16 * kk + 8 * hh; kf[kk] = cvt8(*(const f32x4*)p, *(const f32x4*)(p + 4)); }
#pragma unroll
            for (int q4 = 0; q4 < 4; ++q4) { const int vr = 32 * kt + (lane >> 3) + 8 * q4; const float* p = vcb + (size_t)vr * 128 + 8 * (lane & 7); vv[q4] = __builtin_bit_cast(u32x4, cvt8(*(const f32x4*)p, *(const f32x4*)(p + 4))); }
        }
        const float base = -sl2 * (float)(128 + i - 32 * kt);
        f32x16 s;
#pragma unroll
        for (int r = 0; r < 16; ++r) s[r] = base + cko[r];
#pragma unroll
        for (int kk = 0; kk < 4; ++kk) s = __builtin_amdgcn_mfma_f32_32x32x16_bf16(kf[kk], qf[kk], s, 0, 0, 0);
        asm volatile("" ::: "memory");
#pragma unroll
        for (int q4 = 0; q4 < 4; ++q4) *(LAS u32x4*)(vwr + 8 * q4 * VROW) = vv[q4];
        if (kt == 4 || kt == 0) {
#pragma unroll
            for (int r = 0; r < 16; ++r) { const int ko = (r & 3) + 8 * (r >> 2) + 4 * hh; const bool ok = kt == 4 ? (ko <= i) : (ko >= i); s[r] = ok ? s[r] : -INFINITY; }
        }
        float tmax = fmaxf(fmaxf(s[0], s[1]), fmaxf(s[2], s[3]));
#pragma unroll
        for (int r = 4; r < 16; r += 4) tmax = fmaxf(tmax, fmaxf(fmaxf(s[r], s[r + 1]), fmaxf(s[r + 2], s[r + 3])));
        tmax = xhalf_max(tmax);
        const float mnew = fmaxf(m, tmax), scl = __builtin_amdgcn_exp2f(m - mnew);
        m = mnew; l *= scl;
#pragma unroll
        for (int r = 0; r < 16; ++r) { o[0][r] *= scl; o[1][r] *= scl; }
        float ps = 0.f;
#pragma unroll
        for (int r = 0; r < 16; ++r) { s[r] = __builtin_amdgcn_exp2f(s[r] - mnew); ps += s[r]; }
        l += ps;
        u32x4 pw0, pw1;
        pw0.x = cvtpk(s[0], s[1]); pw0.y = cvtpk(s[2], s[3]); pw0.z = cvtpk(s[4], s[5]); pw0.w = cvtpk(s[6], s[7]);
        pw1.x = cvtpk(s[8], s[9]); pw1.y = cvtpk(s[10], s[11]); pw1.z = cvtpk(s[12], s[13]); pw1.w = cvtpk(s[14], s[15]);
        const bf16x8 pf0 = __builtin_bit_cast(bf16x8, pw0), pf1 = __builtin_bit_cast(bf16x8, pw1);
        asm volatile("s_waitcnt lgkmcnt(0)" ::: "memory");
#pragma unroll
        for (int cb = 0; cb < 2; ++cb) {
            const s16x4 a0 = vtr(vrd + (0) * VROW + cb * 64), a1 = vtr(vrd + (8) * VROW + cb * 64), b0 = vtr(vrd + (16) * VROW + cb * 64), b1 = vtr(vrd + (24) * VROW + cb * 64);
            const bf16x8 vf0 = (bf16x8){a0[0], a0[1], a0[2], a0[3], a1[0], a1[1], a1[2], a1[3]}, vf1 = (bf16x8){b0[0], b0[1], b0[2], b0[3], b1[0], b1[1], b1[2], b1[3]};
            o[cb] = __builtin_amdgcn_mfma_f32_32x32x16_bf16(vf0, pf0, o[cb], 0, 0, 0);
            o[cb] = __builtin_amdgcn_mfma_f32_32x32x16_bf16(vf1, pf1, o[cb], 0, 0, 0);
        }
        asm volatile("s_waitcnt lgkmcnt(0)" ::: "memory");
    }
    float lt = xhalf_sum(l) + __builtin_amdgcn_exp2f(sink2 - m);
    const float inv = 1.0f / lt;
    bf16_t* op = MIX + (row0 + i) * DM + h * 64;
#pragma unroll
    for (int cb = 0; cb < 2; ++cb)
#pragma unroll
        for (int gq = 0; gq < 4; ++gq) { u32x2v w; w.x = cvtpk(o[cb][4 * gq] * inv, o[cb][4 * gq + 1] * inv); w.y = cvtpk(o[cb][4 * gq + 2] * inv, o[cb][4 * gq + 3] * inv);
            *(u32x2v*)(op + 32 * cb + 8 * gq + 4 * hh) = w; }
}
constexpr int FD_LDS = 3 * 8 * 132 * 4;
__device__ __forceinline__ f32x4 ldq4(const bf16_t* p) { const u32x2v w = *(const u32x2v*)p; return (f32x4){bflo(w.x), bfhi(w.x), bflo(w.y), bfhi(w.y)}; }
__device__ __forceinline__ float dot4(const f32x4 a, const f32x4 b) { return (a[0] * b[0] + a[1] * b[1]) + (a[2] * b[2] + a[3] * b[3]); }
template <bool VPASS>
__device__ __forceinline__ void fd_stream(const float* cc, float* co, const f32x4 qa, const f32x4 qb, f32x4& oa, f32x4& ob, LAS float* Sc, float sl4, float sl16, int qd, int sub) {
#pragma unroll 1
    for (int s0 = 0; s0 < 192; s0 += 16) {
        f32x4 rv[16];
#pragma unroll
        for (int u = 0; u < 16; ++u) { const int it = 4 * ((s0 + u) >> 1) + (u & 1); rv[u] = __builtin_nontemporal_load((const f32x4*)(cc + (size_t)(4 * it + qd) * 512 + 4 * sub)); }
#pragma unroll
        for (int u = 0; u < 16; ++u) {
            const int it = 4 * ((s0 + u) >> 1) + (u & 1), pos = 4 * it + qd, j16 = 128 - (it >> 2);
            if (s0 > 0 || u >= 2) __builtin_nontemporal_store(rv[u], (f32x4*)(co + (size_t)(pos - 8) * 512 + 4 * sub));
            if (!VPASS) {
                const float d = row16_sum(dot4((u & 1) ? qb : qa, rv[u]));
                if (sub == 0) Sc[(16 + qd + 4 * (u & 1)) * 132 + j16] = d - sl16 * (float)j16;
            } else {
                if (u & 1) ob += rv[u] * Sc[(16 + qd + 4) * 132 + j16]; else oa += rv[u] * Sc[(16 + qd) * 132 + j16];
            }
        }
    }
#pragma unroll 1
    for (int it0 = 384; it0 < 512; it0 += 16) {
        f32x4 rv[16];
#pragma unroll
        for (int u = 0; u < 16; ++u) rv[u] = __builtin_nontemporal_load((const f32x4*)(cc + (size_t)(4 * (it0 + u) + qd) * 512 + 4 * sub));
#pragma unroll
        for (int u = 0; u < 16; ++u) {
            const int it = it0 + u, pos = 4 * it + qd;
            __builtin_nontemporal_store(rv[u], (f32x4*)(co + (size_t)(pos - 8) * 512 + 4 * sub));
            const int ph = u & 3, j16 = 128 - (it >> 2), j1 = 512 - it, j2 = 513 - it;
            if (!VPASS) {
                const float da = row16_sum(dot4(qa, rv[u])), db = row16_sum(dot4(qb, rv[u]));
                if (sub == 0) {
                    if (ph == 0) Sc[(16 + qd) * 132 + j16] = da - sl16 * (float)j16;
                    if (ph == 1) Sc[(16 + qd + 4) * 132 + j16] = db - sl16 * (float)j16;
                    Sc[(8 + qd) * 132 + j1] = da - sl4 * (float)j1; if (j2 <= 128) Sc[(8 + qd + 4) * 132 + j2] = db - sl4 * (float)j2;
                }
            } else {
                if (ph == 0) oa += rv[u] * Sc[(16 + qd) * 132 + j16];
                if (ph == 1) ob += rv[u] * Sc[(16 + qd + 4) * 132 + j16];
                oa += rv[u] * Sc[(8 + qd) * 132 + j1]; if (j2 <= 128) ob += rv[u] * Sc[(8 + qd + 4) * 132 + j2];
            }
        }
    }
}
__device__ __forceinline__ void fused_d_item(const Args& A, int b, int h, LAS float* Sc, int lane_in) {
    int lane = lane_in; asm volatile("" : "+v"(lane));
    const int qd = lane >> 4, sub = lane & 15;
    unsigned char* ws = A.ws;
    const bf16_t* Q = (const bf16_t*)(ws + WS_Q); const bf16_t* KN = (const bf16_t*)(ws + WS_K); const bf16_t* VN = (const bf16_t*)(ws + WS_V); bf16_t* MIX = (bf16_t*)(ws + WS_MIX);
    const long row0 = MP + (long)b * NST;
    const float* kc = A.in[6] + (size_t)b * ND_HIST * 512 + h * 64; const float* vc = A.in[7] + (size_t)b * ND_HIST * 512 + h * 64;
    float* ko = A.out + O_DKS + (size_t)b * ND_HIST * 512 + h * 64; float* vo = A.out + O_DVS + (size_t)b * ND_HIST * 512 + h * 64;
    const float slope = alibi_slope(h) * LOG2E, sl1 = slope, sl4 = 4.f * slope, sl16 = 16.f * slope;
    for (int e = lane; e < 3 * 8 * 132; e += 64) Sc[e] = -INFINITY;
    f32x4 q[8];
#pragma unroll
    for (int i = 0; i < 8; ++i) q[i] = ldq4(Q + (row0 + i) * 512 + h * 64 + 4 * sub);
    const f32x4 qa = qd == 0 ? q[0] : qd == 1 ? q[1] : qd == 2 ? q[2] : q[3], qb = qd == 0 ? q[4] : qd == 1 ? q[5] : qd == 2 ? q[6] : q[7];
    asm volatile("s_waitcnt lgkmcnt(0)" ::: "memory");
    f32x4 oa = (f32x4){0.f, 0.f, 0.f, 0.f}, ob = oa;
    fd_stream<false>(kc, ko, qa, qb, oa, ob, Sc, sl4, sl16, qd, sub);
#pragma unroll 1
    for (int it0 = 480; it0 < 512; it0 += 8) {
        f32x4 rv[8];
#pragma unroll
        for (int u = 0; u < 8; ++u) rv[u] = *(const f32x4*)(kc + (size_t)(4 * (it0 + u) + qd) * 512 + 4 * sub);
#pragma unroll
        for (int u = 0; u < 8; ++u) { const int pos = 4 * (it0 + u) + qd;
#pragma unroll
            for (int i = 0; i < 8; ++i) { const float d = row16_sum(dot4(q[i], rv[u])); const int j = 2048 + i - pos; if (sub == 0 && j <= 128) Sc[i * 132 + j] = d - sl1 * (float)j; } }
    }
#pragma unroll
    for (int s2 = 0; s2 < 2; ++s2) { const int r = 4 * s2 + qd; const f32x4 kn = ldq4(KN + (row0 + r) * 512 + h * 64 + 4 * sub);
#pragma unroll
        for (int i = 0; i < 8; ++i) { const float d = row16_sum(dot4(q[i], kn)); const int dd = i - r;
            if (sub == 0 && dd >= 0) { Sc[i * 132 + dd] = d - sl1 * (float)dd; if ((dd & 3) == 0) Sc[(8 + i) * 132 + (dd >> 2)] = d - sl4 * (float)(dd >> 2); if (dd == 0) Sc[(16 + i) * 132] = d; } } }
    asm volatile("s_waitcnt lgkmcnt(0)" ::: "memory");
    float linv[8];
#pragma unroll
    for (int i = 0; i < 8; ++i) {
        float sv[7], mx = -INFINITY;
#pragma unroll
        for (int t = 0; t < 7; ++t) { const int e = lane + 64 * t, br = e / 129, j = e - br * 129; sv[t] = e < 387 ? Sc[(br * 8 + i) * 132 + j] : -INFINITY; mx = fmaxf(mx, sv[t]); }
        mx = wave_max(mx);
        float ps = 0.f;
#pragma unroll
        for (int t = 0; t < 7; ++t) { const int e = lane + 64 * t, br = e / 129, j = e - br * 129; const float p = __builtin_amdgcn_exp2f(sv[t] - mx); if (e < 387) { Sc[(br * 8 + i) * 132 + j] = p; ps += p; } }
        linv[i] = 1.0f / wave_sum(ps);
    }
    asm volatile("s_waitcnt lgkmcnt(0)" ::: "memory");
    fd_stream<true>(vc, vo, qa, qb, oa, ob, Sc, sl4, sl16, qd, sub);
    f32x4 o1[8];
#pragma unroll
    for (int i = 0; i < 8; ++i) o1[i] = (f32x4){0.f, 0.f, 0.f, 0.f};
#pragma unroll 1
    for (int it0 = 480; it0 < 512; it0 += 8) {
        f32x4 rv[8];
#pragma unroll
        for (int u = 0; u < 8; ++u) rv[u] = *(const f32x4*)(vc + (size_t)(4 * (it0 + u) + qd) * 512 + 4 * sub);
#pragma unroll
        for (int u = 0; u < 8; ++u) { const int pos = 4 * (it0 + u) + qd;
#pragma unroll
            for (int i = 0; i < 8; ++i) { const int j = 2048 + i - pos; const float p = j <= 128 ? Sc[i * 132 + j] : 0.f; o1[i] += rv[u] * p; } }
    }
#pragma unroll
    for (int s2 = 0; s2 < 2; ++s2) { const int r = 4 * s2 + qd; const f32x4 vn = ldq4(VN + (row0 + r) * 512 + h * 64 + 4 * sub);
#pragma unroll
        for (int i = 0; i < 8; ++i) { const int dd = i - r; float p = 0.f;
            if (dd >= 0) { p = Sc[i * 132 + dd]; if ((dd & 3) == 0) p += Sc[(8 + i) * 132 + (dd >> 2)]; if (dd == 0) p += Sc[(16 + i) * 132]; }
            o1[i] += vn * p; } }
#pragma unroll
    for (int i = 0; i < 8; ++i) {
        f32x4 t = o1[i];
#pragma unroll
        for (int e = 0; e < 4; ++e) { float x = t[e]; x += __shfl_xor(x, 16); x += __shfl_xor(x, 32); t[e] = x; }
        if (qd == (i & 3)) { t += (i < 4 ? oa : ob); t = t * linv[i];
            u32x2v w; w.x = cvtpk(t[0], t[1]); w.y = cvtpk(t[2], t[3]); *(u32x2v*)(MIX + (row0 + i) * DM + 512 + h * 64 + 4 * sub) = w; }
    }
}
__device__ __forceinline__ void ld8(const bf16_t* p, float (&v)[8]) { const u32x4 w = *(const u32x4*)p; v[0] = bflo(w.x); v[1] = bfhi(w.x); v[2] = bflo(w.y); v[3] = bfhi(w.y); v[4] = bflo(w.z); v[5] = bfhi(w.z); v[6] = bflo(w.w); v[7] = bfhi(w.w); }
__device__ __forceinline__ void ld8f(const float* p, float (&v)[8]) { const f32x4 a = *(const f32x4*)p, b = *(const f32x4*)(p + 4); v[0] = a[0]; v[1] = a[1]; v[2] = a[2]; v[3] = a[3]; v[4] = b[0]; v[5] = b[1]; v[6] = b[2]; v[7] = b[3]; }
__device__ __forceinline__ void st8(bf16_t* p, const float (&v)[8]) { u32x4 w; w.x = cvtpk(v[0], v[1]); w.y = cvtpk(v[2], v[3]); w.z = cvtpk(v[4], v[5]); w.w = cvtpk(v[6], v[7]); *(u32x4*)p = w; }
__device__ __forceinline__ void conv_item(const Args& A, int item, int lane_in) {
    int lane = lane_in; asm volatile("" : "+v"(lane));
    unsigned char* ws = A.ws; const bf16_t* C = (const bf16_t*)(ws + WS_C); const bf16_t* GB = (const bf16_t*)(ws + WS_GB); bf16_t* MIX = (bf16_t*)(ws + WS_MIX);
    const int c0 = 8 * lane;
    float w0[8], w1[8], w2[8], cm2[8], cm1[8];
    ld8f(A.in[11] + c0, w0); ld8f(A.in[11] + 512 + c0, w1); ld8f(A.in[11] + 1024 + c0, w2);
    long row0; int nrow;
    if (item < 1024) {
        const int b = item >> 7, t0 = (item & 127) * 32; row0 = (long)b * SEQ + t0; nrow = 32;
        if (t0 == 0) {
#pragma unroll
            for (int e = 0; e < 8; ++e) { cm2[e] = 0.f; cm1[e] = 0.f; }
        } else { ld8(C + (row0 - 2) * 512 + c0, cm2); ld8(C + (row0 - 1) * 512 + c0, cm1); }
    } else {
        const int b = item - 1024; row0 = MP + (long)b * NST; nrow = NST;
        ld8f(A.in[4] + (size_t)(b * 2 + 0) * 512 + c0, cm2); ld8f(A.in[4] + (size_t)(b * 2 + 1) * 512 + c0, cm1);
    }
    u32x4 cw[4], gw[4], cn[4], gn[4];
#pragma unroll
    for (int k = 0; k < 4; ++k) { cw[k] = *(const u32x4*)(C + (row0 + k) * 512 + c0); gw[k] = *(const u32x4*)(GB + (row0 + k) * 512 + c0); }
#pragma unroll 1
    for (int t0 = 0; t0 < nrow; t0 += 4) {
        if (t0 + 4 < nrow) {
#pragma unroll
            for (int k = 0; k < 4; ++k) { cn[k] = *(const u32x4*)(C + (row0 + t0 + 4 + k) * 512 + c0); gn[k] = *(const u32x4*)(GB + (row0 + t0 + 4 + k) * 512 + c0); }
        }
#pragma unroll
        for (int k = 0; k < 4; ++k) {
            float cc[8], gb[8], y[8];
            cc[0] = bflo(cw[k].x); cc[1] = bfhi(cw[k].x); cc[2] = bflo(cw[k].y); cc[3] = bfhi(cw[k].y); cc[4] = bflo(cw[k].z); cc[5] = bfhi(cw[k].z); cc[6] = bflo(cw[k].w); cc[7] = bfhi(cw[k].w);
            gb[0] = bflo(gw[k].x); gb[1] = bfhi(gw[k].x); gb[2] = bflo(gw[k].y); gb[3] = bfhi(gw[k].y); gb[4] = bflo(gw[k].z); gb[5] = bfhi(gw[k].z); gb[6] = bflo(gw[k].w); gb[7] = bfhi(gw[k].w);
#pragma unroll
            for (int e = 0; e < 8; ++e) { y[e] = gb[e] * (w0[e] * cm2[e] + w1[e] * cm1[e] + w2[e] * cc[e]); cm2[e] = cm1[e]; cm1[e] = cc[e]; }
            st8(MIX + (row0 + t0 + k) * DM + 512 + c0, y);
        }
#pragma unroll
        for (int k = 0; k < 4; ++k) { cw[k] = cn[k]; gw[k] = gn[k]; }
    }
}

__device__ __forceinline__ void pool_item(const Args& A, int item, int lane_in) {
    int lane = lane_in; asm volatile("" : "+v"(lane));
    unsigned char* ws = A.ws; const bf16_t* U = (const bf16_t*)(ws + WS_C); bf16_t* MIX = (bf16_t*)(ws + WS_MIX);
    const int c0 = 8 * lane, w = 2 << (lane >> 4);
    if (item < 1024) {
        const int b = item >> 7, t0 = (item & 127) * 32; const long rb = (long)b * SEQ;
        float S[8];
#pragma unroll
        for (int e = 0; e < 8; ++e) S[e] = 0.f;
        for (int k = 1; k < w; ++k) { const int t = t0 - k; if (t >= 0) { float u[8]; ld8(U + (rb + t) * 512 + c0, u);
#pragma unroll
            for (int e = 0; e < 8; ++e) S[e] += u[e]; } }
        for (int tb = t0; tb < t0 + 32; tb += 4) {
            u32x4 uw[4], ow[4];
#pragma unroll
            for (int k = 0; k < 4; ++k) { const int t = tb + k, tl = t - w + 1; uw[k] = *(const u32x4*)(U + (rb + t) * 512 + c0); ow[k] = *(const u32x4*)(U + (rb + (tl < 0 ? 0 : tl)) * 512 + c0); }
#pragma unroll
            for (int k = 0; k < 4; ++k) {
                const int t = tb + k; float u[8], o[8], y[8];
                u[0] = bflo(uw[k].x); u[1] = bfhi(uw[k].x); u[2] = bflo(uw[k].y); u[3] = bfhi(uw[k].y); u[4] = bflo(uw[k].z); u[5] = bfhi(uw[k].z); u[6] = bflo(uw[k].w); u[7] = bfhi(uw[k].w);
                o[0] = bflo(ow[k].x); o[1] = bfhi(ow[k].x); o[2] = bflo(ow[k].y); o[3] = bfhi(ow[k].y); o[4] = bflo(ow[k].z); o[5] = bfhi(ow[k].z); o[6] = bflo(ow[k].w); o[7] = bfhi(ow[k].w);
                const float inv = 1.0f / (float)(t + 1 < w ? t + 1 : w); const bool sub = t - w + 1 >= 0;
#pragma unroll
                for (int e = 0; e < 8; ++e) { S[e] += u[e]; y[e] = S[e] * inv - u[e]; if (sub) S[e] -= o[e]; }
                st8(MIX + (rb + t) * DM + c0, y);
            }
        }
    } else {
        const int b = item - 1024; const long rb = MP + (long)b * NST; const float inv = 1.0f / (float)w;
        for (int i = 0; i < NST; ++i) {
            float S[8], ui[8], y[8];
#pragma unroll
            for (int e = 0; e < 8; ++e) S[e] = 0.f;
            for (int k = 0; k < w; ++k) { const int idx = 15 + i - k; float u[8];
                if (idx >= 15) ld8(U + (rb + idx - 15) * 512 + c0, u); else ld8f(A.in[5] + ((size_t)b * 15 + idx) * 512 + c0, u);
#pragma unroll
                for (int e = 0; e < 8; ++e) S[e] += u[e]; }
            ld8(U + (rb + i) * 512 + c0, ui);
#pragma unroll
            for (int e = 0; e < 8; ++e) y[e] = S[e] * inv - ui[e];
            st8(MIX + (rb + i) * DM + c0, y);
        }
    }
}

#ifndef REP_ATT
#define REP_ATT 1
#endif
#ifndef REP_FUSED
#define REP_FUSED 1
#endif
#ifndef REP_CP
#define REP_CP 1
#endif
#ifndef REP_SATT
#define REP_SATT 1
#endif

__device__ __forceinline__ void mixer0(const Frame& F, const Args& A) {
    unsigned char* ws = A.ws; const int lane = F.lane;
    const bf16_t* Q = (const bf16_t*)(ws + WS_Q); const bf16_t* K = (const bf16_t*)(ws + WS_K); const bf16_t* V = (const bf16_t*)(ws + WS_V); bf16_t* MIX = (bf16_t*)(ws + WS_MIX);
    LAS unsigned char* vimg = F.lds + F.wave * VIMG;
    const int gw7 = F.gw, NGW7 = F.NGW;
    const bool conv_first = F.wave >= 4;
    if (conv_first) { for (int it = gw7; it < 1024 + NSB; it += NGW7) conv_item(A, it, lane); }
    {
        const int nun = (512 - (int)blockIdx.x + F.G - 1) / F.G, nit = 2 * nun;
        auto acfg = [&](int idx) {
            const int un = blockIdx.x + (idx >> 1) * F.G, k = idx & 1;
            const int kvh = un & 1, ch = (un >> 1) & 31, b = un >> 6;
            const int it = F.wave * 2 + k, g = it >> 2, qt = it & 3, h = kvh * 4 + g;
            AttnCfg c; c.Q = Q + h * 64; c.K = K + kvh * 64; c.V = V + kvh * 64; c.qpitch = 512; c.kvpitch = 128; c.rowbase = (long)b * SEQ; c.i0 = ch * 128 + qt * 32; c.dl = 1;
            c.sl2 = alibi_slope(h) * LOG2E; c.st = nullptr; c.tl0 = 0; c.out = MIX + h * 64; c.opitch = DM; c.sink2 = A.in[10][h] * LOG2E;
            return c;
        };
        bf16x8 qf[4], kf[4]; u32x4 vv[4];
        AttnCfg c = acfg(0); attn_preload_q(c, lane, qf); attn_preload_kv(c, lane, kf, vv);
#pragma unroll 1
        for (int idx = 0; idx < nit; ++idx) {
            const bool hn = idx + 1 < nit; const AttnCfg cn = acfg(hn ? idx + 1 : idx);
            attn_item<false, true, true>(c, vimg, lane, qf, kf, vv, hn, cn);
            c = cn;
        }
    }
    if (!conv_first) { for (int it = gw7; it < 1024 + NSB; it += NGW7) conv_item(A, it, lane); }
    for (int rep_ = 0; rep_ < REP_SATT; ++rep_)
    {
        const int free0 = 1024 + NSB;
        if (NGW7 >= free0 + 3 * NSB * 2) { const int q = gw7 - free0; if (q >= 0 && q % 3 == 0 && q / 3 < NSB * 2) { const int it = q / 3; sattn_a_item(Q, A.in[2], A.in[3], K, V, A.in[10], MIX, it >> 1, it & 1, vimg, lane); } }
        else for (int it = gw7; it < NSB * 2; it += NGW7) sattn_a_item(Q, A.in[2], A.in[3], K, V, A.in[10], MIX, it >> 1, it & 1, vimg, lane);
    }
}

__device__ __forceinline__ void mixer1(const Frame& F, const Args& A) {
    unsigned char* ws = A.ws; const int lane = F.lane;
    const bf16_t* Q = (const bf16_t*)(ws + WS_Q); const bf16_t* K = (const bf16_t*)(ws + WS_K); const bf16_t* V = (const bf16_t*)(ws + WS_V); bf16_t* MIX = (bf16_t*)(ws + WS_MIX);
    LAS unsigned char* stlds = F.lds + NWAVES * VIMG;
    static_assert(NWAVES * VIMG + ST_BYTES <= RING_BYTES, "attention LDS map");
    LAS unsigned char* vimg = F.lds + F.wave * VIMG;
    {
        const int nun = (512 - (int)blockIdx.x + F.G - 1) / F.G, nit = 6 * nun;
        auto dcfg = [&](int idx) {
            const int j = idx / 6, w6 = idx - 6 * j, br = w6 >> 1, k = w6 & 1, un = blockIdx.x + j * F.G;
            const int h = un & 7, ch = (un >> 3) & 7, b = un >> 6, T0 = ch * 512;
            const int dl = br == 0 ? 16 : br == 1 ? 4 : 1, it = F.wave * 2 + k;
            int r, i0; if (br == 0) { r = it; i0 = T0 / 16; } else if (br == 1) { r = it & 3; i0 = T0 / 4 + 32 * (it >> 2); } else { r = 0; i0 = T0 + 32 * it; }
            AttnCfg c; c.Q = Q + h * 64; c.K = K + h * 64; c.V = V + h * 64; c.qpitch = 512; c.kvpitch = 512; c.rowbase = (long)b * SEQ + r; c.i0 = i0; c.dl = dl;
            c.sl2 = alibi_slope(h) * (float)dl * LOG2E; c.st = stlds; c.tl0 = r - T0; c.out = MIX + 512 + h * 64; c.opitch = DM; c.sink2 = 0.f;
            return c;
        };
        bf16x8 qf[4], kf[4]; u32x4 vv[4];
        AttnCfg c = dcfg(0); attn_preload_q(c, lane, qf); attn_preload_kv(c, lane, kf, vv);
        int br = 0, k = 0;
#pragma unroll 1
        for (int idx = 0; idx < nit; ++idx) {
            const bool hn = idx + 1 < nit; const AttnCfg cn = dcfg(hn ? idx + 1 : idx);
            if (br == 0) attn_item<false, false, false>(c, vimg, lane, qf, kf, vv, hn, cn);
            else if (br == 1) attn_item<true, false, false>(c, vimg, lane, qf, kf, vv, hn, cn);
            else attn_item<true, true, false>(c, vimg, lane, qf, kf, vv, hn, cn);
            if (k == 1) { __syncthreads(); br = br == 2 ? 0 : br + 1; }
            k ^= 1;
            c = cn;
        }
    }
    __syncthreads();
    if (F.wave < 4) {
        const int item = F.vcu * 4 + F.wave;
        for (int rep_ = 0; rep_ < REP_FUSED; ++rep_)
        for (int it = item; it < NSB * 8; it += F.G * 4) fused_d_item(A, it >> 3, it & 7, (LAS float*)(F.lds + F.wave * FD_LDS), lane);
    } else {
        const int gw4 = F.vcu * 4 + (F.wave - 4), NGW4 = F.G * 4;
        for (int rep_ = 0; rep_ < REP_CP; ++rep_)
        for (int it = gw4; it < 1024 + NSB; it += NGW4) pool_item(A, it, lane);
    }
}

__device__ __forceinline__ void final_ln(const Frame& F, const Args& A, float* dstbase, bool desig, int dsg) {
    const float* g = A.in[24] + DM; const float* bb = A.in[25] + DM;
    f32x4 gv[4], bv[4];
#pragma unroll
    for (int j = 0; j < 4; ++j) { gv[j] = ((const f32x4*)g)[F.lane + 64 * j]; bv[j] = ((const f32x4*)bb)[F.lane + 64 * j]; }
    const int m0 = desig ? MP + dsg * 64 + F.wave : F.vcu_lt240 * NWAVES + F.wave, mstep = desig ? NWAVES : 240 * NWAVES, mend = desig ? MP + dsg * 64 + 64 : MP;
    for (int m = m0; m < mend; m += mstep) {
        GAS f32x4* xr = (GAS f32x4*)(A.out + O_Y + (size_t)m * DM) + F.lane;
        f32x4 v[4]; float s = 0.f;
#pragma unroll
        for (int j = 0; j < 4; ++j) { v[j] = xr[64 * j]; s += (v[j][0] + v[j][1]) + (v[j][2] + v[j][3]); }
        const float mean = wave_sum(s) * (1.f / DM); float s2 = 0.f;
#pragma unroll
        for (int j = 0; j < 4; ++j) { v[j] = v[j] - mean; s2 += (v[j][0] * v[j][0] + v[j][1] * v[j][1]) + (v[j][2] * v[j][2] + v[j][3] * v[j][3]); }
        const float rstd = 1.f / sqrtf(wave_sum(s2) * (1.f / DM) + LN_EPS);
        GAS f32x4* xo = (GAS f32x4*)(dstbase + (size_t)m * DM) + F.lane;
#pragma unroll
        for (int j = 0; j < 4; ++j) xo[64 * j] = v[j] * rstd * gv[j] + bv[j];
    }
}
#ifndef LAST_PHASE
#define LAST_PHASE 11
#endif
constexpr int CW_DEFER = 12288;
struct UOrder {
    int nN, c, npre, pm0, pn0, nmain, extraL, rev;
    __device__ __forceinline__ static void map(int L, int nN, Unit& u) {
        const int nM = MP / 256, nwg = nM * nN; int wgid = L;
        { const int q = nwg / 8, r = nwg % 8, xcd = wgid % 8, off = wgid / 8; wgid = (xcd < r ? xcd * (q + 1) : r * (q + 1) + (xcd - r) * q) + off; }
        const int nig = 8 * nN, gid = wgid / nig, fm = gid * 8, gsz = (nM - fm) < 8 ? (nM - fm) : 8;
        u.pm = fm + ((wgid % nig) % gsz); u.pn = (wgid % nig) / gsz;
    }
    __device__ __forceinline__ bool next(int i, Unit& u) const {
        if (i < npre) { u.pm = pm0; u.pn = pn0 + i; return true; }
        const int k = i - npre; int L;
        if (k < nmain) L = (rev ? nmain - 1 - k : k) * 256 + c; else if (k == nmain && extraL >= 0) L = extraL; else return false;
        map(L, nN, u); return true;
    }
    __device__ __forceinline__ void a_ready(const Unit&) const {}
    __device__ __forceinline__ void done(const Unit&) const {}
    __device__ __forceinline__ static UOrder prompt_rounds(int nN, int c, int rounds, int rev = 0) { return UOrder{nN, c, 0, 0, 0, rounds, -1, rev}; }
    __device__ __forceinline__ static UOrder sample_units(int nN, int pm, int pn0, int n) { return UOrder{nN, 0, n, pm, pn0, 0, -1, 0}; }
    __device__ __forceinline__ static UOrder mlp1(int c) {
        if (c >= 240) { const int d = c - 240; return UOrder{16, c, 4, 128 + (d >> 2), 4 * (d & 3), 0, -1, 0}; }
        const int g8 = c >> 3, a = (g8 & 1) == 0 ? (g8 >> 1) * 8 + (c & 7) : (g8 == 29 ? 120 + (c & 7) : -1);
        return UOrder{16, c, 0, 0, 0, 8, a >= 0 ? (a / 16) * 256 + 240 + (a % 16) : -1, 0};
    }
    __device__ __forceinline__ static UOrder in1(int c) {
        if (c >= 240) { const int d = c - 240; return UOrder{8, c, 2, 128 + (d >> 2), 2 * (d & 3), 2, -1, 0}; }
        return UOrder{8, c, 0, 0, 0, 4, c < 32 ? (2 + c / 16) * 256 + 240 + (c % 16) : -1, 0};
    }
};
__device__ __forceinline__ void sync16(const Frame& F, gu32* cnt) {
    asm volatile("s_waitcnt vmcnt(0)" ::: "memory");
    __syncthreads();
    if (F.tid == 0) {
        __builtin_amdgcn_fence(__ATOMIC_RELEASE, "agent");
        asm volatile("s_waitcnt vmcnt(0)" ::: "memory");
        __hip_atomic_fetch_add(cnt, 1u, RLX_AGENT);
        unsigned sp = 0;
        while (__hip_atomic_load(cnt, RLX_AGENT) < 16u) { __builtin_amdgcn_s_sleep(1); if (++sp > XB_SPIN_CAP) { atomicAdd((unsigned*)(F.ctl + CW_BAR) + XB_TMO, 1u); break; } }
        __builtin_amdgcn_fence(__ATOMIC_ACQUIRE, "agent");
        asm volatile("s_waitcnt vmcnt(0)" ::: "memory");
    }
    __syncthreads();
}
constexpr int ARG_OFF = LDSCTL_OFF + 512;
__device__ __forceinline__ const float* lds_arg(const Frame& F, int i) {
    const LAS unsigned* t = (const LAS unsigned*)(F.lds + ARG_OFF) + 2 * i;
    const unsigned lo = __builtin_amdgcn_readfirstlane(t[0]), hi = __builtin_amdgcn_readfirstlane(t[1]);
    return (const float*)(const GAS float*)(((unsigned long long)hi << 32) | lo);
}
#define LOAD_ARGS(A) Args A; { int t_ = threadIdx.x; asm volatile("" : "+v"(t_)); F.tid = t_; F.lane = t_ & 63; } {     _Pragma("unroll") for (int i_ = 0; i_ < 26; ++i_) A.in[i_] = lds_arg(F, i_); A.out = (float*)lds_arg(F, 26); A.ws = (unsigned char*)lds_arg(F, 27); }
__global__ void __launch_bounds__(NWAVES * 64, 2) hybrid_fwd(Args args) {
    extern __shared__ __attribute__((aligned(16))) unsigned char lds[];
    Frame F;
    F.lds = (LAS unsigned char*)lds;
    F.tid = threadIdx.x; F.lane = F.tid & 63; F.wave = __builtin_amdgcn_readfirstlane(F.tid >> 6);
    F.G = gridDim.x; { const int bx = blockIdx.x; F.vcu = (F.G % 8 == 0) ? (bx % 8) * (F.G / 8) + bx / 8 : bx; }
    F.gw = F.vcu * NWAVES + F.wave; F.NGW = F.G * NWAVES; F.vcu_lt240 = (int)blockIdx.x;
    F.ctl = (gu32*)(args.ws + WS_CTL);
    volatile LAS unsigned* MISC = (volatile LAS unsigned*)(F.lds + MISC_OFF);
    for (int u = F.tid; u < (LDS_BYTES - LDSCTL_OFF) / 4; u += NWAVES * 64) ((LAS unsigned*)(F.lds + LDSCTL_OFF))[u] = 0u;
    __syncthreads();
    if (F.tid == 0) {
        LAS unsigned long long* t = (LAS unsigned long long*)(F.lds + ARG_OFF);
#pragma unroll
        for (int i = 0; i < 26; ++i) t[i] = (unsigned long long)args.in[i];
        t[26] = (unsigned long long)args.out; t[27] = (unsigned long long)args.ws;
    }
    __syncthreads();
    XcdBarrier bar = xcd_barrier_post((unsigned*)(F.ctl + CW_BAR), MISC + 8);
    const int bid = (int)blockIdx.x;
#ifdef REP_BAR
#define PHASE_END(k) do { { LOAD_ARGS(Ac_); steal_copy(F, Ac_, (k), false); } xcd_barrier(bar); xcd_barrier(bar); } while (0)
#else
#define PHASE_END(k) do { { LOAD_ARGS(Ac_); steal_copy(F, Ac_, (k), false); } xcd_barrier(bar); } while (0)
#endif
#define PHASE_END_NS(k) do { xcd_barrier(bar); } while (0)
#define WSP(T, off) ((T*)(A.ws + (off)))
#define VECP(off) ((float*)(A.ws + WS_VEC) + (off))

    const bool desig = bid >= 240; const int dsg = bid - 240;
    gu32* dcnt = F.ctl + CW_DEFER;

#define STAGGER if (!desig && ((bid >> 3) & 1) && (bid >> 3) != 29) { LOAD_ARGS(As_); stagger_copy(F, As_, 2); }
    { LOAD_ARGS(A); p0_prologue(F, A); }
    PHASE_END_NS(0);
    { LOAD_ARGS(A); pg8::Gemm g{WSP(bf16_t, WS_XB), WSP(const bf16_t, WS_WIN0), M, N_IN0, DM}; pg8::StaticOrder S; S.init(M, N_IN0, F.G, bid);
      EpiIn0 E{WSP(bf16_t, WS_Q), WSP(bf16_t, WS_K), WSP(bf16_t, WS_V), WSP(bf16_t, WS_C), WSP(bf16_t, WS_GB), VECP(V_BIN0), A.out};
      pg8::gemm_phase<EpiIn0, pg8::StaticOrder, true, true>(F.lds, g, S, E); }
    PHASE_END(1);
    { LOAD_ARGS(A); mixer0(F, A); }
    PHASE_END_NS(2);
#define GEMM_MLP2_0(ORD) { LOAD_ARGS(A); pg8::Gemm g{WSP(bf16_t, WS_H), WSP(const bf16_t, WS_W2_0), M, DM, FF}; \
      EpiRes<true, false, false> E{WSP(const bf16_t, WS_ZH0), WSP(float, WS_STA), A.in[22], A.in[23], nullptr, nullptr, WSP(bf16_t, WS_ZH1), WSP(float, WS_STB), F.lds}; \
      pg8::gemm_phase<EpiRes<true, false, false>, UOrder, true, true>(F.lds, g, ORD, E); }
#define GEMM_MLP2_0_SAMPLE if (desig) { sync16(F, dcnt + 64); { UOrder S = UOrder::sample_units(4, 128 + (dsg >> 2), dsg & 3, 1); GEMM_MLP2_0(S) } }
#define GEMM_OUT0(ORD) { LOAD_ARGS(A); pg8::Gemm g{WSP(bf16_t, WS_MIX), WSP(const bf16_t, WS_WOUT0), M, DM, DM}; \
      EpiRes<false, true, false> E{WSP(const bf16_t, WS_XB), nullptr, nullptr, nullptr, A.in[13], nullptr, WSP(bf16_t, WS_ZH0), WSP(float, WS_STA), F.lds}; \
      pg8::gemm_phase<EpiRes<false, true, false>, UOrder, true, true>(F.lds, g, ORD, E); }
    { UOrder S = UOrder::prompt_rounds(4, bid, 2); GEMM_OUT0(S) }
    PHASE_END_NS(3);
    if (desig) { { UOrder S = UOrder::sample_units(4, 128 + (dsg >> 2), dsg & 3, 1); GEMM_OUT0(S) } sync16(F, dcnt + 0); }
#define GEMM_MLP1(WOFF, CSO, BWO, ORD) { LOAD_ARGS(A); pg8::Gemm g{WSP(bf16_t, WS_ZH0), WSP(const bf16_t, WOFF), M, FF, DM}; \
      EpiMlp1 E{WSP(bf16_t, WS_H), VECP(CSO), VECP(BWO), WSP(float, WS_STA), F.lds}; \
      pg8::gemm_phase<EpiMlp1, UOrder, true, true>(F.lds, g, ORD, E); }
    STAGGER
    { UOrder S = UOrder::mlp1(bid); GEMM_MLP1(WS_W1_0, V_CS1_0, V_BW1_0, S) }
    GEMM_MLP2_0_SAMPLE
    PHASE_END(4);
    { UOrder S = UOrder::prompt_rounds(4, bid, 2, 1); GEMM_MLP2_0(S) }
    PHASE_END_NS(5);
    { LOAD_ARGS(A); pg8::Gemm g{WSP(bf16_t, WS_ZH1), WSP(const bf16_t, WS_WIN1), M, N_IN1, DM}; UOrder S = UOrder::in1(bid);
      EpiIn1 E{WSP(bf16_t, WS_C), WSP(bf16_t, WS_Q), WSP(bf16_t, WS_K), WSP(bf16_t, WS_V), VECP(V_CSIN1), VECP(V_BWIN1), WSP(float, WS_STB), A.out, F.lds};
      pg8::gemm_phase<EpiIn1, UOrder, true, true>(F.lds, g, S, E); }
    PHASE_END(6);
    { LOAD_ARGS(A); mixer1(F, A); }
    PHASE_END_NS(7);
#define GEMM_MLP2_1(ORD) { LOAD_ARGS(A); pg8::Gemm g{WSP(bf16_t, WS_H), WSP(const bf16_t, WS_W2_1), M, DM, FF}; \
      EpiResFinal E{WSP(const bf16_t, WS_ZH0), WSP(float, WS_STA), A.in[22] + DM, A.in[23] + DM, A.in[24] + DM, A.in[25] + DM, A.out + O_Y, WSP(float, WS_STB), F.ctl, F.lds}; \
      pg8::gemm_phase<EpiResFinal, UOrder, true, true>(F.lds, g, ORD, E); }
#define GEMM_MLP2_1_SAMPLE if (desig) { sync16(F, dcnt + 192); { UOrder S = UOrder::sample_units(4, 128 + (dsg >> 2), dsg & 3, 1); GEMM_MLP2_1(S) } }
#define GEMM_OUT1(ORD) { LOAD_ARGS(A); pg8::Gemm g{WSP(bf16_t, WS_MIX), WSP(const bf16_t, WS_WOUT1), M, DM, DM}; \
      EpiRes<true, true, false> E{WSP(const bf16_t, WS_ZH1), WSP(float, WS_STB), A.in[24], A.in[25], A.in[19], nullptr, WSP(bf16_t, WS_ZH0), WSP(float, WS_STA), F.lds}; \
      pg8::gemm_phase<EpiRes<true, true, false>, UOrder, true, true>(F.lds, g, ORD, E); }
    { UOrder S = UOrder::prompt_rounds(4, bid, 2); GEMM_OUT1(S) }
    PHASE_END_NS(8);
    if (desig) { { UOrder S = UOrder::sample_units(4, 128 + (dsg >> 2), dsg & 3, 1); GEMM_OUT1(S) } sync16(F, dcnt + 128); }
    STAGGER
    { UOrder S = UOrder::mlp1(bid); GEMM_MLP1(WS_W1_1, V_CS1_1, V_BW1_1, S) }
    GEMM_MLP2_1_SAMPLE
    PHASE_END(9);
    { UOrder S = UOrder::prompt_rounds(4, bid, 2, 1); GEMM_MLP2_1(S) }
    { LOAD_ARGS(A); steal_copy(F, A, 11, true); }
#undef GEMM_OUT0
#undef GEMM_MLP1
#undef GEMM_MLP2_0
#undef GEMM_OUT1
#undef GEMM_MLP2_1
#undef GEMM_MLP2_0_SAMPLE
#undef GEMM_MLP2_1_SAMPLE
#undef PHASE_END
#undef WSP
#undef VECP
}

extern "C" void kernel_launch(void* const* d_in, const int* in_sizes, int n_in, void* d_out, int out_size, void* d_ws, size_t ws_size, hipStream_t stream) {
    static int grid = 0;
    if (grid == 0) {
        if (n_in != 26 || in_sizes[0] != MP * DM || (size_t)out_size != O_TOTAL || ws_size < WS_END) {
            fprintf(stderr, "kernel_launch: unexpected shapes (n_in %d, in0 %d, out %d, ws %zu); nothing launched\n", n_in, n_in > 0 ? in_sizes[0] : -1, out_size, ws_size); grid = -1; return; }
        int dev = 0, cus = 0, per_cu = 0;
        if (hipGetDevice(&dev) != hipSuccess || hipDeviceGetAttribute(&cus, hipDeviceAttributeMultiprocessorCount, dev) != hipSuccess) { grid = -1; return; }
        if (hipFuncSetAttribute((const void*)hybrid_fwd, hipFuncAttributeMaxDynamicSharedMemorySize, LDS_BYTES) != hipSuccess) { fprintf(stderr, "kernel_launch: hipFuncSetAttribute failed\n"); grid = -1; return; }
        if (hipOccupancyMaxActiveBlocksPerMultiprocessor(&per_cu, (const void*)hybrid_fwd, NWAVES * 64, LDS_BYTES) != hipSuccess || per_cu < 1) {
            fprintf(stderr, "kernel_launch: occupancy query reports %d workgroups per CU; nothing launched\n", per_cu); (void)hipGetLastError(); grid = -1; return; }
        grid = cus;
        if (grid != 256) { fprintf(stderr, "kernel_launch: the unit schedule is built for 256 workgroups, this device has %d CUs; nothing launched\n", cus); grid = -1; return; }
    }
    if (grid < 0) return;
    if (hipMemsetAsync((char*)d_ws + WS_CTL, 0, CTL_ZERO_BYTES, stream) != hipSuccess) return;
    Args a{};
    for (int i = 0; i < 26; ++i) a.in[i] = (const float*)d_in[i];
    a.out = (float*)d_out; a.ws = (unsigned char*)d_ws;
    hipLaunchKernelGGL(hybrid_fwd, dim3(grid), dim3(NWAVES * 64), LDS_BYTES, stream, a);
}
```

```cpp
#include <hip/hip_runtime.h>
#include <cstdio>
#include <cstdint>
namespace pg8 {
#define PG8_LAS __attribute__((address_space(3)))
typedef unsigned short bf16_t;
typedef short bf16x8 __attribute__((ext_vector_type(8)));
typedef float f32x4 __attribute__((ext_vector_type(4)));
typedef unsigned u32x4 __attribute__((ext_vector_type(4)));
constexpr int BM = 256, BK = 64, HALF = 128, HTB = HALF * BK * 2  , STAGE_BYTES = 8 * HTB, NXCD = 8, WGM = 8;

__host__ __device__ __forceinline__ int lds_byte(int r, int c) { const int st = (r >> 4) * 2 + (c >> 5), rr = r & 15, cc = c & 31, ob = rr * 64 + cc * 2; return st * 1024 + (ob ^ (((ob >> 9) & 1) << 5)); }
__host__ __device__ __forceinline__ void stage_rc(int b, int& R, int& C) { const int st = b / 1024, sb = b % 1024, swz = sb ^ (((sb >> 9) & 1) << 5); R = (st >> 1) * 16 + swz / 64; C = (st & 1) * 32 + (swz % 64) / 2; }
__host__ __device__ __forceinline__ int perm32(int rho) { const int n = rho >> 4, i = rho & 15; return 8 * (i >> 2) + 4 * n + (i & 3); }

struct Unit { int pm, pn; };
struct Gemm { const bf16_t* A; const bf16_t* Bt; int M, N, K; };

struct StaticOrder {
    int nM, nN, nwg, G, c;
    __host__ __device__ void init(int M, int N, int G_, int c_) { nM = M / BM; nN = N / BM; nwg = nM * nN; G = G_; c = c_; }
    __host__ __device__ bool next(int i, Unit& u) const {
        const long L = (long)i * G + c; if (L >= nwg) return false;
        int wgid = (int)L; { const int q = nwg / NXCD, r = nwg % NXCD, xcd = wgid % NXCD, off = wgid / NXCD; wgid = (xcd < r ? xcd * (q + 1) : r * (q + 1) + (xcd - r) * q) + off; }
        const int nig = WGM * nN, gid = wgid / nig, fm = gid * WGM, gsz = (nM - fm) < WGM ? (nM - fm) : WGM;
        u.pm = fm + ((wgid % nig) % gsz); u.pn = (wgid % nig) / gsz; return true;
    }
    __device__ __forceinline__ void a_ready(const Unit&) const {}
    __device__ __forceinline__ void done(const Unit&) const {}
};

__device__ __forceinline__ unsigned cvt_pk_bf16(float lo, float hi) { unsigned r; asm volatile("v_cvt_pk_bf16_f32 %0, %1, %2" : "=v"(r) : "v"(lo), "v"(hi)); return r; }
typedef float f32x2 __attribute__((ext_vector_type(2)));
template <class Epi, class Sched, bool ALIGN_EPI = false, bool SP2 = false>
__device__ __forceinline__ void gemm_phase(PG8_LAS unsigned char* lds, const Gemm g, const Sched& S, const Epi& E) {
    int tid_ = threadIdx.x; asm volatile("" : "+v"(tid_));
    const int tid = tid_, wid = __builtin_amdgcn_readfirstlane(tid >> 6), lane = tid & 63, wr = wid >> 2, wc = wid & 3, fr = lane & 15, fq = lane >> 4;
    const int K = g.K, nt = K / BK;
    unsigned voffA[2], voffB[2];
#pragma unroll
    for (int i = 0; i < 2; ++i) { int R, C; stage_rc(tid * 16 + i * 8192, R, C); const int Rb = Epi::PERM ? ((R & ~31) + perm32(R & 31)) : R;
        voffA[i] = (unsigned)(R * K + C) * 2u; voffB[i] = (unsigned)(Rb * K + C) * 2u; }
    const size_t kstep = (size_t)(BK * 2);
    const size_t hstep = (size_t)HALF * K * 2;
    const size_t tstep = 2 * hstep;
    const unsigned ldsw = (unsigned)wid * 1024u;
    const int aoff = lds_byte(wr * 64 + fr, fq * 8), boff = lds_byte(wc * 32 + fr, fq * 8);
#define PG8_SA(b, h) (((b) * 2 + (h)) * HTB)
#define PG8_SB(b, h) ((4 + (b) * 2 + (h)) * HTB)
#define PG8_STAGE(bufoff, gbase, voff) do { _Pragma("unroll") for (int _i = 0; _i < 2; ++_i) \
        __builtin_amdgcn_global_load_lds((const unsigned*)((const char*)(gbase) + (voff)[_i]), (PG8_LAS unsigned*)(lds + (bufoff) + ldsw + _i * 8192), 16, 0, 0); } while (0)
#define PG8_LDA(dst, b, h) do { _Pragma("unroll") for (int m = 0; m < 4; ++m) _Pragma("unroll") for (int k = 0; k < 2; ++k) dst[m][k] = *(const PG8_LAS bf16x8*)(lds + PG8_SA(b, h) + aoff + m * 2048 + k * 1024); } while (0)
#define PG8_LDB(dst, b, h) do { _Pragma("unroll") for (int n = 0; n < 2; ++n) _Pragma("unroll") for (int k = 0; k < 2; ++k) dst[n][k] = *(const PG8_LAS bf16x8*)(lds + PG8_SB(b, h) + boff + n * 2048 + k * 1024); } while (0)
#define PG8_MMA(ai, bj, At, Bt) do { __builtin_amdgcn_s_setprio(1); _Pragma("unroll") for (int m = 0; m < 4; ++m) _Pragma("unroll") for (int n = 0; n < 2; ++n) _Pragma("unroll") for (int k = 0; k < 2; ++k) \
        acc[ai][bj][m][n] = __builtin_amdgcn_mfma_f32_16x16x32_bf16(Bt[n][k], At[m][k], acc[ai][bj][m][n], 0, 0, 0); __builtin_amdgcn_s_setprio(0); } while (0)
#define PG8_WAIT_V(n) asm volatile("s_waitcnt vmcnt(" #n ")" ::: "memory")
#define PG8_WAIT_L(n) asm volatile("s_waitcnt lgkmcnt(" #n ")" ::: "memory")
#define PG8_BAR __builtin_amdgcn_s_barrier()
#define PG8_SCHED __builtin_amdgcn_sched_barrier(0)
    Unit cur, nxt; int ui = 0;
    if (!S.next(0, cur)) return;
    f32x4 acc[2][2][4][2];
#pragma unroll
    for (int a = 0; a < 2; ++a)
#pragma unroll
        for (int b = 0; b < 2; ++b)
#pragma unroll
            for (int m = 0; m < 4; ++m)
#pragma unroll
                for (int n = 0; n < 2; ++n) acc[a][b][m][n] = (f32x4){0.f, 0.f, 0.f, 0.f};
    bf16x8 At[4][2], B0[2][2], B1[2][2];
    const char* cA = (const char*)g.A + (size_t)cur.pm * tstep; const char* cB = (const char*)g.Bt + (size_t)cur.pn * tstep;
    S.a_ready(cur);
    if (wr == 1) E.pre(cur, wid, lane);
    if constexpr (SP2) {
        PG8_STAGE(PG8_SB(0, 0), cB, voffB); PG8_STAGE(PG8_SB(0, 1), cB + hstep, voffB); PG8_STAGE(PG8_SA(0, 0), cA, voffA); PG8_STAGE(PG8_SA(0, 1), cA + hstep, voffA);
        if (wr == 1) PG8_BAR;
        PG8_WAIT_V(2); PG8_BAR;
        PG8_STAGE(PG8_SB(1, 0), cB + kstep, voffB); PG8_STAGE(PG8_SA(1, 0), cA + kstep, voffA); PG8_STAGE(PG8_SB(1, 1), cB + hstep + kstep, voffB);
        PG8_WAIT_V(6); PG8_BAR;
    } else {
        PG8_STAGE(PG8_SB(0, 0), cB, voffB); PG8_STAGE(PG8_SA(0, 0), cA, voffA); PG8_STAGE(PG8_SB(0, 1), cB + hstep, voffB); PG8_STAGE(PG8_SA(0, 1), cA + hstep, voffA);
        if (wr == 1) PG8_BAR;
        PG8_WAIT_V(4); PG8_BAR;
        PG8_STAGE(PG8_SB(1, 0), cB + kstep, voffB); PG8_STAGE(PG8_SA(1, 0), cA + kstep, voffA); PG8_STAGE(PG8_SB(1, 1), cB + hstep + kstep, voffB);
        PG8_WAIT_V(6); PG8_BAR;
    }
    for (;;) {
        const bool has_next = S.next(ui + 1, nxt);
        const char* nA = has_next ? (const char*)g.A + (size_t)nxt.pm * tstep : cA; const char* nB = has_next ? (const char*)g.Bt + (size_t)nxt.pn * tstep : cB;
        for (int t = 0; t < nt; t += 2) {
            const bool last = (t == nt - 2);
            const char* a1 = cA + (size_t)(t + 1) * kstep;
            const char* a2 = last ? nA : cA + (size_t)(t + 2) * kstep; const char* b2 = last ? nB : cB + (size_t)(t + 2) * kstep;
            const char* a3 = a2 + kstep; const char* b3 = b2 + kstep;
            if (last && has_next) S.a_ready(nxt);
            if constexpr (SP2) {
            PG8_LDB(B0, 0, 0); PG8_LDB(B1, 0, 1); PG8_SCHED; PG8_LDA(At, 0, 0); PG8_STAGE(PG8_SA(1, 1), a1 + hstep, voffA);
            PG8_WAIT_V(8); PG8_WAIT_L(0); PG8_BAR; PG8_MMA(0, 0, At, B0); PG8_MMA(0, 1, At, B1); PG8_BAR; PG8_SCHED;
            PG8_LDA(At, 0, 1); PG8_STAGE(PG8_SB(0, 0), b2, voffB); PG8_STAGE(PG8_SB(0, 1), b2 + hstep, voffB); PG8_STAGE(PG8_SA(0, 0), a2, voffA);
            PG8_WAIT_V(8); PG8_WAIT_L(0); PG8_BAR; PG8_MMA(1, 0, At, B0); PG8_MMA(1, 1, At, B1); PG8_BAR; PG8_SCHED;
            PG8_LDB(B0, 1, 0); PG8_LDB(B1, 1, 1); PG8_SCHED; PG8_LDA(At, 1, 0); PG8_STAGE(PG8_SA(0, 1), a2 + hstep, voffA);
            PG8_WAIT_V(8); PG8_WAIT_L(0); PG8_BAR; PG8_MMA(0, 0, At, B0); PG8_MMA(0, 1, At, B1); PG8_BAR; PG8_SCHED;
            PG8_LDA(At, 1, 1); PG8_STAGE(PG8_SB(1, 0), b3, voffB); PG8_STAGE(PG8_SB(1, 1), b3 + hstep, voffB); PG8_STAGE(PG8_SA(1, 0), a3, voffA);
            PG8_WAIT_V(8); PG8_WAIT_L(0); PG8_BAR; PG8_MMA(1, 0, At, B0); PG8_MMA(1, 1, At, B1); PG8_BAR; PG8_SCHED;
            } else {
            PG8_LDB(B0, 0, 0); PG8_SCHED; PG8_LDA(At, 0, 0); PG8_STAGE(PG8_SA(1, 1), a1 + hstep, voffA);
            PG8_WAIT_L(8); PG8_BAR; PG8_WAIT_L(0); PG8_MMA(0, 0, At, B0); PG8_BAR; PG8_SCHED;
            PG8_LDB(B1, 0, 1); PG8_STAGE(PG8_SB(0, 0), b2, voffB);
            PG8_BAR; PG8_WAIT_L(0); PG8_MMA(0, 1, At, B1); PG8_BAR;
            PG8_LDA(At, 0, 1); PG8_STAGE(PG8_SA(0, 0), a2, voffA);
            PG8_BAR; PG8_WAIT_L(0); PG8_MMA(1, 0, At, B0); PG8_BAR; PG8_SCHED;
            PG8_STAGE(PG8_SB(0, 1), b2 + hstep, voffB);
            PG8_WAIT_V(6); PG8_BAR; PG8_MMA(1, 1, At, B1); PG8_BAR;
            PG8_LDB(B0, 1, 0); PG8_SCHED; PG8_LDA(At, 1, 0); PG8_STAGE(PG8_SA(0, 1), a2 + hstep, voffA);
            PG8_WAIT_L(8); PG8_BAR; PG8_WAIT_L(0); PG8_MMA(0, 0, At, B0); PG8_BAR; PG8_SCHED;
            PG8_LDB(B1, 1, 1); PG8_STAGE(PG8_SB(1, 0), b3, voffB);
            PG8_BAR; PG8_WAIT_L(0); PG8_MMA(0, 1, At, B1); PG8_BAR;
            PG8_LDA(At, 1, 1); PG8_STAGE(PG8_SA(1, 0), a3, voffA);
            PG8_BAR; PG8_WAIT_L(0); PG8_MMA(1, 0, At, B0); PG8_BAR; PG8_SCHED;
            PG8_STAGE(PG8_SB(1, 1), b3 + hstep, voffB);
            PG8_WAIT_V(6); PG8_BAR; PG8_MMA(1, 1, At, B1); PG8_BAR;
            }
        }
        if constexpr (ALIGN_EPI) { if (wr == 0) PG8_BAR; }
        if constexpr (!Epi::AFTER_DRAIN) { E(acc, cur, wr, wc, fr, fq); S.done(cur); }
        if (!has_next) break;
#pragma unroll
        for (int a = 0; a < 2; ++a)
#pragma unroll
            for (int b = 0; b < 2; ++b)
#pragma unroll
                for (int m = 0; m < 4; ++m)
#pragma unroll
                    for (int n = 0; n < 2; ++n) acc[a][b][m][n] = (f32x4){0.f, 0.f, 0.f, 0.f};
        cur = nxt; cA = nA; cB = nB; ++ui;
        if constexpr (ALIGN_EPI) { if (wr == 1) { PG8_BAR; E.pre(cur, wid, lane); } }
    }
    PG8_WAIT_V(0);
    if constexpr (!ALIGN_EPI) { if (wr == 0) PG8_BAR; }
    PG8_BAR;
    if constexpr (Epi::AFTER_DRAIN) { E.fused(acc, cur, wr, wc, fr, fq, lds, wid, lane); S.done(cur); }
#undef PG8_SA
#undef PG8_SB
#undef PG8_STAGE
#undef PG8_LDA
#undef PG8_LDB
#undef PG8_MMA
#undef PG8_WAIT_V
#undef PG8_WAIT_L
#undef PG8_BAR
#undef PG8_SCHED
}
}
#define GAS __attribute__((address_space(1)))
#define LAS __attribute__((address_space(3)))
typedef unsigned short bf16;
typedef unsigned v4u __attribute__((ext_vector_type(4)));
typedef float f32x4 __attribute__((ext_vector_type(4)));
typedef short bf16x8 __attribute__((ext_vector_type(8)));
typedef GAS unsigned gu32;
typedef GAS unsigned long long gu64;
#define RLX_AGENT __ATOMIC_RELAXED, __HIP_MEMORY_SCOPE_AGENT
#define LDS_WAIT() asm volatile("s_waitcnt lgkmcnt(0)" ::: "memory")
#define VM_WAIT() asm volatile("s_waitcnt vmcnt(0)" ::: "memory")
__device__ __forceinline__ unsigned long long rt() { return __builtin_amdgcn_s_memrealtime(); }
__device__ __forceinline__ unsigned f2bf(float f) { unsigned u = __builtin_bit_cast(unsigned, f); return (u + 0x7fffu + ((u >> 16) & 1u)) >> 16; }
__device__ __forceinline__ unsigned pk2(float lo, float hi) { return f2bf(lo) | (f2bf(hi) << 16); }

#define XB_TMO      128
#define XB_XCNT(j)  (256  + 64 * (j))
#define XB_XSUB(j)  (1280 + 64 * (j))
#define XB_XGEN(j)  (2304 + 64 * (j))
#define XB_TOP      3328
#define XB_TOPGEN   3392
#define XCD_BAR_WORDS 3456
#define XB_SPIN_CAP (1u << 22)

__device__ __forceinline__ unsigned xb_ld(unsigned* p)              { return __hip_atomic_load(p, __ATOMIC_RELAXED, __HIP_MEMORY_SCOPE_AGENT); }
__device__ __forceinline__ unsigned xb_add(unsigned* p, unsigned v) { return __hip_atomic_fetch_add(p, v, __ATOMIC_RELAXED, __HIP_MEMORY_SCOPE_AGENT); }
__device__ __forceinline__ unsigned xb_xcc_id() { return (unsigned)__builtin_amdgcn_s_getreg((3 << 11) | 20) & 0xFu; }
#define XB_SPIN(cond, bar) do { unsigned _sp = 0; while (cond) { __builtin_amdgcn_s_sleep(1); \
    if ((++_sp & 255u) == 0u) { if (xb_ld(&(bar)[XB_TMO])) break; if (_sp > XB_SPIN_CAP) { atomicAdd(&(bar)[XB_TMO], 1u); break; } } } } while (0)

struct XcdBarrier {
    unsigned* bar; unsigned x;
    volatile LAS unsigned* st;
};

__device__ __forceinline__ XcdBarrier xcd_barrier_post(unsigned* bar, volatile LAS unsigned* st) {
    XcdBarrier b; b.bar = bar; b.x = xb_xcc_id(); b.st = st;
    if (threadIdx.x == 0) (void)xb_add(&bar[XB_XCNT(b.x)], 1u);
    return b;
}
__device__ __forceinline__ void xcd_barrier_complete(unsigned* bar, unsigned x, unsigned& nloc, unsigned& nx) {
    const unsigned G = gridDim.x * gridDim.y * gridDim.z;
    unsigned sum, cnt, mine, sp = 0u;
    for (;;) {
        sum = 0u; cnt = 0u; mine = 0u;
#pragma unroll
        for (unsigned j = 0; j < 16; ++j) { const unsigned c = xb_ld(&bar[XB_XCNT(j)]); sum += c; cnt += (c > 0u) ? 1u : 0u; mine = (j == x) ? c : mine; }
        if (sum == G) break;
        __builtin_amdgcn_s_sleep(1);
        if ((++sp & 255u) == 0u) { if (xb_ld(&bar[XB_TMO])) break; if (sp > XB_SPIN_CAP) { atomicAdd(&bar[XB_TMO], 1u); break; } }
    }
    nloc = mine > 0u ? mine : 1u; nx = cnt > 0u ? cnt : 1u;
}

__device__ __forceinline__ void xcd_barrier(const XcdBarrier& b) {
    asm volatile("s_waitcnt vmcnt(0)" ::: "memory");
    __syncthreads();
    if (threadIdx.x == 0) {
        unsigned* bar = b.bar;
        __builtin_amdgcn_s_waitcnt(0);
        unsigned nloc = b.st[0], nx = b.st[1];
        if (nloc == 0u) { xcd_barrier_complete(bar, b.x, nloc, nx); b.st[0] = nloc; b.st[1] = nx; }
        const unsigned old = xb_add(&bar[XB_XSUB(b.x)], 1u);
        const unsigned gen = old / nloc;
        if (old + 1u == (gen + 1u) * nloc) {
            __builtin_amdgcn_fence(__ATOMIC_RELEASE, "agent");
            asm volatile("s_waitcnt vmcnt(0)" ::: "memory");
            const unsigned og = xb_add(&bar[XB_TOP], 1u);
            const unsigned tg = og / nx;
            if (og + 1u == (tg + 1u) * nx) xb_add(&bar[XB_TOPGEN], 1u);
            else XB_SPIN(xb_ld(&bar[XB_TOPGEN]) == tg, bar);
            __builtin_amdgcn_fence(__ATOMIC_ACQUIRE, "agent");
            xb_add(&bar[XB_XGEN(b.x)], 1u);
            asm volatile("s_waitcnt vmcnt(0)" ::: "memory");
        } else {
            XB_SPIN(xb_ld(&bar[XB_XGEN(b.x)]) == gen, bar);
            __builtin_amdgcn_fence(__ATOMIC_ACQUIRE, "agent");
            asm volatile("s_waitcnt vmcnt(0)" ::: "memory");
        }
    }
    __syncthreads();
}
constexpr int NWAVES = 8;
constexpr int DM = 1024, SEQ = 4096, NB = 8, NSB = 128, NST = 8, FF = 4096;
constexpr int MP = NB * SEQ;
constexpr int MS = NSB * NST;
constexpr int M = MP + MS;
constexpr int N_IN0 = 2304, N_IN1 = 2048;
constexpr float LN_EPS = 1e-5f;
constexpr float ALPHA = 1.4142135623730951f;
constexpr float LOG2E = 1.4426950408889634f;
constexpr float QS = 0.125f * LOG2E;
constexpr int NA_HIST = 128, ND_HIST = 2048;

constexpr size_t O_Y = 0, O_AKP = 34603008, O_AVP = 34734080, O_BCP = 34865152, O_CPP = 34873344, O_DKP = 34934784, O_DVP = 43323392,
                 O_AKS = 51712000, O_AVS = 53809152, O_BCS = 55906304, O_CPS = 56037376, O_DKS = 57020416, O_DVS = 191238144, O_TOTAL = 325455872;

constexpr size_t MiB = 1u << 20;
constexpr size_t WS_CTL = 0, CTL_ZERO_BYTES = 1 * MiB;
constexpr size_t WS_WIN0 = 2 * MiB, WS_WOUT0 = 8 * MiB, WS_W1_0 = 10 * MiB, WS_W2_0 = 18 * MiB, WS_WIN1 = 26 * MiB, WS_WOUT1 = 30 * MiB, WS_W1_1 = 32 * MiB, WS_W2_1 = 40 * MiB;
constexpr size_t WS_VEC = 48 * MiB;
constexpr int V_BIN0 = 0, V_CS1_0 = 4096, V_BW1_0 = 8192, V_CSIN1 = 12288, V_BWIN1 = 16384, V_CS1_1 = 20480, V_BW1_1 = 24576;
constexpr size_t WS_STA = 49 * MiB, WS_STB = 51 * MiB;
constexpr size_t WS_XB = 64 * MiB;
constexpr size_t WS_Q = 130 * MiB, WS_K = 163 * MiB, WS_V = 196 * MiB, WS_C = 229 * MiB, WS_GB = 262 * MiB;
constexpr size_t WS_MIX = 295 * MiB;
constexpr size_t WS_ZH0 = 361 * MiB, WS_ZH1 = 493 * MiB;
constexpr size_t WS_ZB = 559 * MiB;
constexpr size_t WS_H = 691 * MiB;
constexpr size_t WS_STO = 955 * MiB;
constexpr size_t WS_STML = 1021 * MiB;
constexpr size_t WS_END = 1024 * MiB;
constexpr int CW_BAR = 4096;

constexpr int RING_BYTES = 131072;
constexpr int LDSCTL_OFF = RING_BYTES, MISC_OFF = LDSCTL_OFF + 320;
constexpr int EPI_P_OFF = RING_BYTES + 1024;
constexpr int EPI_S_OFF = EPI_P_OFF + 8192;
constexpr int EPI_R_OFF = EPI_S_OFF + 2048;
constexpr int EPI_V_OFF = EPI_R_OFF + 8192;
constexpr int LDS_BYTES = 154624;
static_assert(EPI_V_OFF + 4096 <= LDS_BYTES && LDS_BYTES <= 163840, "LDS map");

typedef float f32x2v __attribute__((ext_vector_type(2)));
typedef unsigned u32x2v __attribute__((ext_vector_type(2)));
using pg8::bf16_t; using pg8::Unit; using pg8::u32x4;
#define EPI_BAR() do { asm volatile("s_waitcnt lgkmcnt(0)" ::: "memory"); __builtin_amdgcn_s_barrier(); asm volatile("" ::: "memory"); } while (0)

__device__ __forceinline__ u32x4 pack8(const f32x4 a, const f32x4 b) { u32x4 w; w.x = pg8::cvt_pk_bf16(a[0], a[1]); w.y = pg8::cvt_pk_bf16(a[2], a[3]); w.z = pg8::cvt_pk_bf16(b[0], b[1]); w.w = pg8::cvt_pk_bf16(b[2], b[3]); return w; }
__device__ __forceinline__ float bf2f(unsigned short h) { return __builtin_bit_cast(float, (unsigned)h << 16); }
__device__ __forceinline__ float bflo(unsigned w) { return __builtin_bit_cast(float, w << 16); }
__device__ __forceinline__ float bfhi(unsigned w) { return __builtin_bit_cast(float, w & 0xffff0000u); }

__device__ __forceinline__ void swap32(float& a, float& b) { asm volatile("s_nop 1\n\tv_permlane32_swap_b32 %0, %1\n\ts_nop 1" : "+v"(a), "+v"(b)); }
__device__ __forceinline__ void swap32(unsigned& a, unsigned& b) { asm volatile("s_nop 1\n\tv_permlane32_swap_b32 %0, %1\n\ts_nop 1" : "+v"(a), "+v"(b)); }
__device__ __forceinline__ void swap16(float& a, float& b) { asm volatile("s_nop 1\n\tv_permlane16_swap_b32 %0, %1\n\ts_nop 1" : "+v"(a), "+v"(b)); }
__device__ __forceinline__ float rows16_sum(float v) { float a = v, b = v; swap16(a, b); const float s2 = a + b; a = s2; b = s2; swap32(a, b); return a + b; }
__device__ __forceinline__ void epi_dma1k(const void* g, LAS unsigned char* l, int lane) { __builtin_amdgcn_global_load_lds((const unsigned*)((const char*)g + lane * 16), (LAS unsigned*)l, 16, 0, 0); }
__device__ __forceinline__ void epi_pre_slots(const float* slots, int pm, LAS unsigned char* lds, int wid, int lane) {
    const char* src = (const char*)(slots + (size_t)pm * 256 * 8); const int c = 2 * (wid - 4);
    epi_dma1k(src + c * 1024, lds + EPI_R_OFF + c * 1024, lane); epi_dma1k(src + (c + 1) * 1024, lds + EPI_R_OFF + (c + 1) * 1024, lane);
}
__device__ __forceinline__ void epi_pre_vec(const float* v, int col0, int slot, LAS unsigned char* lds, int lane) { epi_dma1k(v + col0, lds + EPI_V_OFF + slot * 1024, lane); }
__device__ __forceinline__ void epi_stats_lds(LAS unsigned char* lds, int tid) {
    LAS f32x2v* S = (LAS f32x2v*)(lds + EPI_S_OFF);
    if (tid < 256) {
        const LAS f32x4* sp = (const LAS f32x4*)(lds + EPI_R_OFF + tid * 32);
        const f32x4 a = sp[0], b = sp[1];
        const float mean = ((a[0] + a[2]) + (b[0] + b[2])) * 0.25f;
        const float d0 = a[0] - mean, d1 = a[2] - mean, d2 = b[0] - mean, d3 = b[2] - mean;
        const float q = ((a[1] + a[3]) + (b[1] + b[3])) + 256.0f * ((d0 * d0 + d1 * d1) + (d2 * d2 + d3 * d3));
        S[tid] = (f32x2v){mean, 1.0f / sqrtf(q * (1.0f / 1024.0f) + LN_EPS)};
    }
    EPI_BAR();
}
__device__ __forceinline__ void epi_load_stats(const float* slots, int pm, LAS unsigned char* lds, int tid) {
    LAS f32x2v* S = (LAS f32x2v*)(lds + EPI_S_OFF);
    if (tid < 256) {
        const f32x4* sp = (const f32x4*)(slots + (size_t)(pm * 256 + tid) * 8);
        const f32x4 a = sp[0], b = sp[1];
        const float mean = ((a[0] + a[2]) + (b[0] + b[2])) * 0.25f;
        const float d0 = a[0] - mean, d1 = a[2] - mean, d2 = b[0] - mean, d3 = b[2] - mean;
        const float q = ((a[1] + a[3]) + (b[1] + b[3])) + 256.0f * ((d0 * d0 + d1 * d1) + (d2 * d2 + d3 * d3));
        S[tid] = (f32x2v){mean, 1.0f / sqrtf(q * (1.0f / 1024.0f) + LN_EPS)};
    }
    EPI_BAR();
}
__device__ __forceinline__ void epi_row_stats(const f32x4 (&z)[2][2], LAS unsigned char* lds, int rl, int wc, int fq) {
    float s = 0.f;
#pragma unroll
    for (int bj = 0; bj < 2; ++bj)
#pragma unroll
        for (int n = 0; n < 2; ++n) s += (z[bj][n][0] + z[bj][n][1]) + (z[bj][n][2] + z[bj][n][3]);
    s = rows16_sum(s);
    const float mw = s * (1.0f / 64.0f); float q = 0.f;
#pragma unroll
    for (int bj = 0; bj < 2; ++bj)
#pragma unroll
        for (int n = 0; n < 2; ++n) { const f32x4 d = z[bj][n] - mw; q += (d[0] * d[0] + d[1] * d[1]) + (d[2] * d[2] + d[3] * d[3]); }
    q = rows16_sum(q);
    if (fq == 0) ((LAS f32x2v*)(lds + EPI_P_OFF))[rl * 4 + wc] = (f32x2v){mw, q};
}
__device__ __forceinline__ void epi_store_stats(float* slots, int pm, int pn, LAS unsigned char* lds, int tid) {
    if (tid < 256) {
        const LAS f32x2v* P = (const LAS f32x2v*)(lds + EPI_P_OFF) + tid * 4;
        const f32x2v a = P[0], b = P[1], c = P[2], d = P[3];
        const float mt = ((a.x + b.x) + (c.x + d.x)) * 0.25f;
        const float da = a.x - mt, db = b.x - mt, dc = c.x - mt, dd = d.x - mt;
        const float m2 = ((a.y + b.y) + (c.y + d.y)) + 64.0f * ((da * da + db * db) + (dc * dc + dd * dd));
        *(f32x2v*)(slots + (size_t)(pm * 256 + tid) * 8 + pn * 2) = (f32x2v){mt, m2};
    }
}


struct EpiIn0 {
    static constexpr bool PERM = true, AFTER_DRAIN = false;
    bf16_t *Q, *K, *V, *C, *GB; const float* bias; float* out;
    __device__ __forceinline__ void pre(const Unit&, int, int) const {}
    __device__ __forceinline__ void operator()(const f32x4 (&acc)[2][2][4][2], const Unit& u, int wr, int wc, int fr_in, int fq_in) const {
        int fr = fr_in, fq = fq_in; asm volatile("" : "+v"(fr), "+v"(fq));
        const int pn = u.pn, cc0 = wc * 32 + 8 * fq;
        f32x4 bv[2][2];
#pragma unroll
        for (int bj = 0; bj < 2; ++bj)
#pragma unroll
            for (int n = 0; n < 2; ++n) bv[bj][n] = *(const f32x4*)(bias + pn * 256 + bj * 128 + cc0 + 4 * n);
#pragma unroll
        for (int ai = 0; ai < 2; ++ai)
#pragma unroll
            for (int m = 0; m < 4; ++m) {
                const int row = u.pm * 256 + ai * 128 + wr * 64 + m * 16 + fr;
                f32x4 v[2][2];
#pragma unroll
                for (int bj = 0; bj < 2; ++bj)
#pragma unroll
                    for (int n = 0; n < 2; ++n) v[bj][n] = acc[ai][bj][m][n] + bv[bj][n];
                if (pn < 2) {
#pragma unroll
                    for (int bj = 0; bj < 2; ++bj) *(u32x4*)(Q + (size_t)row * 512 + pn * 256 + bj * 128 + cc0) = pack8(v[bj][0] * QS, v[bj][1] * QS);
                } else if (pn == 2) {
                    *(u32x4*)(K + (size_t)row * 128 + cc0) = pack8(v[0][0], v[0][1]);
                    *(u32x4*)(V + (size_t)row * 128 + cc0) = pack8(v[1][0], v[1][1]);
                    long o = -1;
                    if (row >= MP) { const int s = row - MP; o = (long)((s >> 3) * 128 + 120 + (s & 7)) * 128 + (long)(O_AKS - O_AKP); }
                    else { const int t = row & (SEQ - 1); if (t >= SEQ - 128) o = (long)((row >> 12) * 128 + t - (SEQ - 128)) * 128; }
                    if (o >= 0) {
                        float* ok = out + O_AKP + o + cc0; float* ov = ok + (row >= MP ? (O_AVS - O_AKS) : (O_AVP - O_AKP));
                        *(f32x4*)ok = v[0][0]; *(f32x4*)(ok + 4) = v[0][1]; *(f32x4*)ov = v[1][0]; *(f32x4*)(ov + 4) = v[1][1];
                    }
                } else if (pn < 7) {
                    const int p = pn - 3; const f32x4 c0 = v[0][0] * v[1][0], c1 = v[0][1] * v[1][1];
                    *(u32x4*)(C + (size_t)row * 512 + p * 128 + cc0) = pack8(c0, c1);
                    long o = -1;
                    if (row >= MP) { const int s = row - MP; if ((s & 7) >= 6) o = (long)((s >> 3) * 2 + (s & 7) - 6) * 512 + (long)(O_BCS - O_BCP); }
                    else { const int t = row & (SEQ - 1); if (t >= SEQ - 2) o = (long)((row >> 12) * 2 + t - (SEQ - 2)) * 512; }
                    if (o >= 0) { float* oc = out + O_BCP + o + p * 128 + cc0; *(f32x4*)oc = c0; *(f32x4*)(oc + 4) = c1; }
                } else {
#pragma unroll
                    for (int bj = 0; bj < 2; ++bj) *(u32x4*)(GB + (size_t)row * 512 + (pn - 7) * 256 + bj * 128 + cc0) = pack8(v[bj][0], v[bj][1]);
                }
            }
    }
};

struct EpiIn1 {
    static constexpr bool PERM = true, AFTER_DRAIN = false;
    bf16_t *U, *Q, *K, *V; const float *cs, *bw, *slots; float* out; LAS unsigned char* lds;
    __device__ __forceinline__ void pre(const Unit& u, int wid, int lane) const { epi_pre_slots(slots, u.pm, lds, wid, lane); if (wid == 4) epi_pre_vec(cs, u.pn * 256, 0, lds, lane); if (wid == 5) epi_pre_vec(bw, u.pn * 256, 1, lds, lane); }
    __device__ __forceinline__ void operator()(const f32x4 (&acc)[2][2][4][2], const Unit& u, int wr, int wc, int fr_in, int fq_in) const {
        int fr = fr_in, fq = fq_in; asm volatile("" : "+v"(fr), "+v"(fq));
        const int pn = u.pn, cc0 = wc * 32 + 8 * fq, tid = threadIdx.x;
        f32x4 cv[2][2], bv[2][2];
#pragma unroll
        for (int bj = 0; bj < 2; ++bj)
#pragma unroll
            for (int n = 0; n < 2; ++n) { cv[bj][n] = *(const LAS f32x4*)(lds + EPI_V_OFF + (bj * 128 + cc0 + 4 * n) * 4); bv[bj][n] = *(const LAS f32x4*)(lds + EPI_V_OFF + 1024 + (bj * 128 + cc0 + 4 * n) * 4); }
        epi_stats_lds(lds, tid);
        const LAS f32x2v* S = (const LAS f32x2v*)(lds + EPI_S_OFF);
        const int sel = pn >> 1; bf16_t* dst = sel == 0 ? U : sel == 1 ? Q : sel == 2 ? K : V;
        const float sc = sel == 1 ? QS : 1.0f;
        const size_t obase = sel == 0 ? O_CPP : sel == 2 ? O_DKP : O_DVP;
#pragma unroll
        for (int ai = 0; ai < 2; ++ai)
#pragma unroll
            for (int m = 0; m < 4; ++m) {
                const int rl = ai * 128 + wr * 64 + m * 16 + fr, row = u.pm * 256 + rl;
                const f32x2v st = S[rl];
                f32x4 v[2][2];
#pragma unroll
                for (int bj = 0; bj < 2; ++bj)
#pragma unroll
                    for (int n = 0; n < 2; ++n) v[bj][n] = (acc[ai][bj][m][n] - cv[bj][n] * st.x) * st.y + bv[bj][n];
                const int c512 = (pn & 1) * 256 + cc0;
#pragma unroll
                for (int bj = 0; bj < 2; ++bj) *(u32x4*)(dst + (size_t)row * 512 + c512 + bj * 128) = pack8(v[bj][0] * sc, v[bj][1] * sc);
                if (sel != 1) {
                    long o = -1;
                    if (sel == 0) {
                        if (row >= MP) { const int s = row - MP; o = (long)((s >> 3) * 15 + 7 + (s & 7)) * 512 + (long)(O_CPS - O_CPP); }
                        else { const int t = row & (SEQ - 1); if (t >= SEQ - 15) o = (long)((row >> 12) * 15 + t - (SEQ - 15)) * 512; }
                    } else {
                        if (row >= MP) { const int s = row - MP; o = (long)((s >> 3) * 2048 + 2040 + (s & 7)) * 512 + (sel == 2 ? (long)(O_DKS - O_DKP) : (long)(O_DVS - O_DVP)); }
                        else { const int t = row & (SEQ - 1); if (t >= SEQ - 2048) o = (long)((row >> 12) * 2048 + t - (SEQ - 2048)) * 512; }
                    }
                    if (o >= 0) {
                        float* op = out + obase + o + c512;
#pragma unroll
                        for (int bj = 0; bj < 2; ++bj) { *(f32x4*)(op + bj * 128) = v[bj][0]; *(f32x4*)(op + bj * 128 + 4) = v[bj][1]; }
                    }
                }
            }
    }
};

struct EpiMlp1 {
    static constexpr bool PERM = true, AFTER_DRAIN = false;
    bf16_t* H; const float *cs, *bw, *slots; LAS unsigned char* lds;
    __device__ __forceinline__ void pre(const Unit& u, int wid, int lane) const { epi_pre_slots(slots, u.pm, lds, wid, lane); if (wid == 4) epi_pre_vec(cs, u.pn * 256, 0, lds, lane); if (wid == 5) epi_pre_vec(bw, u.pn * 256, 1, lds, lane); }
    __device__ __forceinline__ void operator()(const f32x4 (&acc)[2][2][4][2], const Unit& u, int wr, int wc, int fr_in, int fq_in) const {
        int fr = fr_in, fq = fq_in; asm volatile("" : "+v"(fr), "+v"(fq));
        const int cc0 = u.pn * 256 + wc * 32 + 8 * fq, tid = threadIdx.x;
        f32x4 cv[2][2], bv[2][2];
        { const int cl = wc * 32 + 8 * fq;
#pragma unroll
        for (int bj = 0; bj < 2; ++bj)
#pragma unroll
            for (int n = 0; n < 2; ++n) { cv[bj][n] = *(const LAS f32x4*)(lds + EPI_V_OFF + (bj * 128 + cl + 4 * n) * 4); bv[bj][n] = *(const LAS f32x4*)(lds + EPI_V_OFF + 1024 + (bj * 128 + cl + 4 * n) * 4); } }
        epi_stats_lds(lds, tid);
        const LAS f32x2v* S = (const LAS f32x2v*)(lds + EPI_S_OFF);
#pragma unroll
        for (int ai = 0; ai < 2; ++ai)
#pragma unroll
            for (int m = 0; m < 4; ++m) {
                const int rl = ai * 128 + wr * 64 + m * 16 + fr, row = u.pm * 256 + rl;
                const f32x2v st = S[rl];
#pragma unroll
                for (int bj = 0; bj < 2; ++bj) {
                    f32x4 v0 = (acc[ai][bj][m][0] - cv[bj][0] * st.x) * st.y + bv[bj][0], v1 = (acc[ai][bj][m][1] - cv[bj][1] * st.x) * st.y + bv[bj][1];
#pragma unroll
                    for (int e = 0; e < 4; ++e) { const float a = fmaxf(v0[e], 0.f), b = fmaxf(v1[e], 0.f); v0[e] = a * a; v1[e] = b * b; }
                    *(u32x4*)(H + (size_t)row * FF + cc0 + bj * 128) = pack8(v0, v1);
                }
            }
    }
};

template <bool LNRES, bool HAS_BIAS, bool F32OUT>
struct EpiRes {
    static constexpr bool PERM = true, AFTER_DRAIN = false;
    const bf16_t* rprev;
    const float *sprev, *g, *b;
    const float* bias; float* zout; bf16_t* zb; float* sout; LAS unsigned char* lds;
    __device__ __forceinline__ void pre(const Unit& u, int wid, int lane) const {
        if (LNRES) { epi_pre_slots(sprev, u.pm, lds, wid, lane); if (wid == 4) epi_pre_vec(g, u.pn * 256, 0, lds, lane); if (wid == 5) epi_pre_vec(b, u.pn * 256, 1, lds, lane); }
        if (HAS_BIAS && wid == 6) epi_pre_vec(bias, u.pn * 256, 2, lds, lane);
    }
    __device__ __forceinline__ void operator()(const f32x4 (&acc)[2][2][4][2], const Unit& u, int wr, int wc, int fr_in, int fq_in) const {
        int fr = fr_in, fq = fq_in; asm volatile("" : "+v"(fr), "+v"(fq));
        const int col0 = u.pn * 256 + wc * 32 + 8 * fq, tid = threadIdx.x;
        const size_t prow = (size_t)u.pm * 256;
        f32x4 gv[2][2], bv[2][2];
#pragma unroll
        for (int bj = 0; bj < 2; ++bj)
#pragma unroll
            for (int n = 0; n < 2; ++n) {
                const int cb = (bj * 128 + wc * 32 + 8 * fq + 4 * n) * 4;
                const f32x4 biv = HAS_BIAS ? *(const LAS f32x4*)(lds + EPI_V_OFF + 2048 + cb) : (f32x4){0.f, 0.f, 0.f, 0.f};
                if (LNRES) { gv[bj][n] = *(const LAS f32x4*)(lds + EPI_V_OFF + cb) * ALPHA; bv[bj][n] = *(const LAS f32x4*)(lds + EPI_V_OFF + 1024 + cb) * ALPHA + biv; }
                else { gv[bj][n] = (f32x4){ALPHA, ALPHA, ALPHA, ALPHA}; bv[bj][n] = biv; }
            }
        if (LNRES) epi_stats_lds(lds, tid);
        const LAS f32x2v* S = (const LAS f32x2v*)(lds + EPI_S_OFF);
#pragma unroll
        for (int ai = 0; ai < 2; ++ai) {
            u32x4 rw[4][2];
#pragma unroll
            for (int m = 0; m < 4; ++m)
#pragma unroll
                for (int bj = 0; bj < 2; ++bj) rw[m][bj] = *(const u32x4*)(rprev + (prow + ai * 128 + wr * 64 + m * 16 + fr) * DM + col0 + bj * 128);
#pragma unroll
            for (int m = 0; m < 4; ++m) {
                const int rl = ai * 128 + wr * 64 + m * 16 + fr; const size_t row = prow + rl;
                f32x2v st = (f32x2v){0.f, 1.f}; if (LNRES) st = S[rl];
                f32x4 z[2][2];
#pragma unroll
                for (int bj = 0; bj < 2; ++bj) {
                    const u32x4 w = rw[m][bj];
                    const f32x4 x0 = (f32x4){bflo(w.x), bfhi(w.x), bflo(w.y), bfhi(w.y)}, x1 = (f32x4){bflo(w.z), bfhi(w.z), bflo(w.w), bfhi(w.w)};
                    z[bj][0] = acc[ai][bj][m][0] + ((x0 - st.x) * st.y) * gv[bj][0] + bv[bj][0];
                    z[bj][1] = acc[ai][bj][m][1] + ((x1 - st.x) * st.y) * gv[bj][1] + bv[bj][1];
                }
#pragma unroll
                for (int bj = 0; bj < 2; ++bj) {
                    if (F32OUT) { float* zo = zout + row * DM + col0 + bj * 128; *(f32x4*)zo = z[bj][0]; *(f32x4*)(zo + 4) = z[bj][1]; }
                    else *(u32x4*)(zb + row * DM + col0 + bj * 128) = pack8(z[bj][0], z[bj][1]);
                }
                epi_row_stats(z, lds, rl, wc, fq);
            }
            asm volatile("" ::: "memory");
        }
        EPI_BAR();
        epi_store_stats(sout, u.pm, u.pn, lds, tid);
    }
};

constexpr int CW_PANEL = 16384;
struct EpiResFinal {
    static constexpr bool PERM = true, AFTER_DRAIN = false;
    const bf16_t* rprev; const float *sprev, *g, *b, *g2, *b2; float* out; float* xslots; gu32* ctl; LAS unsigned char* lds;
    __device__ __forceinline__ void pre(const Unit& u, int wid, int lane) const {
        epi_pre_slots(sprev, u.pm, lds, wid, lane);
        epi_pre_vec(wid == 4 ? g : wid == 5 ? b : wid == 6 ? g2 : b2, u.pn * 256, wid - 4, lds, lane);
    }
    __device__ __forceinline__ void operator()(const f32x4 (&acc_in)[2][2][4][2], const Unit& u, int wr, int wc, int fr_in, int fq_in) const {
        f32x4 (&acc)[2][2][4][2] = const_cast<f32x4 (&)[2][2][4][2]>(acc_in);
        int fr = fr_in, fq = fq_in; asm volatile("" : "+v"(fr), "+v"(fq));
        const int col0 = u.pn * 256 + wc * 32 + 8 * fq, tid = threadIdx.x;
        const size_t prow = (size_t)u.pm * 256;
        const int cb0 = (wc * 32 + 8 * fq) * 4;
        epi_stats_lds(lds, tid);
        const LAS f32x2v* S = (const LAS f32x2v*)(lds + EPI_S_OFF);
        {
            f32x4 gv[2][2], bv[2][2];
#pragma unroll
            for (int bj = 0; bj < 2; ++bj)
#pragma unroll
                for (int n = 0; n < 2; ++n) { const int cb = cb0 + (bj * 128 + 4 * n) * 4; gv[bj][n] = *(const LAS f32x4*)(lds + EPI_V_OFF + cb) * ALPHA; bv[bj][n] = *(const LAS f32x4*)(lds + EPI_V_OFF + 1024 + cb) * ALPHA; }
#pragma unroll
            for (int ai = 0; ai < 2; ++ai) {
                u32x4 rw[4][2];
#pragma unroll
                for (int m = 0; m < 4; ++m)
#pragma unroll
                    for (int bj = 0; bj < 2; ++bj) rw[m][bj] = *(const u32x4*)(rprev + (prow + ai * 128 + wr * 64 + m * 16 + fr) * DM + col0 + bj * 128);
#pragma unroll
                for (int m = 0; m < 4; ++m) {
                    const int rl = ai * 128 + wr * 64 + m * 16 + fr; const f32x2v st = S[rl];
                    f32x4 z[2][2];
#pragma unroll
                    for (int bj = 0; bj < 2; ++bj) {
                        const u32x4 w = rw[m][bj];
                        const f32x4 x0 = (f32x4){bflo(w.x), bfhi(w.x), bflo(w.y), bfhi(w.y)}, x1 = (f32x4){bflo(w.z), bfhi(w.z), bflo(w.w), bfhi(w.w)};
                        z[bj][0] = acc[ai][bj][m][0] + ((x0 - st.x) * st.y) * gv[bj][0] + bv[bj][0];
                        z[bj][1] = acc[ai][bj][m][1] + ((x1 - st.x) * st.y) * gv[bj][1] + bv[bj][1];
                        acc[ai][bj][m][0] = z[bj][0]; acc[ai][bj][m][1] = z[bj][1];
                    }
                    epi_row_stats(z, lds, rl, wc, fq);
                }
                asm volatile("" ::: "memory");
            }
        }
        EPI_BAR();
        if (tid < 256) {
            const LAS f32x2v* P = (const LAS f32x2v*)(lds + EPI_P_OFF) + tid * 4;
            const f32x2v a = P[0], b2_ = P[1], c = P[2], d = P[3];
            const float mt = ((a.x + b2_.x) + (c.x + d.x)) * 0.25f;
            const float da = a.x - mt, db = b2_.x - mt, dc = c.x - mt, dd = d.x - mt;
            const float m2 = ((a.y + b2_.y) + (c.y + d.y)) + 64.0f * ((da * da + db * db) + (dc * dc + dd * dd));
            unsigned long long* slot = (unsigned long long*)(xslots + (prow + tid) * 8 + u.pn * 2);
            __hip_atomic_store(slot, ((unsigned long long)__builtin_bit_cast(unsigned, m2) << 32) | __builtin_bit_cast(unsigned, mt), __ATOMIC_RELAXED, __HIP_MEMORY_SCOPE_AGENT);
        }
        asm volatile("s_waitcnt vmcnt(0)" ::: "memory");
        EPI_BAR();
        if (tid == 0) {
            gu32* cnt = ctl + CW_PANEL + 64 * u.pm;
            __hip_atomic_fetch_add(cnt, 1u, RLX_AGENT);
            unsigned sp = 0;
            while (__hip_atomic_load(cnt, RLX_AGENT) < 4u) { __builtin_amdgcn_s_sleep(1); if (++sp > XB_SPIN_CAP) { atomicAdd((unsigned*)(ctl + CW_BAR) + XB_TMO, 1u); break; } }
            __builtin_amdgcn_fence(__ATOMIC_ACQUIRE, "agent");
            asm volatile("s_waitcnt vmcnt(0)" ::: "memory");
        }
        EPI_BAR();
        if (tid < 256) {
            const unsigned long long* slot = (const unsigned long long*)(xslots + (prow + tid) * 8); float mt[4], m2[4];
#pragma unroll
            for (int t = 0; t < 4; ++t) { const unsigned long long w = __hip_atomic_load(slot + t, __ATOMIC_RELAXED, __HIP_MEMORY_SCOPE_AGENT); mt[t] = __builtin_bit_cast(float, (unsigned)w); m2[t] = __builtin_bit_cast(float, (unsigned)(w >> 32)); }
            const float mean = ((mt[0] + mt[1]) + (mt[2] + mt[3])) * 0.25f;
            float q = 0.f;
#pragma unroll
            for (int t = 0; t < 4; ++t) { const float dm = mt[t] - mean; q += m2[t] + 256.0f * dm * dm; }
            ((LAS f32x2v*)(lds + EPI_S_OFF))[tid] = (f32x2v){mean, 1.0f / sqrtf(q * (1.0f / 1024.0f) + LN_EPS)};
        }
        EPI_BAR();
#pragma unroll
        for (int ai = 0; ai < 2; ++ai)
#pragma unroll
            for (int m = 0; m < 4; ++m) {
                const int rl = ai * 128 + wr * 64 + m * 16 + fr; const f32x2v st = S[rl]; float* yo = out + (prow + rl) * DM + col0;
#pragma unroll
                for (int bj = 0; bj < 2; ++bj)
#pragma unroll
                    for (int n = 0; n < 2; ++n) { const int cb = cb0 + (bj * 128 + 4 * n) * 4;
                        *(f32x4*)(yo + bj * 128 + 4 * n) = ((acc[ai][bj][m][n] - st.x) * st.y) * *(const LAS f32x4*)(lds + EPI_V_OFF + 2048 + cb) + *(const LAS f32x4*)(lds + EPI_V_OFF + 3072 + cb); }
            }
    }
};
struct Args { const float* in[26]; float* out; unsigned char* ws; };
struct Frame {
    LAS unsigned char* lds; gu32* ctl; int tid, lane, wave, vcu, G, gw, NGW, vcu_lt240;
};
__device__ __forceinline__ float wave_sum(float v) {
#pragma unroll
    for (int o = 1; o < 64; o <<= 1) v += __shfl_xor(v, o);
    return v;
}
__device__ __forceinline__ float wave_max(float v) {
#pragma unroll
    for (int o = 1; o < 64; o <<= 1) v = fmaxf(v, __shfl_xor(v, o));
    return v;
}

__device__ __forceinline__ void transpose_tile(const float* W, int ldw, int n0, int k0, const float* gk, bf16_t* WT, int ldt, int drow0, int kdst0, LAS float* scr, int lane) {
    {
        float wv[32];
#pragma unroll
        for (int i = 0; i < 32; ++i) { const int kk = 2 * i + (lane >> 5); wv[i] = W[(size_t)(k0 + kk) * ldw + n0 + (lane & 31)]; }
#pragma unroll
        for (int i = 0; i < 32; ++i) { const int kk = 2 * i + (lane >> 5); float w = wv[i]; if (gk) w *= gk[k0 + kk]; scr[kk * 33 + (lane & 31)] = w; }
    }
    LDS_WAIT(); asm volatile("" ::: "memory");
    const int c = lane & 7;
#pragma unroll
    for (int j = 0; j < 4; ++j) { const int n = (lane >> 3) + 8 * j; const LAS float* s = scr + (8 * c) * 33 + n;
        v4u o; o.x = pk2(s[0 * 33], s[1 * 33]); o.y = pk2(s[2 * 33], s[3 * 33]); o.z = pk2(s[4 * 33], s[5 * 33]); o.w = pk2(s[6 * 33], s[7 * 33]);
        *(GAS v4u*)(WT + (size_t)(drow0 + n) * ldt + kdst0 + k0 + 8 * c) = o; }
    LDS_WAIT(); asm volatile("" ::: "memory");
}
__device__ __forceinline__ int in0_src_col(int np) {
    if (np < 768) return np;
    if (np < 1792) { const int tt = np - 768, p = tt >> 8, w = tt & 255; return w < 128 ? 768 + 128 * p + w : 1792 + 128 * p + (w - 128); }
    return 1280 + (np - 1792);
}
__device__ __forceinline__ void colsum_item(const float* W, int K, int N, const float* g, const float* b, const float* bias, float* cs, float* bw, int item, int lane) {
    const int n = item * 16 + (lane & 15), kq = lane >> 4, kn = K / 4;
    float a = 0.f, c = 0.f;
    for (int k0 = kq * kn; k0 < (kq + 1) * kn; k0 += 32) {
        float w[32], gg[32], bb[32];
#pragma unroll
        for (int u = 0; u < 32; ++u) { w[u] = W[(size_t)(k0 + u) * N + n]; gg[u] = g[k0 + u]; bb[u] = b[k0 + u]; }
#pragma unroll
        for (int u = 0; u < 32; ++u) { a += __builtin_bit_cast(float, f2bf(gg[u] * w[u]) << 16); c += bb[u] * w[u]; }
    }
    a += __shfl_xor(a, 16); a += __shfl_xor(a, 32); c += __shfl_xor(c, 16); c += __shfl_xor(c, 32);
    if (lane < 16) { cs[n] = a; bw[n] = c + (bias ? bias[n] : 0.f); }
}
__device__ __forceinline__ void poolfold_item(const float* Wg, const float* scale, const float* Wo, bf16_t* WT, int item, int lane) {
    const int nb = item & 15, ib = (item >> 4) & 15, g = item >> 8, n = nb * 64 + lane, i0 = ib * 8;
    float acc[8];
#pragma unroll
    for (int ii = 0; ii < 8; ++ii) acc[ii] = 0.f;
    const float* wg = Wg + (size_t)g * 128 * 128 + (size_t)i0 * 128;
    for (int j0 = 0; j0 < 128; j0 += 16) {
        float w[16], wgv[8][16];
#pragma unroll
        for (int u = 0; u < 16; ++u) { w[u] = scale[128 * g + j0 + u] * Wo[(size_t)(128 * g + j0 + u) * DM + n];
#pragma unroll
            for (int ii = 0; ii < 8; ++ii) wgv[ii][u] = wg[ii * 128 + j0 + u]; }
#pragma unroll
        for (int u = 0; u < 16; ++u)
#pragma unroll
            for (int ii = 0; ii < 8; ++ii) acc[ii] += wgv[ii][u] * w[u];
    }
    v4u o; o.x = pk2(acc[0], acc[1]); o.y = pk2(acc[2], acc[3]); o.z = pk2(acc[4], acc[5]); o.w = pk2(acc[6], acc[7]);
    *(GAS v4u*)(WT + (size_t)n * DM + 128 * g + i0) = o;
}
constexpr int CW_COPY_HEAD = 8192, CW_DONE0 = 8256;
constexpr unsigned U_A = 120, U_C = 28, U_DB = NSB * 24, NUNIT = 2 * U_A + U_C + 2 * U_DB;
template <int NT, int NB>
__device__ __forceinline__ void copy_dblock_unit(const float* src, float* dst, unsigned idx, int t) {
    const unsigned b = idx / 24u, q = idx - b * 24u;
    const GAS f32x4* s = (const GAS f32x4*)src + (size_t)b * ND_HIST * 128; GAS f32x4* d = (GAS f32x4*)dst + (size_t)b * ND_HIST * 128;
    constexpr int NPER = 4096 / NT;
#pragma unroll 1
    for (int h = 0; h < NPER; h += NB) {
        f32x4 v[NB]; size_t di[NB];
#pragma unroll
        for (int k = 0; k < NB; ++k) { const unsigned p = (unsigned)(h + k) * (unsigned)NT + (unsigned)t, blk = p >> 10, w = p & 1023u; di[k] = (size_t)(16u * (4u * q + blk)) * 128 + w; v[k] = __builtin_nontemporal_load(s + di[k] + 8 * 128); }
#pragma unroll
        for (int k = 0; k < NB; ++k) __builtin_nontemporal_store(v[k], d + di[k]);
    }
}
template <int BP, int SKIP, int NT, int NB  >
__device__ __forceinline__ void copy_unit(const float* src, float* dst, unsigned unit, int t) {
    const GAS f32x4* s = (const GAS f32x4*)src; GAS f32x4* d = (GAS f32x4*)dst;
    constexpr unsigned PER = BP - SKIP; constexpr int NPER = 4096 / NT;
#pragma unroll 1
    for (int h = 0; h < NPER; h += NB) {
        f32x4 v[NB]; size_t di[NB];
#pragma unroll
        for (int k = 0; k < NB; ++k) { const unsigned i = unit * 4096u + (unsigned)(h + k) * (unsigned)NT + (unsigned)t, b = i / PER, r = i - b * PER; di[k] = (size_t)b * BP + r; v[k] = __builtin_nontemporal_load(s + di[k] + SKIP); }
#pragma unroll
        for (int k = 0; k < NB; ++k) __builtin_nontemporal_store(v[k], d + di[k]);
    }
}
template <int NT, int NB>
__device__ __forceinline__ void copy_unit_any(const Args& A, unsigned c, int t) {
    if (c < U_A) copy_unit<NA_HIST * 32, NST * 32, NT, NB>(A.in[2], A.out + O_AKS, c, t);
    else if (c < 2 * U_A) copy_unit<NA_HIST * 32, NST * 32, NT, NB>(A.in[3], A.out + O_AVS, c - U_A, t);
    else if (c < 2 * U_A + U_C) copy_unit<15 * 128, NST * 128, NT, NB>(A.in[5], A.out + O_CPS, c - 2 * U_A, t);
    else if (c < 2 * U_A + U_C + U_DB) copy_dblock_unit<NT, NB>(A.in[6], A.out + O_DKS, c - (2 * U_A + U_C), t);
    else copy_dblock_unit<NT, NB>(A.in[7], A.out + O_DVS, c - (2 * U_A + U_C + U_DB), t);
}
__device__ __forceinline__ void steal_copy(const Frame& F, const Args& A, int phase, bool until_empty) {
    volatile LAS unsigned* slot = (volatile LAS unsigned*)(F.lds + MISC_OFF) + 12;
    gu32* head = F.ctl + CW_COPY_HEAD; gu32* done = F.ctl + CW_DONE0 + 64 * phase;
    if (F.tid == 0 && !until_empty) __hip_atomic_fetch_add(done, 1u, RLX_AGENT);
    for (;;) {
        if (F.tid == 0) {
            unsigned c = NUNIT;
            if (until_empty || __hip_atomic_load(done, RLX_AGENT) < (unsigned)F.G) c = __hip_atomic_fetch_add(head, 4u, RLX_AGENT);
            *slot = c;
        }
        __syncthreads();
        const unsigned c = *slot;
        __syncthreads();
        if (c >= NUNIT) break;
#pragma unroll 1
        for (unsigned u = c; u < c + 4 && u < NUNIT; ++u) copy_unit_any<512, 8>(A, u, F.tid);
    }
}
__device__ __forceinline__ void stagger_copy(const Frame& F, const Args& A, int nclaim) {
    volatile LAS unsigned* slot = (volatile LAS unsigned*)(F.lds + MISC_OFF) + 12;
    gu32* head = F.ctl + CW_COPY_HEAD;
#pragma unroll 1
    for (int i = 0; i < nclaim; ++i) {
        if (F.tid == 0) *slot = __hip_atomic_fetch_add(head, 4u, RLX_AGENT);
        __syncthreads();
        const unsigned c = *slot;
        __syncthreads();
        if (c >= NUNIT) break;
#pragma unroll 1
        for (unsigned u = c; u < c + 4 && u < NUNIT; ++u) copy_unit_any<512, 8>(A, u, F.tid);
    }
}
__device__ __forceinline__ void wave_copy(const Frame& F, const Args& A, volatile LAS unsigned* fin) {
    gu32* head = F.ctl + CW_COPY_HEAD;
    for (;;) {
        if (*fin >= 7u) break;
        unsigned c = 0; if (F.lane == 0) c = __hip_atomic_fetch_add(head, 1u, RLX_AGENT);
        c = __builtin_amdgcn_readfirstlane(c);
        if (c >= NUNIT) break;
        copy_unit_any<64, 32>(A, c, F.lane);
    }
}
__device__ __forceinline__ void wave_fin(const Frame& F, volatile LAS unsigned* fin) { if (F.lane == 0) __hip_atomic_fetch_add((LAS unsigned*)fin, 1u, __ATOMIC_RELAXED, __HIP_MEMORY_SCOPE_WORKGROUP); }

__device__ __forceinline__ void p0_prologue(const Frame& F, const Args& A) {
    unsigned char* ws = A.ws;
    LAS float* scr = (LAS float*)(F.lds + F.wave * 16384);
    float* vec = (float*)(ws + WS_VEC);
    const int lane = F.lane;
    constexpr int T_IN0 = 16 * 72, T_OUT0 = 16 * 32, T_W1 = 16 * 128, T_W2 = 64 * 32, T_IN1 = 16 * 64, T_OUT1 = 8 * 32;
    constexpr int NT = T_IN0 + T_OUT0 + 2 * T_W1 + 2 * T_W2 + T_IN1 + T_OUT1;
    for (int it = F.gw; it < NT; it += F.NGW) {
        int r = it;
        if (r < T_IN0) { const int kb = r / 72, nb = r % 72; transpose_tile(A.in[8], N_IN0, in0_src_col(32 * nb), 64 * kb, nullptr, (bf16_t*)(ws + WS_WIN0), DM, 32 * nb, 0, scr, lane); continue; } r -= T_IN0;
        if (r < T_OUT0) { const int kb = r / 32, nb = r % 32; transpose_tile(A.in[12], DM, 32 * nb, 64 * kb, nullptr, (bf16_t*)(ws + WS_WOUT0), DM, 32 * nb, 0, scr, lane); continue; } r -= T_OUT0;
        if (r < 2 * T_W1) { const int L = r / T_W1; r %= T_W1; const int kb = r / 128, nb = r % 128;
            transpose_tile(A.in[20] + (size_t)L * DM * FF, FF, 32 * nb, 64 * kb, A.in[22] + L * DM, (bf16_t*)(ws + (L ? WS_W1_1 : WS_W1_0)), DM, 32 * nb, 0, scr, lane); continue; } r -= 2 * T_W1;
        if (r < 2 * T_W2) { const int L = r / T_W2; r %= T_W2; const int kb = r / 32, nb = r % 32;
            transpose_tile(A.in[21] + (size_t)L * FF * DM, DM, 32 * nb, 64 * kb, nullptr, (bf16_t*)(ws + (L ? WS_W2_1 : WS_W2_0)), FF, 32 * nb, 0, scr, lane); continue; } r -= 2 * T_W2;
        if (r < T_IN1) { const int kb = r / 64, nb = r % 64; transpose_tile(A.in[14], N_IN1, 32 * nb, 64 * kb, A.in[24], (bf16_t*)(ws + WS_WIN1), DM, 32 * nb, 0, scr, lane); continue; } r -= T_IN1;
        { const int kb = r / 32, nb = r % 32; transpose_tile(A.in[18] + (size_t)512 * DM, DM, 32 * nb, 64 * kb, nullptr, (bf16_t*)(ws + WS_WOUT1), DM, 32 * nb, 512, scr, lane); }
    }
    if (F.NGW >= 2048) { const int pf = F.gw - 1024; if (pf >= 0 && pf < 1024) poolfold_item(A.in[16], A.in[17], A.in[18], (bf16_t*)(ws + WS_WOUT1), pf, lane); }
    else for (int it = F.gw; it < 1024; it += F.NGW) poolfold_item(A.in[16], A.in[17], A.in[18], (bf16_t*)(ws + WS_WOUT1), it, lane);
    for (int it = F.gw; it < 640; it += F.NGW) {
        if (it < 256) colsum_item(A.in[20], DM, FF, A.in[22], A.in[23], nullptr, vec + V_CS1_0, vec + V_BW1_0, it, lane);
        else if (it < 512) colsum_item(A.in[20] + (size_t)DM * FF, DM, FF, A.in[22] + DM, A.in[23] + DM, nullptr, vec + V_CS1_1, vec + V_BW1_1, it - 256, lane);
        else colsum_item(A.in[14], DM, N_IN1, A.in[24], A.in[25], A.in[15], vec + V_CSIN1, vec + V_BWIN1, it - 512, lane);
    }
    for (int i = F.gw * 64 + lane; i < N_IN0; i += F.NGW * 64) vec[V_BIN0 + i] = A.in[9][in0_src_col(i)];
    for (int m0 = F.gw * 4; m0 < M; m0 += F.NGW * 4) {
        const float* xr = m0 < MP ? A.in[0] + (size_t)m0 * DM : A.in[1] + (size_t)(m0 - MP) * DM;
        const GAS f32x4* x4 = (const GAS f32x4*)xr + lane; GAS u32x2v* o = (GAS u32x2v*)((bf16_t*)(ws + WS_XB) + (size_t)m0 * DM) + lane;
        f32x4 v[16];
#pragma unroll
        for (int j = 0; j < 16; ++j) v[j] = x4[64 * j];
#pragma unroll
        for (int j = 0; j < 16; ++j) { u32x2v w; w.x = pk2(v[j][0], v[j][1]); w.y = pk2(v[j][2], v[j][3]); o[64 * j] = w; }
    }
}
__device__ __forceinline__ float alibi_slope(int h) { return __builtin_amdgcn_exp2f(-(float)(h + 1)); }
typedef float f32x16 __attribute__((ext_vector_type(16)));
typedef short s16x4 __attribute__((ext_vector_type(4)));
typedef short v4i16_t __attribute__((ext_vector_type(4)));
using pg8::bf16x8;
constexpr int VROW = 192;
constexpr int VIMG = 32 * VROW;
constexpr int ST_ROW = 136, ST_M_OFF = 512 * ST_ROW, ST_L_OFF = ST_M_OFF + 2048, ST_BYTES = ST_L_OFF + 2048;
__device__ __forceinline__ s16x4 vtr(LAS const unsigned char* p) { return __builtin_bit_cast(s16x4, __builtin_amdgcn_ds_read_tr16_b64_v4i16((LAS v4i16_t*)p)); }
__device__ __forceinline__ unsigned cvtpk(float lo, float hi) { return pg8::cvt_pk_bf16(lo, hi); }
#define DPP_ADD(v, CTRL) ((v) + __builtin_bit_cast(float, __builtin_amdgcn_update_dpp(0, __builtin_bit_cast(int, (v)), (CTRL), 0xf, 0xf, true)))
__device__ __forceinline__ float row16_sum(float d) {
    d = DPP_ADD(d, 0xB1);
    d = DPP_ADD(d, 0x4E);
    d = DPP_ADD(d, 0x141);
    d = DPP_ADD(d, 0x140);
    return d;
}
__device__ __forceinline__ float xhalf_max(float v) { float a = v, b = v; swap32(a, b); return fmaxf(a, b); }
__device__ __forceinline__ float xhalf_sum(float v) { float a = v, b = v; swap32(a, b); return a + b; }

struct AttnCfg {
    const bf16_t *Q, *K, *V; int qpitch, kvpitch;
    long rowbase;
    int i0, dl; float sl2;
    LAS unsigned char* st; int tl0;
    bf16_t* out; int opitch; float sink2;
};
__device__ __forceinline__ void attn_preload_q(const AttnCfg& c, int lane, bf16x8 (&QF)[4]) {
    const int qi = lane & 31, hh = lane >> 5;
    const long qrow = c.rowbase + (long)c.dl * (c.i0 + qi);
#pragma unroll
    for (int kk = 0; kk < 4; ++kk) QF[kk] = *(const bf16x8*)(c.Q + qrow * c.qpitch + 16 * kk + 8 * hh);
}
__device__ __forceinline__ void attn_preload_kv(const AttnCfg& c, int lane, bf16x8 (&KF)[4], u32x4 (&VV)[4]) {
    const int qi = lane & 31, hh = lane >> 5;
    const long qrow = c.rowbase + (long)c.dl * (c.i0 + qi);
    const char* kp = (const char*)(c.K + qrow * c.kvpitch + 8 * hh);
    const char* vp = (const char*)(c.V + (c.rowbase + (long)c.dl * (c.i0 + (lane >> 3))) * c.kvpitch + 8 * (lane & 7));
    const long vrow8 = (long)16 * c.dl * c.kvpitch;
#pragma unroll
    for (int kk = 0; kk < 4; ++kk) KF[kk] = *(const bf16x8*)(kp + 32 * kk);
#pragma unroll
    for (int i = 0; i < 4; ++i) VV[i] = *(const u32x4*)(vp + (long)i * vrow8);
}
template <bool LOADST, bool FINAL, bool SINK>
__device__ __forceinline__ void attn_item(const AttnCfg& c, LAS unsigned char* vimg, int lane_in, bf16x8 (&qf)[4], bf16x8 (&kf)[4], u32x4 (&vv)[4], bool have_next, const AttnCfg& cn) {
    int lane = lane_in; asm volatile("" : "+v"(lane));
    const int qi = lane & 31, hh = lane >> 5;
    const long qrow = c.rowbase + (long)c.dl * (c.i0 + qi);
    float m, l; f32x16 o[2];
    if (LOADST) {
        const int tl = c.dl * (c.i0 + qi) + c.tl0, rho = tl ^ ((tl >> 5) & 15);
        LAS const unsigned char* sp = c.st + rho * ST_ROW + 8 * hh;
        m = *(LAS const float*)(c.st + ST_M_OFF + 4 * rho); l = *(LAS const float*)(c.st + ST_L_OFF + 4 * rho); l = hh == 0 ? l : 0.f;
#pragma unroll
        for (int cb = 0; cb < 2; ++cb)
#pragma unroll
            for (int g = 0; g < 4; ++g) { const u32x2v w = *(LAS const u32x2v*)(sp + 64 * cb + 16 * g); o[cb][4 * g] = bflo(w.x); o[cb][4 * g + 1] = bfhi(w.x); o[cb][4 * g + 2] = bflo(w.y); o[cb][4 * g + 3] = bfhi(w.y); }
    } else {
        m = -INFINITY; l = 0.f;
#pragma unroll
        for (int r = 0; r < 16; ++r) { o[0][r] = 0.f; o[1][r] = 0.f; }
    }
    const int blk = (lane >> 4) & 1, tq = (lane & 15) >> 2, tp = lane & 3;
    LAS const unsigned char* vrd = vimg + (4 * hh + tq) * VROW + (16 * blk + 4 * tp) * 2;
    LAS unsigned char* vwr = vimg + (lane >> 3) * VROW + (lane & 7) * 16;
    const float e3 = 3.0f * c.sl2, e8 = 8.0f * c.sl2;
    const int ktmin = c.i0 >= 97 ? 0 : (128 - c.i0) / 32;
    const bool edge = c.i0 < 128;
    const char* kbase = (const char*)(c.K + (c.rowbase + (long)c.dl * (c.i0 + qi)) * c.kvpitch + 8 * hh);
    const char* vbase = (const char*)(c.V + (c.rowbase + (long)c.dl * (c.i0 + (lane >> 3))) * c.kvpitch + 8 * (lane & 7));
    const long tstep = (long)64 * c.dl * c.kvpitch, vrow8 = (long)16 * c.dl * c.kvpitch;
#define ATT_LOAD(KT, KF, VV) do { if (!edge) { const char* kp_ = kbase - (long)(4 - (KT)) * tstep; const char* vp_ = vbase - (long)(4 - (KT)) * tstep; \
        _Pragma("unroll") for (int kk = 0; kk < 4; ++kk) KF[kk] = *(const bf16x8*)(kp_ + 32 * kk); \
        _Pragma("unroll") for (int i = 0; i < 4; ++i) VV[i] = *(const u32x4*)(vp_ + (long)i * vrow8); \
      } else { const int pk0_ = c.i0 - 128 + 32 * (KT); const int pk_ = pk0_ + qi; const long krow_ = c.rowbase + (long)c.dl * (pk_ < 0 ? 0 : pk_); \
        _Pragma("unroll") for (int kk = 0; kk < 4; ++kk) KF[kk] = *(const bf16x8*)(c.K + krow_ * c.kvpitch + 16 * kk + 8 * hh); \
        _Pragma("unroll") for (int i = 0; i < 4; ++i) { const int pv_ = pk0_ + (lane >> 3) + 8 * i; const long vrow_ = c.rowbase + (long)c.dl * (pv_ < 0 ? 0 : pv_); \
            VV[i] = *(const u32x4*)(c.V + vrow_ * c.kvpitch + 8 * (lane & 7)); } } } while (0)
    for (int kt = 4; kt >= ktmin; --kt) {
        const int pk0 = c.i0 - 128 + 32 * kt;
        bf16x8 kn[4]; u32x4 vn[4];
#pragma unroll
        for (int kk = 0; kk < 4; ++kk) { kn[kk] = kf[kk]; vn[kk] = vv[kk]; }
        if (kt > ktmin) ATT_LOAD(kt - 1, kn, vn);
        else if (have_next) attn_preload_kv(cn, lane, kn, vn);
        {
          const int dq = qi + 128 - 32 * kt;
          float bg = c.sl2 * (float)(4 * hh - dq);
          f32x16 s;
#pragma unroll
          for (int g = 0; g < 4; ++g) { s[4 * g] = bg; s[4 * g + 1] = bg + c.sl2; s[4 * g + 2] = __builtin_fmaf(c.sl2, 2.0f, bg); s[4 * g + 3] = bg + e3; bg += e8; }
          __builtin_amdgcn_s_setprio(1);
#pragma unroll
          for (int kk = 0; kk < 4; ++kk) s = __builtin_amdgcn_mfma_f32_32x32x16_bf16(kf[kk], qf[kk], s, 0, 0, 0);
          __builtin_amdgcn_s_setprio(0);
          asm volatile("" ::: "memory");
          if (kt == ktmin && have_next) attn_preload_q(cn, lane, qf);
#pragma unroll
          for (int i = 0; i < 4; ++i) *(LAS u32x4*)(vwr + 8 * i * VROW) = vv[i];
          if (kt == 4 || kt == 0 || pk0 < 0) {
#pragma unroll
              for (int r = 0; r < 16; ++r) { const int ko = (r & 3) + 8 * (r >> 2) + 4 * hh, dist = dq - ko;
                  const bool ok = (dist >= 0) & (dist <= 128) & (pk0 + ko >= 0);
                  s[r] = ok ? s[r] : -INFINITY; }
          }
          float tmax = fmaxf(fmaxf(s[0], s[1]), fmaxf(s[2], s[3]));
#pragma unroll
          for (int r = 4; r < 16; r += 4) tmax = fmaxf(tmax, fmaxf(fmaxf(s[r], s[r + 1]), fmaxf(s[r + 2], s[r + 3])));
          tmax = xhalf_max(tmax);
          const float mnew = fmaxf(m, tmax), scl = __builtin_amdgcn_exp2f(m - mnew);
          m = mnew; l *= scl;
#pragma unroll
          for (int r = 0; r < 16; ++r) { o[0][r] *= scl; o[1][r] *= scl; }
          float ps = 0.f;
#pragma unroll
          for (int r = 0; r < 16; ++r) { s[r] = __builtin_amdgcn_exp2f(s[r] - mnew); ps += s[r]; }
          l += ps;
          u32x4 pw0, pw1;
          pw0.x = cvtpk(s[0], s[1]); pw0.y = cvtpk(s[2], s[3]); pw0.z = cvtpk(s[4], s[5]); pw0.w = cvtpk(s[6], s[7]);
          pw1.x = cvtpk(s[8], s[9]); pw1.y = cvtpk(s[10], s[11]); pw1.z = cvtpk(s[12], s[13]); pw1.w = cvtpk(s[14], s[15]);
          const bf16x8 pf0 = __builtin_bit_cast(bf16x8, pw0), pf1 = __builtin_bit_cast(bf16x8, pw1);
          asm volatile("s_waitcnt lgkmcnt(0)" ::: "memory");
#pragma unroll
          for (int cb = 0; cb < 2; ++cb) {
              const s16x4 a0 = vtr(vrd + (0) * VROW + cb * 64), a1 = vtr(vrd + (8) * VROW + cb * 64), b0 = vtr(vrd + (16) * VROW + cb * 64), b1 = vtr(vrd + (24) * VROW + cb * 64);
              const bf16x8 vf0 = (bf16x8){a0[0], a0[1], a0[2], a0[3], a1[0], a1[1], a1[2], a1[3]}, vf1 = (bf16x8){b0[0], b0[1], b0[2], b0[3], b1[0], b1[1], b1[2], b1[3]};
              __builtin_amdgcn_s_setprio(1);
              o[cb] = __builtin_amdgcn_mfma_f32_32x32x16_bf16(vf0, pf0, o[cb], 0, 0, 0);
              o[cb] = __builtin_amdgcn_mfma_f32_32x32x16_bf16(vf1, pf1, o[cb], 0, 0, 0);
              __builtin_amdgcn_s_setprio(0);
          }
          asm volatile("s_waitcnt lgkmcnt(0)" ::: "memory");
        }
#pragma unroll
        for (int kk = 0; kk < 4; ++kk) { kf[kk] = kn[kk]; vv[kk] = vn[kk]; }
    }
#undef ATT_LOAD
    float lt = xhalf_sum(l);
    if (FINAL) {
        if (SINK) lt += __builtin_amdgcn_exp2f(c.sink2 - m);
        const float inv = 1.0f / lt;
        bf16_t* op = c.out + qrow * c.opitch;
#pragma unroll
        for (int cb = 0; cb < 2; ++cb)
#pragma unroll
            for (int gp = 0; gp < 4; gp += 2) {
                unsigned ax = cvtpk(o[cb][4 * gp] * inv, o[cb][4 * gp + 1] * inv), ay = cvtpk(o[cb][4 * gp + 2] * inv, o[cb][4 * gp + 3] * inv);
                unsigned bx = cvtpk(o[cb][4 * gp + 4] * inv, o[cb][4 * gp + 5] * inv), by = cvtpk(o[cb][4 * gp + 6] * inv, o[cb][4 * gp + 7] * inv);
                swap32(ax, bx); swap32(ay, by);
                *(u32x4*)(op + 32 * cb + 8 * (gp + hh)) = (u32x4){ax, ay, bx, by}; }
    } else {
        const int tl = c.dl * (c.i0 + qi) + c.tl0, rho = tl ^ ((tl >> 5) & 15);
        LAS unsigned char* sp = c.st + rho * ST_ROW + 8 * hh;
#pragma unroll
        for (int cb = 0; cb < 2; ++cb)
#pragma unroll
            for (int g = 0; g < 4; ++g) { u32x2v w; w.x = cvtpk(o[cb][4 * g], o[cb][4 * g + 1]); w.y = cvtpk(o[cb][4 * g + 2], o[cb][4 * g + 3]); *(LAS u32x2v*)(sp + 64 * cb + 16 * g) = w; }
        if (hh == 0) { *(LAS float*)(c.st + ST_M_OFF + 4 * rho) = m; *(LAS float*)(c.st + ST_L_OFF + 4 * rho) = lt; }
    }
}

struct SAttnCfg {
    const bf16_t* q;
    const float *kc, *vc; int cpitch;
    const bf16_t *kn, *vn; int npitch;
    int nh, i, dl; float sl2;
};
template <bool SINK>
__device__ __forceinline__ void sattn_item(const SAttnCfg& c, float sink2, bf16_t* out, float& m_io, float& l_io, f32x4& o_io, bool first, bool last, int lane_in) {
    int lane = lane_in; asm volatile("" : "+v"(lane));
    int qd = lane >> 4; const int sub = lane & 15;
    asm volatile("" : "+v"(qd));
    f32x4 qv; { const u32x2v w = *(const u32x2v*)(c.q + 4 * sub); qv = (f32x4){bflo(w.x), bfhi(w.x), bflo(w.y), bfhi(w.y)}; }
#define SA_ROW(IT, CACHE, NEW, DST) do { const int j_ = 4 * (IT) + qd, row_ = c.nh + c.i - j_ * c.dl; const int rc_ = row_ < 0 ? 0 : (row_ >= c.nh ? c.nh - 1 : row_); \
        DST = *(const f32x4*)((CACHE) + (size_t)rc_ * c.cpitch + 4 * sub); \
        if ((IT) < 3) { const int rn_ = row_ - c.nh; const u32x2v w_ = *(const u32x2v*)((NEW) + (size_t)(rn_ < 0 ? 0 : rn_) * c.npitch + 4 * sub); \
            if (rn_ >= 0) DST = (f32x4){bflo(w_.x), bfhi(w_.x), bflo(w_.y), bfhi(w_.y)}; } } while (0)
    float sc[33];
    {
        f32x4 kv[33];
#pragma unroll
        for (int it = 0; it < 33; ++it) SA_ROW(it, c.kc, c.kn, kv[it]);
#pragma unroll
        for (int it = 0; it < 33; ++it) {
            const int j = 4 * it + qd;
            float d = (qv[0] * kv[it][0] + qv[1] * kv[it][1]) + (qv[2] * kv[it][2] + qv[3] * kv[it][3]);
            d = row16_sum(d);
            sc[it] = j <= 128 ? d - c.sl2 * (float)j : -INFINITY;
        }
    }
    float tm = sc[0];
#pragma unroll
    for (int it = 1; it < 33; ++it) tm = fmaxf(tm, sc[it]);
    tm = fmaxf(tm, __shfl_xor(tm, 16)); tm = fmaxf(tm, __shfl_xor(tm, 32));
    float m = first ? tm : fmaxf(m_io, tm);
    const float scl = first ? 0.f : __builtin_amdgcn_exp2f(m_io - m);
    float l = first ? 0.f : l_io * scl; f32x4 o = first ? (f32x4){0.f, 0.f, 0.f, 0.f} : o_io * scl;
    float ps = 0.f; f32x4 oa = (f32x4){0.f, 0.f, 0.f, 0.f};
    {
        f32x4 vv[33];
#pragma unroll
        for (int it = 0; it < 33; ++it) SA_ROW(it, c.vc, c.vn, vv[it]);
#pragma unroll
        for (int it = 0; it < 33; ++it) { const float p = __builtin_amdgcn_exp2f(sc[it] - m); ps += p; oa += vv[it] * p; }
    }
#undef SA_ROW
    ps += __shfl_xor(ps, 16); ps += __shfl_xor(ps, 32);
#pragma unroll
    for (int e = 0; e < 4; ++e) { float t = oa[e]; t += __shfl_xor(t, 16); t += __shfl_xor(t, 32); oa[e] = t; }
    l += ps; o += oa;
    if (last) {
        if (SINK) l += __builtin_amdgcn_exp2f(sink2 - m);
        const float inv = 1.0f / l;
        if (qd == 0) { u32x2v w; w.x = cvtpk(o[0] * inv, o[1] * inv); w.y = cvtpk(o[2] * inv, o[3] * inv); *(u32x2v*)(out + 4 * sub) = w; }
    }
    m_io = m; l_io = l; o_io = o;
}

__device__ __forceinline__ bf16x8 cvt8(const f32x4 a, const f32x4 b) { u32x4 w; w.x = cvtpk(a[0], a[1]); w.y = cvtpk(a[2], a[3]); w.z = cvtpk(b[0], b[1]); w.w = cvtpk(b[2], b[3]); return __builtin_bit_cast(bf16x8, w); }
__device__ __forceinline__ void sattn_a_item(const bf16_t* Q, const float* kc, const float* vc, const bf16_t* KN, const bf16_t* VN, const float* sinks, bf16_t* MIX, int b, int kvh, LAS unsigned char* vimg, int lane_in) {
    int lane = lane_in; asm volatile("" : "+v"(lane));
    const int qi = lane & 31, hh = lane >> 5, g = qi >> 3, i = qi & 7, h = kvh * 4 + g;
    const long row0 = MP + (long)b * NST;
    bf16x8 qf[4];
#pragma unroll
    for (int kk = 0; kk < 4; ++kk) qf[kk] = *(const bf16x8*)(Q + (row0 + i) * 512 + h * 64 + 16 * kk + 8 * hh);
    const float sl2 = alibi_slope(h) * LOG2E, sink2 = sinks[h] * LOG2E;
    float cko[16];
#pragma unroll
    for (int r = 0; r < 16; ++r) cko[r] = sl2 * (float)((r & 3) + 8 * (r >> 2) + 4 * hh);
    float m = -INFINITY, l = 0.f; f32x16 o[2];
#pragma unroll
    for (int r = 0; r < 16; ++r) { o[0][r] = 0.f; o[1][r] = 0.f; }
    const int blk = (lane >> 4) & 1, tq = (lane & 15) >> 2, tp = lane & 3;
    LAS const unsigned char* vrd = vimg + (4 * hh + tq) * VROW + (16 * blk + 4 * tp) * 2;
    LAS unsigned char* vwr = vimg + (lane >> 3) * VROW + (lane & 7) * 16;
    const float* kcb = kc + (size_t)b * NA_HIST * 128 + kvh * 64; const float* vcb = vc + (size_t)b * NA_HIST * 128 + kvh * 64;
    f32x4 kraw[8], vraw[8];
#define SA_PREFETCH(KT) do { const int r_ = 32 * (KT) + (lane & 31); \
        _Pragma("unroll") for (int kk = 0; kk < 4; ++kk) { const float* p_ = kcb + (size_t)r_ * 128 + 16 * kk + 8 * hh; kraw[2 * kk] = *(const f32x4*)p_; kraw[2 * kk + 1] = *(const f32x4*)(p_ + 4); } \
        _Pragma("unroll") for (int q4 = 0; q4 < 4; ++q4) { const int vr_ = 32 * (KT) + (lane >> 3) + 8 * q4; const float* p_ = vcb + (size_t)vr_ * 128 + 8 * (lane & 7); vraw[2 * q4] = *(const f32x4*)p_; vraw[2 * q4 + 1] = *(const f32x4*)(p_ + 4); } } while (0)
#pragma unroll 1
    for (int kt = 4; kt >= 0; --kt) {
        bf16x8 kf[4]; u32x4 vv[4];
        if (kt == 4) {
            const int ko = lane & 31;
#pragma unroll
            for (int kk = 0; kk < 4; ++kk) kf[kk] = *(const bf16x8*)(KN + (row0 + (ko < 8 ? ko : 0)) * 128 + kvh * 64 + 16 * kk + 8 * hh);
#pragma unroll
            for (int q4 = 0; q4 < 4; ++q4) { const int vr = (lane >> 3) + 8 * q4; vv[q4] = *(const u32x4*)(VN + (row0 + (vr < 8 ? vr : 0)) * 128 + kvh * 64 + 8 * (lane & 7)); }
        } else {
#pragma unroll
            for (int kk = 0; kk < 4; ++kk) kf[kk] = cvt8(kraw[2 * kk], kraw[2 * kk + 1]);
#pragma unroll
            for (int q4 = 0; q4 < 4; ++q4) vv[q4] = __builtin_bit_cast(u32x4, cvt8(vraw[2 * q4], vraw[2 * q4 + 1]));
        }
        if (kt > 0) SA_PREFETCH(kt - 1);
        const float base = -sl2 * (float)(128 + i - 32 * kt);
        f32x16 s;
#pragma unroll
        for (int r = 0; r < 16; ++r) s[r] = base + cko[r];
#pragma unroll
        for (int kk = 0; kk < 4; ++kk) s = __builtin_amdgcn_mfma_f32_32x32x16_bf16(kf[kk], qf[kk], s, 0, 0, 0);
        asm volatile("" ::: "memory");
#pragma unroll
        for (int q4 = 0; q4 < 4; ++q4) *(LAS u32x4*)(vwr + 8 * q4 * VROW) = vv[q4];
        if (kt == 4 || kt == 0) {
#pragma unroll
            for (int r = 0; r < 16; ++r) { const int ko = (r & 3) + 8 * (r >> 2) + 4 * hh; const bool ok = kt == 4 ? (ko <= i) : (ko >= i); s[r] = ok ? s[r] : -INFINITY; }
        }
        float tmax = fmaxf(fmaxf(s[0], s[1]), fmaxf(s[2], s[3]));
#pragma unroll
        for (int r = 4; r < 16; r += 4) tmax = fmaxf(tmax, fmaxf(fmaxf(s[r], s[r + 1]), fmaxf(s[r + 2], s[r + 3])));
        tmax = xhalf_max(tmax);
        const float mnew = fmaxf(m, tmax), scl = __builtin_amdgcn_exp2f(m - mnew);
        m = mnew; l *= scl;
#pragma unroll
        for (int r = 0; r < 16; ++r) { o[0][r] *= scl; o[1][r] *= scl; }
        float ps = 0.f;
#pragma unroll
        for (int r = 0; r < 16; ++r) { s[r] = __builtin_amdgcn_exp2f(s[r] - mnew); ps += s[r]; }
        l += ps;
        u32x4 pw0, pw1;
        pw0.x = cvtpk(s[0], s[1]); pw0.y = cvtpk(s[2], s[3]); pw0.z = cvtpk(s[4], s[5]); pw0.w = cvtpk(s[6], s[7]);
        pw1.x = cvtpk(s[8], s[9]); pw1.y = cvtpk(s[10], s[11]); pw1.z = cvtpk(s[12], s[13]); pw1.w = cvtpk(s[14], s[15]);
        const bf16x8 pf0 = __builtin_bit_cast(bf16x8, pw0), pf1 = __builtin_bit_cast(bf16x8, pw1);
        asm volatile("s_waitcnt lgkmcnt(0)" ::: "memory");
#pragma unroll
        for (int cb = 0; cb < 2; ++cb) {
            const s16x4 a0 = vtr(vrd + (0) * VROW + cb * 64), a1 = vtr(vrd + (8) * VROW + cb * 64), b0 = vtr(vrd + (16) * VROW + cb * 64), b1 = vtr(vrd + (24) * VROW + cb * 64);
            const bf16x8 vf0 = (bf16x8){a0[0], a0[1], a0[2], a0[3], a1[0], a1[1], a1[2], a1[3]}, vf1 = (bf16x8){b0[0], b0[1], b0[2], b0[3], b1[0], b1[1], b1[2], b1[3]};
            o[cb] = __builtin_amdgcn_mfma_f32_32x32x16_bf16(vf0, pf0, o[cb], 0, 0, 0);
            o[cb] = __builtin_amdgcn_mfma_f32_32x32x16_bf16(vf1, pf1, o[cb], 0, 0, 0);
        }
        asm volatile("s_waitcnt lgkmcnt(0)" ::: "memory");
    }
    float lt = xhalf_sum(l) + __builtin_amdgcn_exp2f(sink2 - m);
    const float inv = 1.0f / lt;
    bf16_t* op = MIX + (row0 + i) * DM + h * 64;
#pragma unroll
    for (int cb = 0; cb < 2; ++cb)
#pragma unroll
        for (int gq = 0; gq < 4; ++gq) { u32x2v w; w.x = cvtpk(o[cb][4 * gq] * inv, o[cb][4 * gq + 1] * inv); w.y = cvtpk(o[cb][4 * gq + 2] * inv, o[cb][4 * gq + 3] * inv);
            *(u32x2v*)(op + 32 * cb + 8 * gq + 4 * hh) = w; }
}
constexpr int FD_LDS = 3 * 8 * 132 * 4;
__device__ __forceinline__ f32x4 ldq4(const bf16_t* p) { const u32x2v w = *(const u32x2v*)p; return (f32x4){bflo(w.x), bfhi(w.x), bflo(w.y), bfhi(w.y)}; }
__device__ __forceinline__ float dot4(const f32x4 a, const f32x4 b) { return (a[0] * b[0] + a[1] * b[1]) + (a[2] * b[2] + a[3] * b[3]); }
template <bool VPASS>
__device__ __forceinline__ void fd_stream(const float* cc, float* co, const f32x4 qa, const f32x4 qb, f32x4& oa, f32x4& ob, LAS float* Sc, float sl4, float sl16, int qd, int sub) {
#pragma unroll 1
    for (int s0 = 0; s0 < 192; s0 += 16) {
        f32x4 rv[16];
#pragma unroll
        for (int u = 0; u < 16; ++u) { const int it = 4 * ((s0 + u) >> 1) + (u & 1); rv[u] = __builtin_nontemporal_load((const f32x4*)(cc + (size_t)(4 * it + qd) * 512 + 4 * sub)); }
#pragma unroll
        for (int u = 0; u < 16; ++u) {
            const int it = 4 * ((s0 + u) >> 1) + (u & 1), pos = 4 * it + qd, j16 = 128 - (it >> 2);
            if (s0 > 0 || u >= 2) __builtin_nontemporal_store(rv[u], (f32x4*)(co + (size_t)(pos - 8) * 512 + 4 * sub));
            if (!VPASS) {
                const float d = row16_sum(dot4((u & 1) ? qb : qa, rv[u]));
                if (sub == 0) Sc[(16 + qd + 4 * (u & 1)) * 132 + j16] = d - sl16 * (float)j16;
            } else {
                if (u & 1) ob += rv[u] * Sc[(16 + qd + 4) * 132 + j16]; else oa += rv[u] * Sc[(16 + qd) * 132 + j16];
            }
        }
    }
#pragma unroll 1
    for (int it0 = 384; it0 < 512; it0 += 16) {
        f32x4 rv[16];
#pragma unroll
        for (int u = 0; u < 16; ++u) rv[u] = __builtin_nontemporal_load((const f32x4*)(cc + (size_t)(4 * (it0 + u) + qd) * 512 + 4 * sub));
#pragma unroll
        for (int u = 0; u < 16; ++u) {
            const int it = it0 + u, pos = 4 * it + qd;
            __builtin_nontemporal_store(rv[u], (f32x4*)(co + (size_t)(pos - 8) * 512 + 4 * sub));
            const int ph = u & 3, j16 = 128 - (it >> 2), j1 = 512 - it, j2 = 513 - it;
            if (!VPASS) {
                const float da = row16_sum(dot4(qa, rv[u])), db = row16_sum(dot4(qb, rv[u]));
                if (sub == 0) {
                    if (ph == 0) Sc[(16 + qd) * 132 + j16] = da - sl16 * (float)j16;
                    if (ph == 1) Sc[(16 + qd + 4) * 132 + j16] = db - sl16 * (float)j16;
                    Sc[(8 + qd) * 132 + j1] = da - sl4 * (float)j1; if (j2 <= 128) Sc[(8 + qd + 4) * 132 + j2] = db - sl4 * (float)j2;
                }
            } else {
                if (ph == 0) oa += rv[u] * Sc[(16 + qd) * 132 + j16];
                if (ph == 1) ob += rv[u] * Sc[(16 + qd + 4) * 132 + j16];
                oa += rv[u] * Sc[(8 + qd) * 132 + j1]; if (j2 <= 128) ob += rv[u] * Sc[(8 + qd + 4) * 132 + j2];
            }
        }
    }
}
__device__ __forceinline__ void fused_d_item(const Args& A, int b, int h, LAS float* Sc, int lane_in) {
    int lane = lane_in; asm volatile("" : "+v"(lane));
    const int qd = lane >> 4, sub = lane & 15;
    unsigned char* ws = A.ws;
    const bf16_t* Q = (const bf16_t*)(ws + WS_Q); const bf16_t* KN = (const bf16_t*)(ws + WS_K); const bf16_t* VN = (const bf16_t*)(ws + WS_V); bf16_t* MIX = (bf16_t*)(ws + WS_MIX);
    const long row0 = MP + (long)b * NST;
    const float* kc = A.in[6] + (size_t)b * ND_HIST * 512 + h * 64; const float* vc = A.in[7] + (size_t)b * ND_HIST * 512 + h * 64;
    float* ko = A.out + O_DKS + (size_t)b * ND_HIST * 512 + h * 64; float* vo = A.out + O_DVS + (size_t)b * ND_HIST * 512 + h * 64;
    const float slope = alibi_slope(h) * LOG2E, sl1 = slope, sl4 = 4.f * slope, sl16 = 16.f * slope;
    for (int e = lane; e < 3 * 8 * 132; e += 64) Sc[e] = -INFINITY;
    f32x4 q[8];
#pragma unroll
    for (int i = 0; i < 8; ++i) q[i] = ldq4(Q + (row0 + i) * 512 + h * 64 + 4 * sub);
    const f32x4 qa = qd == 0 ? q[0] : qd == 1 ? q[1] : qd == 2 ? q[2] : q[3], qb = qd == 0 ? q[4] : qd == 1 ? q[5] : qd == 2 ? q[6] : q[7];
    asm volatile("s_waitcnt lgkmcnt(0)" ::: "memory");
    f32x4 oa = (f32x4){0.f, 0.f, 0.f, 0.f}, ob = oa;
    fd_stream<false>(kc, ko, qa, qb, oa, ob, Sc, sl4, sl16, qd, sub);
#pragma unroll 1
    for (int it0 = 480; it0 < 512; it0 += 8) {
        f32x4 rv[8];
#pragma unroll
        for (int u = 0; u < 8; ++u) rv[u] = *(const f32x4*)(kc + (size_t)(4 * (it0 + u) + qd) * 512 + 4 * sub);
#pragma unroll
        for (int u = 0; u < 8; ++u) { const int pos = 4 * (it0 + u) + qd;
#pragma unroll
            for (int i = 0; i < 8; ++i) { const float d = row16_sum(dot4(q[i], rv[u])); const int j = 2048 + i - pos; if (sub == 0 && j <= 128) Sc[i * 132 + j] = d - sl1 * (float)j; } }
    }
#pragma unroll
    for (int s2 = 0; s2 < 2; ++s2) { const int r = 4 * s2 + qd; const f32x4 kn = ldq4(KN + (row0 + r) * 512 + h * 64 + 4 * sub);
#pragma unroll
        for (int i = 0; i < 8; ++i) { const float d = row16_sum(dot4(q[i], kn)); const int dd = i - r;
            if (sub == 0 && dd >= 0) { Sc[i * 132 + dd] = d - sl1 * (float)dd; if ((dd & 3) == 0) Sc[(8 + i) * 132 + (dd >> 2)] = d - sl4 * (float)(dd >> 2); if (dd == 0) Sc[(16 + i) * 132] = d; } } }
    asm volatile("s_waitcnt lgkmcnt(0)" ::: "memory");
    float linv[8];
#pragma unroll
    for (int i = 0; i < 8; ++i) {
        float sv[7], mx = -INFINITY;
#pragma unroll
        for (int t = 0; t < 7; ++t) { const int e = lane + 64 * t, br = e / 129, j = e - br * 129; sv[t] = e < 387 ? Sc[(br * 8 + i) * 132 + j] : -INFINITY; mx = fmaxf(mx, sv[t]); }
        mx = wave_max(mx);
        float ps = 0.f;
#pragma unroll
        for (int t = 0; t < 7; ++t) { const int e = lane + 64 * t, br = e / 129, j = e - br * 129; const float p = __builtin_amdgcn_exp2f(sv[t] - mx); if (e < 387) { Sc[(br * 8 + i) * 132 + j] = p; ps += p; } }
        linv[i] = 1.0f / wave_sum(ps);
    }
    asm volatile("s_waitcnt lgkmcnt(0)" ::: "memory");
    fd_stream<true>(vc, vo, qa, qb, oa, ob, Sc, sl4, sl16, qd, sub);
    f32x4 o1[8];
#pragma unroll
    for (int i = 0; i < 8; ++i) o1[i] = (f32x4){0.f, 0.f, 0.f, 0.f};
#pragma unroll 1
    for (int it0 = 480; it0 < 512; it0 += 8) {
        f32x4 rv[8];
#pragma unroll
        for (int u = 0; u < 8; ++u) rv[u] = *(const f32x4*)(vc + (size_t)(4 * (it0 + u) + qd) * 512 + 4 * sub);
#pragma unroll
        for (int u = 0; u < 8; ++u) { const int pos = 4 * (it0 + u) + qd;
#pragma unroll
            for (int i = 0; i < 8; ++i) { const int j = 2048 + i - pos; const float p = j <= 128 ? Sc[i * 132 + j] : 0.f; o1[i] += rv[u] * p; } }
    }
#pragma unroll
    for (int s2 = 0; s2 < 2; ++s2) { const int r = 4 * s2 + qd; const f32x4 vn = ldq4(VN + (row0 + r) * 512 + h * 64 + 4 * sub);
#pragma unroll
        for (int i = 0; i < 8; ++i) { const int dd = i - r; float p = 0.f;
            if (dd >= 0) { p = Sc[i * 132 + dd]; if ((dd & 3) == 0) p += Sc[(8 + i) * 132 + (dd >> 2)]; if (dd == 0) p += Sc[(16 + i) * 132]; }
            o1[i] += vn * p; } }
#pragma unroll
    for (int i = 0; i < 8; ++i) {
        f32x4 t = o1[i];
#pragma unroll
        for (int e = 0; e < 4; ++e) { float x = t[e]; x += __shfl_xor(x, 16); x += __shfl_xor(x, 32); t[e] = x; }
        if (qd == (i & 3)) { t += (i < 4 ? oa : ob); t = t * linv[i];
            u32x2v w; w.x = cvtpk(t[0], t[1]); w.y = cvtpk(t[2], t[3]); *(u32x2v*)(MIX + (row0 + i) * DM + 512 + h * 64 + 4 * sub) = w; }
    }
}
__device__ __forceinline__ void ld8(const bf16_t* p, float (&v)[8]) { const u32x4 w = *(const u32x4*)p; v[0] = bflo(w.x); v[1] = bfhi(w.x); v[2] = bflo(w.y); v[3] = bfhi(w.y); v[4] = bflo(w.z); v[5] = bfhi(w.z); v[6] = bflo(w.w); v[7] = bfhi(w.w); }
__device__ __forceinline__ void ld8f(const float* p, float (&v)[8]) { const f32x4 a = *(const f32x4*)p, b = *(const f32x4*)(p + 4); v[0] = a[0]; v[1] = a[1]; v[2] = a[2]; v[3] = a[3]; v[4] = b[0]; v[5] = b[1]; v[6] = b[2]; v[7] = b[3]; }
__device__ __forceinline__ void st8(bf16_t* p, const float (&v)[8]) { u32x4 w; w.x = cvtpk(v[0], v[1]); w.y = cvtpk(v[2], v[3]); w.z = cvtpk(v[4], v[5]); w.w = cvtpk(v[6], v[7]); *(u32x4*)p = w; }
__device__ __forceinline__ void conv_item(const Args& A, int item, int lane_in) {
    int lane = lane_in; asm volatile("" : "+v"(lane));
    unsigned char* ws = A.ws; const bf16_t* C = (const bf16_t*)(ws + WS_C); const bf16_t* GB = (const bf16_t*)(ws + WS_GB); bf16_t* MIX = (bf16_t*)(ws + WS_MIX);
    const int c0 = 8 * lane;
    float w0[8], w1[8], w2[8], cm2[8], cm1[8];
    ld8f(A.in[11] + c0, w0); ld8f(A.in[11] + 512 + c0, w1); ld8f(A.in[11] + 1024 + c0, w2);
    long row0; int nrow;
    if (item < 1024) {
        const int b = item >> 7, t0 = (item & 127) * 32; row0 = (long)b * SEQ + t0; nrow = 32;
        if (t0 == 0) {
#pragma unroll
            for (int e = 0; e < 8; ++e) { cm2[e] = 0.f; cm1[e] = 0.f; }
        } else { ld8(C + (row0 - 2) * 512 + c0, cm2); ld8(C + (row0 - 1) * 512 + c0, cm1); }
    } else {
        const int b = item - 1024; row0 = MP + (long)b * NST; nrow = NST;
        ld8f(A.in[4] + (size_t)(b * 2 + 0) * 512 + c0, cm2); ld8f(A.in[4] + (size_t)(b * 2 + 1) * 512 + c0, cm1);
    }
    u32x4 cw[4], gw[4], cn[4], gn[4];
#pragma unroll
    for (int k = 0; k < 4; ++k) { cw[k] = *(const u32x4*)(C + (row0 + k) * 512 + c0); gw[k] = *(const u32x4*)(GB + (row0 + k) * 512 + c0); }
#pragma unroll 1
    for (int t0 = 0; t0 < nrow; t0 += 4) {
        if (t0 + 4 < nrow) {
#pragma unroll
            for (int k = 0; k < 4; ++k) { cn[k] = *(const u32x4*)(C + (row0 + t0 + 4 + k) * 512 + c0); gn[k] = *(const u32x4*)(GB + (row0 + t0 + 4 + k) * 512 + c0); }
        }
#pragma unroll
        for (int k = 0; k < 4; ++k) {
            float cc[8], gb[8], y[8];
            cc[0] = bflo(cw[k].x); cc[1] = bfhi(cw[k].x); cc[2] = bflo(cw[k].y); cc[3] = bfhi(cw[k].y); cc[4] = bflo(cw[k].z); cc[5] = bfhi(cw[k].z); cc[6] = bflo(cw[k].w); cc[7] = bfhi(cw[k].w);
            gb[0] = bflo(gw[k].x); gb[1] = bfhi(gw[k].x); gb[2] = bflo(gw[k].y); gb[3] = bfhi(gw[k].y); gb[4] = bflo(gw[k].z); gb[5] = bfhi(gw[k].z); gb[6] = bflo(gw[k].w); gb[7] = bfhi(gw[k].w);
#pragma unroll
            for (int e = 0; e < 8; ++e) { y[e] = gb[e] * (w0[e] * cm2[e] + w1[e] * cm1[e] + w2[e] * cc[e]); cm2[e] = cm1[e]; cm1[e] = cc[e]; }
            st8(MIX + (row0 + t0 + k) * DM + 512 + c0, y);
        }
#pragma unroll
        for (int k = 0; k < 4; ++k) { cw[k] = cn[k]; gw[k] = gn[k]; }
    }
}

__device__ __forceinline__ void pool_item(const Args& A, int item, int lane_in) {
    int lane = lane_in; asm volatile("" : "+v"(lane));
    unsigned char* ws = A.ws; const bf16_t* U = (const bf16_t*)(ws + WS_C); bf16_t* MIX = (bf16_t*)(ws + WS_MIX);
    const int c0 = 8 * lane, w = 2 << (lane >> 4);
    if (item < 1024) {
        const int b = item >> 7, t0 = (item & 127) * 32; const long rb = (long)b * SEQ;
        float S[8];
#pragma unroll
        for (int e = 0; e < 8; ++e) S[e] = 0.f;
        for (int k = 1; k < w; ++k) { const int t = t0 - k; if (t >= 0) { float u[8]; ld8(U + (rb + t) * 512 + c0, u);
#pragma unroll
            for (int e = 0; e < 8; ++e) S[e] += u[e]; } }
        for (int tb = t0; tb < t0 + 32; tb += 4) {
            u32x4 uw[4], ow[4];
#pragma unroll
            for (int k = 0; k < 4; ++k) { const int t = tb + k, tl = t - w + 1; uw[k] = *(const u32x4*)(U + (rb + t) * 512 + c0); ow[k] = *(const u32x4*)(U + (rb + (tl < 0 ? 0 : tl)) * 512 + c0); }
#pragma unroll
            for (int k = 0; k < 4; ++k) {
                const int t = tb + k; float u[8], o[8], y[8];
                u[0] = bflo(uw[k].x); u[1] = bfhi(uw[k].x); u[2] = bflo(uw[k].y); u[3] = bfhi(uw[k].y); u[4] = bflo(uw[k].z); u[5] = bfhi(uw[k].z); u[6] = bflo(uw[k].w); u[7] = bfhi(uw[k].w);
                o[0] = bflo(ow[k].x); o[1] = bfhi(ow[k].x); o[2] = bflo(ow[k].y); o[3] = bfhi(ow[k].y); o[4] = bflo(ow[k].z); o[5] = bfhi(ow[k].z); o[6] = bflo(ow[k].w); o[7] = bfhi(ow[k].w);
                const float inv = 1.0f / (float)(t + 1 < w ? t + 1 : w); const bool sub = t - w + 1 >= 0;
#pragma unroll
                for (int e = 0; e < 8; ++e) { S[e] += u[e]; y[e] = S[e] * inv - u[e]; if (sub) S[e] -= o[e]; }
                st8(MIX + (rb + t) * DM + c0, y);
            }
        }
    } else {
        const int b = item - 1024; const long rb = MP + (long)b * NST; const float inv = 1.0f / (float)w;
        for (int i = 0; i < NST; ++i) {
            float S[8], ui[8], y[8];
#pragma unroll
            for (int e = 0; e < 8; ++e) S[e] = 0.f;
            for (int k = 0; k < w; ++k) { const int idx = 15 + i - k; float u[8];
                if (idx >= 15) ld8(U + (rb + idx - 15) * 512 + c0, u); else ld8f(A.in[5] + ((size_t)b * 15 + idx) * 512 + c0, u);
#pragma unroll
                for (int e = 0; e < 8; ++e) S[e] += u[e]; }
            ld8(U + (rb + i) * 512 + c0, ui);
#pragma unroll
            for (int e = 0; e < 8; ++e) y[e] = S[e] * inv - ui[e];
            st8(MIX + (rb + i) * DM + c0, y);
        }
    }
}

#ifndef REP_ATT
#define REP_ATT 1
#endif
#ifndef REP_FUSED
#define REP_FUSED 1
#endif
#ifndef REP_CP
#define REP_CP 1
#endif
#ifndef REP_SATT
#define REP_SATT 1
#endif

__device__ __forceinline__ void mixer0(const Frame& F, const Args& A) {
    unsigned char* ws = A.ws; const int lane = F.lane;
    const bf16_t* Q = (const bf16_t*)(ws + WS_Q); const bf16_t* K = (const bf16_t*)(ws + WS_K); const bf16_t* V = (const bf16_t*)(ws + WS_V); bf16_t* MIX = (bf16_t*)(ws + WS_MIX);
    LAS unsigned char* vimg = F.lds + F.wave * VIMG;
    const int gw7 = F.gw, NGW7 = F.NGW;
    const bool conv_first = F.wave >= 4;
    if (conv_first) { for (int it = gw7; it < 1024 + NSB; it += NGW7) conv_item(A, it, lane); }
    {
        const int nun = (512 - (int)blockIdx.x + F.G - 1) / F.G, nit = 2 * nun;
        auto acfg = [&](int idx) {
            const int un = blockIdx.x + (idx >> 1) * F.G, k = idx & 1;
            const int kvh = un & 1, ch = (un >> 1) & 31, b = un >> 6;
            const int it = F.wave * 2 + k, g = it >> 2, qt = it & 3, h = kvh * 4 + g;
            AttnCfg c; c.Q = Q + h * 64; c.K = K + kvh * 64; c.V = V + kvh * 64; c.qpitch = 512; c.kvpitch = 128; c.rowbase = (long)b * SEQ; c.i0 = ch * 128 + qt * 32; c.dl = 1;
            c.sl2 = alibi_slope(h) * LOG2E; c.st = nullptr; c.tl0 = 0; c.out = MIX + h * 64; c.opitch = DM; c.sink2 = A.in[10][h] * LOG2E;
            return c;
        };
        bf16x8 qf[4], kf[4]; u32x4 vv[4];
        AttnCfg c = acfg(0); attn_preload_q(c, lane, qf); attn_preload_kv(c, lane, kf, vv);
#pragma unroll 1
        for (int idx = 0; idx < nit; ++idx) {
            const bool hn = idx + 1 < nit; const AttnCfg cn = acfg(hn ? idx + 1 : idx);
            attn_item<false, true, true>(c, vimg, lane, qf, kf, vv, hn, cn);
            c = cn;
        }
    }
    if (!conv_first) { for (int it = gw7; it < 1024 + NSB; it += NGW7) conv_item(A, it, lane); }
    for (int rep_ = 0; rep_ < REP_SATT; ++rep_)
    {
        const int free0 = 1024 + NSB;
        if (NGW7 >= free0 + 3 * NSB * 2) { const int q = gw7 - free0; if (q >= 0 && q % 3 == 0 && q / 3 < NSB * 2) { const int it = q / 3; sattn_a_item(Q, A.in[2], A.in[3], K, V, A.in[10], MIX, it >> 1, it & 1, vimg, lane); } }
        else for (int it = gw7; it < NSB * 2; it += NGW7) sattn_a_item(Q, A.in[2], A.in[3], K, V, A.in[10], MIX, it >> 1, it & 1, vimg, lane);
    }
}

__device__ __forceinline__ void mixer1(const Frame& F, const Args& A) {
    unsigned char* ws = A.ws; const int lane = F.lane;
    const bf16_t* Q = (const bf16_t*)(ws + WS_Q); const bf16_t* K = (const bf16_t*)(ws + WS_K); const bf16_t* V = (const bf16_t*)(ws + WS_V); bf16_t* MIX = (bf16_t*)(ws + WS_MIX);
    LAS unsigned char* stlds = F.lds + NWAVES * VIMG;
    static_assert(NWAVES * VIMG + ST_BYTES <= RING_BYTES, "attention LDS map");
    LAS unsigned char* vimg = F.lds + F.wave * VIMG;
    {
        const int nun = (512 - (int)blockIdx.x + F.G - 1) / F.G, nit = 6 * nun;
        auto dcfg = [&](int idx) {
            const int j = idx / 6, w6 = idx - 6 * j, br = w6 >> 1, k = w6 & 1, un = blockIdx.x + j * F.G;
            const int h = un & 7, ch = (un >> 3) & 7, b = un >> 6, T0 = ch * 512;
            const int dl = br == 0 ? 16 : br == 1 ? 4 : 1, it = F.wave * 2 + k;
            int r, i0; if (br == 0) { r = it; i0 = T0 / 16; } else if (br == 1) { r = it & 3; i0 = T0 / 4 + 32 * (it >> 2); } else { r = 0; i0 = T0 + 32 * it; }
            AttnCfg c; c.Q = Q + h * 64; c.K = K + h * 64; c.V = V + h * 64; c.qpitch = 512; c.kvpitch = 512; c.rowbase = (long)b * SEQ + r; c.i0 = i0; c.dl = dl;
            c.sl2 = alibi_slope(h) * (float)dl * LOG2E; c.st = stlds; c.tl0 = r - T0; c.out = MIX + 512 + h * 64; c.opitch = DM; c.sink2 = 0.f;
            return c;
        };
        bf16x8 qf[4], kf[4]; u32x4 vv[4];
        AttnCfg c = dcfg(0); attn_preload_q(c, lane, qf); attn_preload_kv(c, lane, kf, vv);
        int br = 0, k = 0;
#pragma unroll 1
        for (int idx = 0; idx < nit; ++idx) {
            const bool hn = idx + 1 < nit; const AttnCfg cn = dcfg(hn ? idx + 1 : idx);
            if (br == 0) attn_item<false, false, false>(c, vimg, lane, qf, kf, vv, hn, cn);
            else if (br == 1) attn_item<true, false, false>(c, vimg, lane, qf, kf, vv, hn, cn);
            else attn_item<true, true, false>(c, vimg, lane, qf, kf, vv, hn, cn);
            if (k == 1) { __syncthreads(); br = br == 2 ? 0 : br + 1; }
            k ^= 1;
            c = cn;
        }
    }
    __syncthreads();
    if (F.wave < 4) {
        const int item = F.vcu * 4 + F.wave;
        for (int rep_ = 0; rep_ < REP_FUSED; ++rep_)
        for (int it = item; it < NSB * 8; it += F.G * 4) fused_d_item(A, it >> 3, it & 7, (LAS float*)(F.lds + F.wave * FD_LDS), lane);
    } else {
        const int gw4 = F.vcu * 4 + (F.wave - 4), NGW4 = F.G * 4;
        for (int rep_ = 0; rep_ < REP_CP; ++rep_)
        for (int it = gw4; it < 1024 + NSB; it += NGW4) pool_item(A, it, lane);
    }
}

__device__ __forceinline__ void final_ln(const Frame& F, const Args& A, float* dstbase, bool desig, int dsg) {
    const float* g = A.in[24] + DM; const float* bb = A.in[25] + DM;
    f32x4 gv[4], bv[4];
#pragma unroll
    for (int j = 0; j < 4; ++j) { gv[j] = ((const f32x4*)g)[F.lane + 64 * j]; bv[j] = ((const f32x4*)bb)[F.lane + 64 * j]; }
    const int m0 = desig ? MP + dsg * 64 + F.wave : F.vcu_lt240 * NWAVES + F.wave, mstep = desig ? NWAVES : 240 * NWAVES, mend = desig ? MP + dsg * 64 + 64 : MP;
    for (int m = m0; m < mend; m += mstep) {
        GAS f32x4* xr = (GAS f32x4*)(A.out + O_Y + (size_t)m * DM) + F.lane;
        f32x4 v[4]; float s = 0.f;
#pragma unroll
        for (int j = 0; j < 4; ++j) { v[j] = xr[64 * j]; s += (v[j][0] + v[j][1]) + (v[j][2] + v[j][3]); }
        const float mean = wave_sum(s) * (1.f / DM); float s2 = 0.f;
#pragma unroll
        for (int j = 0; j < 4; ++j) { v[j] = v[j] - mean; s2 += (v[j][0] * v[j][0] + v[j][1] * v[j][1]) + (v[j][2] * v[j][2] + v[j][3] * v[j][3]); }
        const float rstd = 1.f / sqrtf(wave_sum(s2) * (1.f / DM) + LN_EPS);
        GAS f32x4* xo = (GAS f32x4*)(dstbase + (size_t)m * DM) + F.lane;
#pragma unroll
        for (int j = 0; j < 4; ++j) xo[64 * j] = v[j] * rstd * gv[j] + bv[j];
    }
}
#ifndef LAST_PHASE
#define LAST_PHASE 11
#endif
constexpr int CW_DEFER = 12288;
struct UOrder {
    int nN, c, npre, pm0, pn0, nmain, extraL, rev;
    __device__ __forceinline__ static void map(int L, int nN, Unit& u) {
        const int nM = MP / 256, nwg = nM * nN; int wgid = L;
        { const int q = nwg / 8, r = nwg % 8, xcd = wgid % 8, off = wgid / 8; wgid = (xcd < r ? xcd * (q + 1) : r * (q + 1) + (xcd - r) * q) + off; }
        const int nig = 8 * nN, gid = wgid / nig, fm = gid * 8, gsz = (nM - fm) < 8 ? (nM - fm) : 8;
        u.pm = fm + ((wgid % nig) % gsz); u.pn = (wgid % nig) / gsz;
    }
    __device__ __forceinline__ bool next(int i, Unit& u) const {
        if (i < npre) { u.pm = pm0; u.pn = pn0 + i; return true; }
        const int k = i - npre; int L;
        if (k < nmain) L = (rev ? nmain - 1 - k : k) * 256 + c; else if (k == nmain && extraL >= 0) L = extraL; else return false;
        map(L, nN, u); return true;
    }
    __device__ __forceinline__ void a_ready(const Unit&) const {}
    __device__ __forceinline__ void done(const Unit&) const {}
    __device__ __forceinline__ static UOrder prompt_rounds(int nN, int c, int rounds, int rev = 0) { return UOrder{nN, c, 0, 0, 0, rounds, -1, rev}; }
    __device__ __forceinline__ static UOrder sample_units(int nN, int pm, int pn0, int n) { return UOrder{nN, 0, n, pm, pn0, 0, -1, 0}; }
    __device__ __forceinline__ static UOrder mlp1(int c) {
        if (c >= 240) { const int d = c - 240; return UOrder{16, c, 4, 128 + (d >> 2), 4 * (d & 3), 0, -1, 0}; }
        const int g8 = c >> 3, a = (g8 & 1) == 0 ? (g8 >> 1) * 8 + (c & 7) : (g8 == 29 ? 120 + (c & 7) : -1);
        return UOrder{16, c, 0, 0, 0, 8, a >= 0 ? (a / 16) * 256 + 240 + (a % 16) : -1, 0};
    }
    __device__ __forceinline__ static UOrder in1(int c) {
        if (c >= 240) { const int d = c - 240; return UOrder{8, c, 2, 128 + (d >> 2), 2 * (d & 3), 2, -1, 0}; }
        return UOrder{8, c, 0, 0, 0, 4, c < 32 ? (2 + c / 16) * 256 + 240 + (c % 16) : -1, 0};
    }
};
__device__ __forceinline__ void sync16(const Frame& F, gu32* cnt) {
    asm volatile("s_waitcnt vmcnt(0)" ::: "memory");
    __syncthreads();
    if (F.tid == 0) {
        __builtin_amdgcn_fence(__ATOMIC_RELEASE, "agent");
        asm volatile("s_waitcnt vmcnt(0)" ::: "memory");
        __hip_atomic_fetch_add(cnt, 1u, RLX_AGENT);
        unsigned sp = 0;
        while (__hip_atomic_load(cnt, RLX_AGENT) < 16u) { __builtin_amdgcn_s_sleep(1); if (++sp > XB_SPIN_CAP) { atomicAdd((unsigned*)(F.ctl + CW_BAR) + XB_TMO, 1u); break; } }
        __builtin_amdgcn_fence(__ATOMIC_ACQUIRE, "agent");
        asm volatile("s_waitcnt vmcnt(0)" ::: "memory");
    }
    __syncthreads();
}
constexpr int ARG_OFF = LDSCTL_OFF + 512;
__device__ __forceinline__ const float* lds_arg(const Frame& F, int i) {
    const LAS unsigned* t = (const LAS unsigned*)(F.lds + ARG_OFF) + 2 * i;
    const unsigned lo = __builtin_amdgcn_readfirstlane(t[0]), hi = __builtin_amdgcn_readfirstlane(t[1]);
    return (const float*)(const GAS float*)(((unsigned long long)hi << 32) | lo);
}
#define LOAD_ARGS(A) Args A; { int t_ = threadIdx.x; asm volatile("" : "+v"(t_)); F.tid = t_; F.lane = t_ & 63; } {     _Pragma("unroll") for (int i_ = 0; i_ < 26; ++i_) A.in[i_] = lds_arg(F, i_); A.out = (float*)lds_arg(F, 26); A.ws = (unsigned char*)lds_arg(F, 27); }
__global__ void __launch_bounds__(NWAVES * 64, 2) hybrid_fwd(Args args) {
    extern __shared__ __attribute__((aligned(16))) unsigned char lds[];
    Frame F;
    F.lds = (LAS unsigned char*)lds;
    F.tid = threadIdx.x; F.lane = F.tid & 63; F.wave = __builtin_amdgcn_readfirstlane(F.tid >> 6);
    F.G = gridDim.x; { const int bx = blockIdx.x; F.vcu = (F.G % 8 == 0) ? (bx % 8) * (F.G / 8) + bx / 8 : bx; }
    F.gw = F.vcu * NWAVES + F.wave; F.NGW = F.G * NWAVES; F.vcu_lt240 = (int)blockIdx.x;
    F.ctl = (gu32*)(args.ws + WS_CTL);
    volatile LAS unsigned* MISC = (volatile LAS unsigned*)(F.lds + MISC_OFF);
    for (int u = F.tid; u < (LDS_BYTES - LDSCTL_OFF) / 4; u += NWAVES * 64) ((LAS unsigned*)(F.lds + LDSCTL_OFF))[u] = 0u;
    __syncthreads();
    if (F.tid == 0) {
        LAS unsigned long long* t = (LAS unsigned long long*)(F.lds + ARG_OFF);
#pragma unroll
        for (int i = 0; i < 26; ++i) t[i] = (unsigned long long)args.in[i];
        t[26] = (unsigned long long)args.out; t[27] = (unsigned long long)args.ws;
    }
    __syncthreads();
    XcdBarrier bar = xcd_barrier_post((unsigned*)(F.ctl + CW_BAR), MISC + 8);
    const int bid = (int)blockIdx.x;
#ifdef REP_BAR
#define PHASE_END(k) do { { LOAD_ARGS(Ac_); steal_copy(F, Ac_, (k), false); } xcd_barrier(bar); xcd_barrier(bar); } while (0)
#else
#define PHASE_END(k) do { { LOAD_ARGS(Ac_); steal_copy(F, Ac_, (k), false); } xcd_barrier(bar); } while (0)
#endif
#define PHASE_END_NS(k) do { xcd_barrier(bar); } while (0)
#define WSP(T, off) ((T*)(A.ws + (off)))
#define VECP(off) ((float*)(A.ws + WS_VEC) + (off))

    const bool desig = bid >= 240; const int dsg = bid - 240;
    gu32* dcnt = F.ctl + CW_DEFER;

#define STAGGER if (!desig && ((bid >> 3) & 1) && (bid >> 3) != 29) { LOAD_ARGS(As_); stagger_copy(F, As_, 2); }
    { LOAD_ARGS(A); p0_prologue(F, A); }
    PHASE_END_NS(0);
    { LOAD_ARGS(A); pg8::Gemm g{WSP(bf16_t, WS_XB), WSP(const bf16_t, WS_WIN0), M, N_IN0, DM}; pg8::StaticOrder S; S.init(M, N_IN0, F.G, bid);
      EpiIn0 E{WSP(bf16_t, WS_Q), WSP(bf16_t, WS_K), WSP(bf16_t, WS_V), WSP(bf16_t, WS_C), WSP(bf16_t, WS_GB), VECP(V_BIN0), A.out};
      pg8::gemm_phase<EpiIn0, pg8::StaticOrder, true, true>(F.lds, g, S, E); }
    PHASE_END(1);
    { LOAD_ARGS(A); mixer0(F, A); }
    PHASE_END_NS(2);
#define GEMM_MLP2_0(ORD) { LOAD_ARGS(A); pg8::Gemm g{WSP(bf16_t, WS_H), WSP(const bf16_t, WS_W2_0), M, DM, FF}; \
      EpiRes<true, false, false> E{WSP(const bf16_t, WS_ZH0), WSP(float, WS_STA), A.in[22], A.in[23], nullptr, nullptr, WSP(bf16_t, WS_ZH1), WSP(float, WS_STB), F.lds}; \
      pg8::gemm_phase<EpiRes<true, false, false>, UOrder, true, true>(F.lds, g, ORD, E); }
#define GEMM_MLP2_0_SAMPLE if (desig) { sync16(F, dcnt + 64); { UOrder S = UOrder::sample_units(4, 128 + (dsg >> 2), dsg & 3, 1); GEMM_MLP2_0(S) } }
#define GEMM_OUT0(ORD) { LOAD_ARGS(A); pg8::Gemm g{WSP(bf16_t, WS_MIX), WSP(const bf16_t, WS_WOUT0), M, DM, DM}; \
      EpiRes<false, true, false> E{WSP(const bf16_t, WS_XB), nullptr, nullptr, nullptr, A.in[13], nullptr, WSP(bf16_t, WS_ZH0), WSP(float, WS_STA), F.lds}; \
      pg8::gemm_phase<EpiRes<false, true, false>, UOrder, true, true>(F.lds, g, ORD, E); }
    { UOrder S = UOrder::prompt_rounds(4, bid, 2); GEMM_OUT0(S) }
    PHASE_END_NS(3);
    if (desig) { { UOrder S = UOrder::sample_units(4, 128 + (dsg >> 2), dsg & 3, 1); GEMM_OUT0(S) } sync16(F, dcnt + 0); }
#define GEMM_MLP1(WOFF, CSO, BWO, ORD) { LOAD_ARGS(A); pg8::Gemm g{WSP(bf16_t, WS_ZH0), WSP(const bf16_t, WOFF), M, FF, DM}; \
      EpiMlp1 E{WSP(bf16_t, WS_H), VECP(CSO), VECP(BWO), WSP(float, WS_STA), F.lds}; \
      pg8::gemm_phase<EpiMlp1, UOrder, true, true>(F.lds, g, ORD, E); }
    STAGGER
    { UOrder S = UOrder::mlp1(bid); GEMM_MLP1(WS_W1_0, V_CS1_0, V_BW1_0, S) }
    GEMM_MLP2_0_SAMPLE
    PHASE_END(4);
    { UOrder S = UOrder::prompt_rounds(4, bid, 2, 1); GEMM_MLP2_0(S) }
    PHASE_END_NS(5);
    { LOAD_ARGS(A); pg8::Gemm g{WSP(bf16_t, WS_ZH1), WSP(const bf16_t, WS_WIN1), M, N_IN1, DM}; UOrder S = UOrder::in1(bid);
      EpiIn1 E{WSP(bf16_t, WS_C), WSP(bf16_t, WS_Q), WSP(bf16_t, WS_K), WSP(bf16_t, WS_V), VECP(V_CSIN1), VECP(V_BWIN1), WSP(float, WS_STB), A.out, F.lds};
      pg8::gemm_phase<EpiIn1, UOrder, true, true>(F.lds, g, S, E); }
    PHASE_END(6);
    { LOAD_ARGS(A); mixer1(F, A); }
    PHASE_END_NS(7);
#define GEMM_MLP2_1(ORD) { LOAD_ARGS(A); pg8::Gemm g{WSP(bf16_t, WS_H), WSP(const bf16_t, WS_W2_1), M, DM, FF}; \
      EpiResFinal E{WSP(const bf16_t, WS_ZH0), WSP(float, WS_STA), A.in[22] + DM, A.in[23] + DM, A.in[24] + DM, A.in[25] + DM, A.out + O_Y, WSP(float, WS_STB), F.ctl, F.lds}; \
      pg8::gemm_phase<EpiResFinal, UOrder, true, true>(F.lds, g, ORD, E); }
#define GEMM_MLP2_1_SAMPLE if (desig) { sync16(F, dcnt + 192); { UOrder S = UOrder::sample_units(4, 128 + (dsg >> 2), dsg & 3, 1); GEMM_MLP2_1(S) } }
#define GEMM_OUT1(ORD) { LOAD_ARGS(A); pg8::Gemm g{WSP(bf16_t, WS_MIX), WSP(const bf16_t, WS_WOUT1), M, DM, DM}; \
      EpiRes<true, true, false> E{WSP(const bf16_t, WS_ZH1), WSP(float, WS_STB), A.in[24], A.in[25], A.in[19], nullptr, WSP(bf16_t, WS_ZH0), WSP(float, WS_STA), F.lds}; \
      pg8::gemm_phase<EpiRes<true, true, false>, UOrder, true, true>(F.lds, g, ORD, E); }
    { UOrder S = UOrder::prompt_rounds(4, bid, 2); GEMM_OUT1(S) }
    PHASE_END_NS(8);
    if (desig) { { UOrder S = UOrder::sample_units(4, 128 + (dsg >> 2), dsg & 3, 1); GEMM_OUT1(S) } sync16(F, dcnt + 128); }
    STAGGER
    { UOrder S = UOrder::mlp1(bid); GEMM_MLP1(WS_W1_1, V_CS1_1, V_BW1_1, S) }
    GEMM_MLP2_1_SAMPLE
    PHASE_END(9);
    { UOrder S = UOrder::prompt_rounds(4, bid, 2, 1); GEMM_MLP2_1(S) }
    { LOAD_ARGS(A); steal_copy(F, A, 11, true); }
#undef GEMM_OUT0
#undef GEMM_MLP1
#undef GEMM_MLP2_0
#undef GEMM_OUT1
#undef GEMM_MLP2_1
#undef GEMM_MLP2_0_SAMPLE
#undef GEMM_MLP2_1_SAMPLE
#undef PHASE_END
#undef WSP
#undef VECP
}

extern "C" void kernel_launch(void* const* d_in, const int* in_sizes, int n_in, void* d_out, int out_size, void* d_ws, size_t ws_size, hipStream_t stream) {
    static int grid = 0;
    if (grid == 0) {
        if (n_in != 26 || in_sizes[0] != MP * DM || (size_t)out_size != O_TOTAL || ws_size < WS_END) {
            fprintf(stderr, "kernel_launch: unexpected shapes (n_in %d, in0 %d, out %d, ws %zu); nothing launched\n", n_in, n_in > 0 ? in_sizes[0] : -1, out_size, ws_size); grid = -1; return; }
        int dev = 0, cus = 0, per_cu = 0;
        if (hipGetDevice(&dev) != hipSuccess || hipDeviceGetAttribute(&cus, hipDeviceAttributeMultiprocessorCount, dev) != hipSuccess) { grid = -1; return; }
        if (hipFuncSetAttribute((const void*)hybrid_fwd, hipFuncAttributeMaxDynamicSharedMemorySize, LDS_BYTES) != hipSuccess) { fprintf(stderr, "kernel_launch: hipFuncSetAttribute failed\n"); grid = -1; return; }
        if (hipOccupancyMaxActiveBlocksPerMultiprocessor(&per_cu, (const void*)hybrid_fwd, NWAVES * 64, LDS_BYTES) != hipSuccess || per_cu < 1) {
            fprintf(stderr, "kernel_launch: occupancy query reports %d workgroups per CU; nothing launched\n", per_cu); (void)hipGetLastError(); grid = -1; return; }
        grid = cus;
        if (grid != 256) { fprintf(stderr, "kernel_launch: the unit schedule is built for 256 workgroups, this device has %d CUs; nothing launched\n", cus); grid = -1; return; }
    }
    if (grid < 0) return;
    if (hipMemsetAsync((char*)d_ws + WS_CTL, 0, CTL_ZERO_BYTES, stream) != hipSuccess) return;
    Args a{};
    for (int i = 0; i < 26; ++i) a.in[i] = (const float*)d_in[i];
    a.out = (float*)d_out; a.ws = (unsigned char*)d_ws;
    hipLaunchKernelGGL(hybrid_fwd, dim3(grid), dim3(NWAVES * 64), LDS_BYTES, stream, a);
}
```
